# Optimizing an MI355X kernel written in HIP

```python
import jax, jax.numpy as jnp
from jax import lax
import numpy as np

D_MODEL = 2048
BATCH = 2
SEQ = 8192
DEPTH = 4
DEC_BATCH = 2
DEC_SEQ = 4096
PAST_LEN = 128

N_MIXERS = 2
N_A_LAYERS = (DEPTH + 1) // 2
N_B_LAYERS = DEPTH // 2
CHUNK = 128
A_WIDTH = D_MODEL
A_GROUPS = 8
A_GROUP_DIM = A_WIDTH // A_GROUPS
HEAD_DIM = 128
N_HEADS = D_MODEL // HEAD_DIM
N_KV_HEADS = 4
Q_PER_KV = N_HEADS // N_KV_HEADS
WINDOW = 128
BLOCK = 128
N_BUCKETS = 32
MAX_DISTANCE = 128
D_FF = ((8 * D_MODEL // 3) + 255) // 256 * 256
CONV_WIDTH = 3
EPS = 1e-6

kernel_name = "hybrid_gmlp_swa_encoder"


def rmsnorm(x, g):
    xf = x.astype(jnp.float32)
    y = xf * lax.rsqrt(jnp.mean(xf * xf, axis=-1, keepdims=True) + EPS)
    return (y * g.astype(jnp.float32)).astype(x.dtype)


def _relative_bucket(rel):
    half = N_BUCKETS // 2
    max_exact = half // 2
    ret = (rel > 0).astype(np.int32) * half
    n = np.abs(rel)
    nf = np.maximum(n, 1).astype(np.float32)
    large = max_exact + (np.log(nf / max_exact) / np.log(MAX_DISTANCE / max_exact)
                         * (half - max_exact)).astype(np.int32)
    large = np.minimum(large, half - 1)
    return (ret + np.where(n < max_exact, n, large)).astype(np.int32)


def _band_bucket_mask(n_blocks, seq_len):
    a = np.arange(BLOCK)[:, None]
    c = np.arange(3 * BLOCK)[None, :]
    rel = c - BLOCK - a
    bucket = _relative_bucket(rel)
    in_window = np.abs(rel) <= WINDOW
    key_pos = np.arange(n_blocks)[:, None, None] * BLOCK + (c - BLOCK)[None]
    mask = (key_pos >= 0) & (key_pos < seq_len) & in_window[None]
    return bucket, mask


def mixer_a(h, w_in, b_in, v_norm, w_s, b_s, w_out):
    B, S, _ = h.shape
    nc = S // CHUNK
    z = jax.nn.gelu(h @ w_in + b_in)
    u, v = jnp.split(z, 2, axis=-1)
    v = rmsnorm(v, v_norm).reshape(B, nc, CHUNK, A_GROUPS, A_GROUP_DIM)
    s = jnp.einsum('gpq,bnqgc->bnpgc', w_s, v) + b_s.T[None, None, :, :, None]
    y = u * s.reshape(B, S, A_WIDTH)
    return y @ w_out


def mixer_b(h, rel_bias, w_qkv, sink, w_out):
    B, S, _ = h.shape
    nb = S // BLOCK
    qkv = h @ w_qkv
    q, k, v = jnp.split(qkv, [N_HEADS * HEAD_DIM, (N_HEADS + N_KV_HEADS) * HEAD_DIM], axis=-1)
    q = q.reshape(B, nb, BLOCK, N_KV_HEADS, Q_PER_KV, HEAD_DIM)

    def windows(t):
        t = t.reshape(B, S, N_KV_HEADS, HEAD_DIM)
        tp = jnp.pad(t, ((0, 0), (BLOCK, BLOCK), (0, 0), (0, 0)))
        tp = tp.reshape(B, nb + 2, BLOCK, N_KV_HEADS, HEAD_DIM)
        return jnp.concatenate([tp[:, :-2], tp[:, 1:-1], tp[:, 2:]], axis=2)

    kw, vw = windows(k), windows(v)
    bucket, mask = _band_bucket_mask(nb, S)
    bias = rel_bias.astype(jnp.float32)[bucket]
    bias = bias.transpose(2, 0, 1).reshape(N_KV_HEADS, Q_PER_KV, BLOCK, 3 * BLOCK)
    logits = jnp.einsum('bnqkgd,bnckd->bnkgqc', q, kw,
                        preferred_element_type=jnp.float32) * (HEAD_DIM ** -0.5) + bias
    logits = jnp.where(mask[None, :, None, None], logits, -jnp.inf)
    sink_l = sink.astype(jnp.float32).reshape(N_KV_HEADS, Q_PER_KV, 1, 1)
    m = jnp.maximum(jnp.max(logits, axis=-1, keepdims=True), sink_l)
    p = jnp.exp(logits - m)
    denom = jnp.sum(p, axis=-1, keepdims=True) + jnp.exp(sink_l - m)
    p = (p / denom).astype(vw.dtype)
    o = jnp.einsum('bnkgqc,bnckd->bnqkgd', p, vw).reshape(B, S, N_HEADS * HEAD_DIM)
    return o @ w_out


def conv_ffn(h, w_in, conv_w, conv_b, w_out):
    z = h @ w_in
    zp = jnp.pad(z, ((0, 0), (1, 1), (0, 0)))
    z = zp[:, :-2] * conv_w[0] + zp[:, 1:-1] * conv_w[1] + zp[:, 2:] * conv_w[2] + conv_b
    g, u = jnp.split(z, 2, axis=-1)
    return (jax.nn.silu(g) * u) @ w_out


def trunk(x, rel_bias, mix_norm, ffn_norm, final_norm,
          a_w_in, a_b_in, a_v_norm, a_w_s, a_b_s, a_w_out,
          b_w_qkv, b_sink, b_w_out,
          f_w_in, f_conv_w, f_conv_b, f_w_out):
    for i in range(DEPTH):
        h = rmsnorm(x, mix_norm[i])
        j = i // N_MIXERS
        if i % N_MIXERS == 0:
            x = x + mixer_a(h, a_w_in[j], a_b_in[j], a_v_norm[j], a_w_s[j], a_b_s[j], a_w_out[j])
        else:
            x = x + mixer_b(h, rel_bias, b_w_qkv[j], b_sink[j], b_w_out[j])
        h = rmsnorm(x, ffn_norm[i])
        x = x + conv_ffn(h, f_w_in[i], f_conv_w[i], f_conv_b[i], f_w_out[i])
    return rmsnorm(x, final_norm)


def setup_inputs(seed: int = 0) -> dict:
    key = jax.random.key(seed)
    ks = jax.random.split(key, 20)
    f32 = jnp.float32

    def nrm(k, shape, scale):
        return jax.random.normal(k, shape, f32) * scale

    qkv_dim = (N_HEADS + 2 * N_KV_HEADS) * HEAD_DIM
    return {
        "x_prompt": nrm(ks[0], (BATCH, SEQ, D_MODEL), 1.0),
        "x_sample": nrm(ks[1], (DEC_BATCH, DEC_SEQ, D_MODEL), 1.0),
        "rel_bias": nrm(ks[2], (N_BUCKETS, N_HEADS), 0.5),
        "mix_norm": 1.0 + nrm(ks[3], (DEPTH, D_MODEL), 0.02),
        "ffn_norm": 1.0 + nrm(ks[4], (DEPTH, D_MODEL), 0.02),
        "final_norm": 1.0 + nrm(ks[5], (D_MODEL,), 0.02),
        "a_w_in": nrm(ks[6], (N_A_LAYERS, D_MODEL, 2 * A_WIDTH), D_MODEL ** -0.5),
        "a_b_in": nrm(ks[7], (N_A_LAYERS, 2 * A_WIDTH), 0.02),
        "a_v_norm": 1.0 + nrm(ks[8], (N_A_LAYERS, A_WIDTH), 0.02),
        "a_w_s": nrm(ks[9], (N_A_LAYERS, A_GROUPS, CHUNK, CHUNK), CHUNK ** -0.5),
        "a_b_s": 1.0 + nrm(ks[10], (N_A_LAYERS, A_GROUPS, CHUNK), 0.02),
        "a_w_out": nrm(ks[11], (N_A_LAYERS, A_WIDTH, D_MODEL), A_WIDTH ** -0.5),
        "b_w_qkv": nrm(ks[12], (N_B_LAYERS, D_MODEL, qkv_dim), D_MODEL ** -0.5),
        "b_sink": nrm(ks[13], (N_B_LAYERS, N_HEADS), 0.5),
        "b_w_out": nrm(ks[14], (N_B_LAYERS, N_HEADS * HEAD_DIM, D_MODEL), (N_HEADS * HEAD_DIM) ** -0.5),
        "f_w_in": nrm(ks[15], (DEPTH, D_MODEL, 2 * D_FF), D_MODEL ** -0.5),
        "f_conv_w": nrm(ks[16], (DEPTH, CONV_WIDTH, 2 * D_FF), CONV_WIDTH ** -0.5),
        "f_conv_b": nrm(ks[17], (DEPTH, 2 * D_FF), 0.02),
        "f_w_out": nrm(ks[18], (DEPTH, D_FF, D_MODEL), D_FF ** -0.5),
    }


def reference(x_prompt, x_sample, rel_bias, mix_norm, ffn_norm, final_norm,
              a_w_in, a_b_in, a_v_norm, a_w_s, a_b_s, a_w_out,
              b_w_qkv, b_sink, b_w_out,
              f_w_in, f_conv_w, f_conv_b, f_w_out):
    y_prompt = trunk(x_prompt, rel_bias, mix_norm, ffn_norm, final_norm,
                     a_w_in, a_b_in, a_v_norm, a_w_s, a_b_s, a_w_out,
                     b_w_qkv, b_sink, b_w_out,
                     f_w_in, f_conv_w, f_conv_b, f_w_out)
    y_sample = trunk(x_sample, rel_bias, mix_norm, ffn_norm, final_norm,
                     a_w_in, a_b_in, a_v_norm, a_w_s, a_b_s, a_w_out,
                     b_w_qkv, b_sink, b_w_out,
                     f_w_in, f_conv_w, f_conv_b, f_w_out)
    return (y_prompt, y_sample)
```

```cpp
#include <hip/hip_runtime.h>
#include <hip/hip_cooperative_groups.h>
#include <cstdio>
#include <cstdint>
namespace cg = cooperative_groups;
#ifndef MK_COOP
#define MK_COOP 0
#endif
namespace pg8 {
#define PG8_LAS __attribute__((address_space(3)))
typedef unsigned short bf16_t;
typedef short bf16x8 __attribute__((ext_vector_type(8)));
typedef float f32x4 __attribute__((ext_vector_type(4)));
typedef unsigned u32x4 __attribute__((ext_vector_type(4)));
constexpr int BM = 256, BK = 64, HALF = 128, HTB = HALF * BK * 2  , STAGE_BYTES = 8 * HTB, NXCD = 8, WGM = 8;

__host__ __device__ __forceinline__ int lds_byte(int r, int c) { const int st = (r >> 4) * 2 + (c >> 5), rr = r & 15, cc = c & 31, ob = rr * 64 + cc * 2; return st * 1024 + (ob ^ (((ob >> 9) & 1) << 5)); }
__host__ __device__ __forceinline__ void stage_rc(int b, int& R, int& C) { const int st = b / 1024, sb = b % 1024, swz = sb ^ (((sb >> 9) & 1) << 5); R = (st >> 1) * 16 + swz / 64; C = (st & 1) * 32 + (swz % 64) / 2; }
__host__ __device__ __forceinline__ int perm32(int rho) { const int n = rho >> 4, i = rho & 15; return 8 * (i >> 2) + 4 * n + (i & 3); }

struct Unit { int pm, pn; };
struct Gemm { const bf16_t* A; const bf16_t* Bt; int M, N, K; };

struct StaticOrder {
    int nM, nN, nwg, G, c;
    __host__ __device__ void init(int M, int N, int G_, int c_) { nM = M / BM; nN = N / BM; nwg = nM * nN; G = G_; c = c_; }
    __host__ __device__ bool next(int i, Unit& u) const {
        const long L = (long)i * G + c; if (L >= nwg) return false;
        int wgid = (int)L; { const int q = nwg / NXCD, r = nwg % NXCD, xcd = wgid % NXCD, off = wgid / NXCD; wgid = (xcd < r ? xcd * (q + 1) : r * (q + 1) + (xcd - r) * q) + off; }
        const int nig = WGM * nN, gid = wgid / nig, fm = gid * WGM, gsz = (nM - fm) < WGM ? (nM - fm) : WGM;
        u.pm = fm + ((wgid % nig) % gsz); u.pn = (wgid % nig) / gsz; return true;
    }
    __device__ __forceinline__ void a_ready(const Unit&) const {}
    __device__ __forceinline__ void done(const Unit&) const {}
};

__device__ __forceinline__ unsigned cvt_pk_bf16(float lo, float hi) { unsigned r; asm volatile("v_cvt_pk_bf16_f32 %0, %1, %2" : "=v"(r) : "v"(lo), "v"(hi)); return r; }

constexpr int MROWS = 24576;
constexpr float NORM_EPS = 1e-6f;
typedef unsigned long long stat_t;
constexpr float STAT_SCALE = 16777216.0f, STAT_INV = 1.0f / 16777216.0f;
__device__ __forceinline__ stat_t stat_fix(float ss) { return (stat_t)(ss * STAT_SCALE + 0.5f); }
__device__ __forceinline__ float rstd2048(const stat_t* rs, int row) { return rsqrtf((float)rs[row] * (STAT_INV / 2048.0f) + NORM_EPS); }
__device__ __forceinline__ float gelu_tanh(float x) {
    const float t = x * (1.5957691216057308f + 0.07135481627f * x * x);
    const float e = __builtin_amdgcn_exp2f(-1.4426950408889634f * t);
    return x * __builtin_amdgcn_rcpf(1.0f + e);
}
__device__ __forceinline__ bf16_t f2bf_rne(float f) { return (bf16_t)(cvt_pk_bf16(f, 0.f) & 0xffffu); }

struct EpiGeluUV {
    static constexpr bool PERM = true, AFTER_DRAIN = false;
    const stat_t* rs; const float* bias; bf16_t* U; bf16_t* VT; stat_t* rsv;
    __device__ __forceinline__ void operator()(const f32x4 (&acc)[2][2][4][2], const Unit& u, int wr, int wc, int fr, int fq) const {
        const int row0 = u.pm * BM + wr * 64 + fr, colt = u.pn * BM, cl = wc * 32 + 8 * fq;
        f32x4 bv[2][2];
#pragma unroll
        for (int bj = 0; bj < 2; ++bj)
#pragma unroll
            for (int n = 0; n < 2; ++n) bv[bj][n] = *(const f32x4*)(bias + colt + bj * HALF + cl + 4 * n);
        const bool isV = u.pn >= 8;
#pragma unroll
        for (int ai = 0; ai < 2; ++ai)
#pragma unroll
            for (int m = 0; m < 4; ++m) {
                const int row = row0 + ai * HALF + m * 16; const float r = rstd2048(rs, row); float ss = 0.f;
#pragma unroll
                for (int bj = 0; bj < 2; ++bj) {
                    float v[8];
#pragma unroll
                    for (int n = 0; n < 2; ++n)
#pragma unroll
                        for (int j = 0; j < 4; ++j) v[4 * n + j] = gelu_tanh(acc[ai][bj][m][n][j] * r + bv[bj][n][j]);
                    if (!isV) {
                        u32x4 w; w.x = cvt_pk_bf16(v[0], v[1]); w.y = cvt_pk_bf16(v[2], v[3]); w.z = cvt_pk_bf16(v[4], v[5]); w.w = cvt_pk_bf16(v[6], v[7]);
                        *(u32x4*)(U + (size_t)row * 2048 + colt + bj * HALF + cl) = w;
                    } else {
                        const int c0 = colt - 2048 + bj * HALF + cl;
#pragma unroll
                        for (int j = 0; j < 8; ++j) { ss += v[j] * v[j]; VT[(size_t)(c0 + j) * MROWS + row] = f2bf_rne(v[j]); }
                    }
                }
                if (isV) { ss += __shfl_xor(ss, 16); ss += __shfl_xor(ss, 32); if (fq == 0) atomicAdd(rsv + row, stat_fix(ss)); }
            }
    }
};
struct EpiResid {
    static constexpr bool PERM = false, AFTER_DRAIN = false;
    float* X; bf16_t* XB; stat_t* rs_next;
    __device__ __forceinline__ void operator()(const f32x4 (&acc)[2][2][4][2], const Unit& u, int wr, int wc, int fr, int fq) const {
        typedef unsigned u32x2v __attribute__((ext_vector_type(2)));
        const int row0 = u.pm * BM + wr * 64 + fr, col0 = u.pn * BM + wc * 32 + 4 * fq;
#pragma unroll
        for (int ai = 0; ai < 2; ++ai)
#pragma unroll
            for (int m = 0; m < 4; ++m) {
                const int row = row0 + ai * HALF + m * 16; const size_t off = (size_t)row * 2048 + col0; float ss = 0.f;
                f32x4 xv[2][2];
#pragma unroll
                for (int bj = 0; bj < 2; ++bj)
#pragma unroll
                    for (int n = 0; n < 2; ++n) xv[bj][n] = *(const f32x4*)(X + off + bj * HALF + n * 16);
#pragma unroll
                for (int bj = 0; bj < 2; ++bj)
#pragma unroll
                    for (int n = 0; n < 2; ++n) {
                        const f32x4 x = xv[bj][n] + acc[ai][bj][m][n];
                        *(f32x4*)(X + off + bj * HALF + n * 16) = x;
                        ss += (x[0] * x[0] + x[1] * x[1]) + (x[2] * x[2] + x[3] * x[3]);
                        u32x2v w; w.x = cvt_pk_bf16(x[0], x[1]); w.y = cvt_pk_bf16(x[2], x[3]);
                        *(u32x2v*)(XB + off + bj * HALF + n * 16) = w;
                    }
                ss += __shfl_xor(ss, 16); ss += __shfl_xor(ss, 32); if (fq == 0) atomicAdd(rs_next + row, stat_fix(ss));
            }
    }
};
struct EpiQKV {
    static constexpr bool PERM = true, AFTER_DRAIN = false;
    const stat_t* rs; bf16_t* Q; bf16_t* Kb; bf16_t* VT; float qscale;
    __device__ __forceinline__ void operator()(const f32x4 (&acc)[2][2][4][2], const Unit& u, int wr, int wc, int fr, int fq) const {
        const int row0 = u.pm * BM + wr * 64 + fr, colt = u.pn * BM, cl = wc * 32 + 8 * fq;
#pragma unroll
        for (int ai = 0; ai < 2; ++ai)
#pragma unroll
            for (int m = 0; m < 4; ++m) {
                const int row = row0 + ai * HALF + m * 16; float r = rstd2048(rs, row); if (u.pn < 8) r *= qscale;
#pragma unroll
                for (int bj = 0; bj < 2; ++bj) {
                    const f32x4 v0 = acc[ai][bj][m][0] * r, v1 = acc[ai][bj][m][1] * r;
                    if (u.pn < 10) {
                        u32x4 w; w.x = cvt_pk_bf16(v0[0], v0[1]); w.y = cvt_pk_bf16(v0[2], v0[3]); w.z = cvt_pk_bf16(v1[0], v1[1]); w.w = cvt_pk_bf16(v1[2], v1[3]);
                        bf16_t* dst = (u.pn < 8) ? Q + (size_t)row * 2048 + colt + bj * HALF + cl : Kb + (size_t)row * 512 + (colt - 2048) + bj * HALF + cl;
                        *(u32x4*)dst = w;
                    } else {
                        const int c0 = colt - 2560 + bj * HALF + cl;
#pragma unroll
                        for (int j = 0; j < 4; ++j) { VT[(size_t)(c0 + j) * MROWS + row] = f2bf_rne(v0[j]); VT[(size_t)(c0 + 4 + j) * MROWS + row] = f2bf_rne(v1[j]); }
                    }
                }
            }
    }
};
struct EpiZ {
    static constexpr bool PERM = true, AFTER_DRAIN = false;
    const stat_t* rs; bf16_t* Z; int ldc;
    __device__ __forceinline__ void operator()(const f32x4 (&acc)[2][2][4][2], const Unit& u, int wr, int wc, int fr, int fq) const {
        const int row0 = u.pm * BM + wr * 64 + fr, col0 = u.pn * BM + wc * 32 + 8 * fq;
#pragma unroll
        for (int ai = 0; ai < 2; ++ai)
#pragma unroll
            for (int m = 0; m < 4; ++m) {
                const int row = row0 + ai * HALF + m * 16; const float r = rstd2048(rs, row);
#pragma unroll
                for (int bj = 0; bj < 2; ++bj) {
                    const f32x4 v0 = acc[ai][bj][m][0] * r, v1 = acc[ai][bj][m][1] * r;
                    u32x4 w; w.x = cvt_pk_bf16(v0[0], v0[1]); w.y = cvt_pk_bf16(v0[2], v0[3]); w.z = cvt_pk_bf16(v1[0], v1[1]); w.w = cvt_pk_bf16(v1[2], v1[3]);
                    *(u32x4*)(Z + (size_t)row * ldc + col0 + bj * HALF) = w;
                }
            }
    }
};

template <class Epi, class Sched, bool ALIGN_EPI = false, bool SP2 = false>
__device__ __forceinline__ void gemm_phase(PG8_LAS unsigned char* lds, const Gemm g, const Sched& S, const Epi& E) {
    int tid_ = threadIdx.x; asm volatile("" : "+v"(tid_)); const int tid = tid_, wid = __builtin_amdgcn_readfirstlane(tid >> 6), lane = tid & 63, wr = wid >> 2, wc = wid & 3, fr = lane & 15, fq = lane >> 4;
    const int K = g.K, nt = K / BK;
    unsigned voffA[2], voffB[2];
#pragma unroll
    for (int i = 0; i < 2; ++i) { int R, C; stage_rc(tid * 16 + i * 8192, R, C); const int Rb = Epi::PERM ? ((R & ~31) + perm32(R & 31)) : R;
        voffA[i] = (unsigned)(R * K + C) * 2u; voffB[i] = (unsigned)(Rb * K + C) * 2u; }
    const size_t kstep = (size_t)(BK * 2);
    const size_t hstep = (size_t)HALF * K * 2;
    const size_t tstep = 2 * hstep;
    const unsigned ldsw = (unsigned)wid * 1024u;
    const int aoff = lds_byte(wr * 64 + fr, fq * 8), boff = lds_byte(wc * 32 + fr, fq * 8);
#define PG8_SA(b, h) (((b) * 2 + (h)) * HTB)
#define PG8_SB(b, h) ((4 + (b) * 2 + (h)) * HTB)
#define PG8_STAGE(bufoff, gbase, voff) do { _Pragma("unroll") for (int _i = 0; _i < 2; ++_i) \
        __builtin_amdgcn_global_load_lds((const unsigned*)((const char*)(gbase) + (voff)[_i]), (PG8_LAS unsigned*)(lds + (bufoff) + ldsw + _i * 8192), 16, 0, 0); } while (0)
#define PG8_LDA(dst, b, h) do { _Pragma("unroll") for (int m = 0; m < 4; ++m) _Pragma("unroll") for (int k = 0; k < 2; ++k) dst[m][k] = *(const PG8_LAS bf16x8*)(lds + PG8_SA(b, h) + aoff + m * 2048 + k * 1024); } while (0)
#define PG8_LDB(dst, b, h) do { _Pragma("unroll") for (int n = 0; n < 2; ++n) _Pragma("unroll") for (int k = 0; k < 2; ++k) dst[n][k] = *(const PG8_LAS bf16x8*)(lds + PG8_SB(b, h) + boff + n * 2048 + k * 1024); } while (0)
#define PG8_MMA(ai, bj, At, Bt) do { __builtin_amdgcn_s_setprio(1); _Pragma("unroll") for (int m = 0; m < 4; ++m) _Pragma("unroll") for (int n = 0; n < 2; ++n) _Pragma("unroll") for (int k = 0; k < 2; ++k) \
        acc[ai][bj][m][n] = __builtin_amdgcn_mfma_f32_16x16x32_bf16(Bt[n][k], At[m][k], acc[ai][bj][m][n], 0, 0, 0); __builtin_amdgcn_s_setprio(0); } while (0)
#define PG8_WAIT_V(n) asm volatile("s_waitcnt vmcnt(" #n ")" ::: "memory")
#define PG8_WAIT_L(n) asm volatile("s_waitcnt lgkmcnt(" #n ")" ::: "memory")
#define PG8_BAR __builtin_amdgcn_s_barrier()
#define PG8_SCHED __builtin_amdgcn_sched_barrier(0)
    Unit cur, nxt; int ui = 0;
    if (!S.next(0, cur)) return;
    f32x4 acc[2][2][4][2];
#pragma unroll
    for (int a = 0; a < 2; ++a)
#pragma unroll
        for (int b = 0; b < 2; ++b)
#pragma unroll
            for (int m = 0; m < 4; ++m)
#pragma unroll
                for (int n = 0; n < 2; ++n) acc[a][b][m][n] = (f32x4){0.f, 0.f, 0.f, 0.f};
    bf16x8 At[4][2], B0[2][2], B1[2][2];
    const char* cA = (const char*)g.A + (size_t)cur.pm * tstep; const char* cB = (const char*)g.Bt + (size_t)cur.pn * tstep;
    S.a_ready(cur);
    if constexpr (SP2) {
        PG8_STAGE(PG8_SB(0, 0), cB, voffB); PG8_STAGE(PG8_SB(0, 1), cB + hstep, voffB); PG8_STAGE(PG8_SA(0, 0), cA, voffA); PG8_STAGE(PG8_SA(0, 1), cA + hstep, voffA);
        if (wr == 1) PG8_BAR;
        PG8_WAIT_V(2); PG8_BAR;
        PG8_STAGE(PG8_SB(1, 0), cB + kstep, voffB); PG8_STAGE(PG8_SA(1, 0), cA + kstep, voffA); PG8_STAGE(PG8_SB(1, 1), cB + hstep + kstep, voffB);
        PG8_WAIT_V(6); PG8_BAR;
    } else {
        PG8_STAGE(PG8_SB(0, 0), cB, voffB); PG8_STAGE(PG8_SA(0, 0), cA, voffA); PG8_STAGE(PG8_SB(0, 1), cB + hstep, voffB); PG8_STAGE(PG8_SA(0, 1), cA + hstep, voffA);
        if (wr == 1) PG8_BAR;
        PG8_WAIT_V(4); PG8_BAR;
        PG8_STAGE(PG8_SB(1, 0), cB + kstep, voffB); PG8_STAGE(PG8_SA(1, 0), cA + kstep, voffA); PG8_STAGE(PG8_SB(1, 1), cB + hstep + kstep, voffB);
        PG8_WAIT_V(6); PG8_BAR;
    }
    for (;;) {
        const bool has_next = S.next(ui + 1, nxt);
        const char* nA = has_next ? (const char*)g.A + (size_t)nxt.pm * tstep : cA; const char* nB = has_next ? (const char*)g.Bt + (size_t)nxt.pn * tstep : cB;
        for (int t = 0; t < nt; t += 2) {
            const bool last = (t == nt - 2);
            const char* a1 = cA + (size_t)(t + 1) * kstep;
            const char* a2 = last ? nA : cA + (size_t)(t + 2) * kstep; const char* b2 = last ? nB : cB + (size_t)(t + 2) * kstep;
            const char* a3 = a2 + kstep; const char* b3 = b2 + kstep;
            if (last && has_next) S.a_ready(nxt);
            if constexpr (SP2) {
            PG8_LDB(B0, 0, 0); PG8_LDB(B1, 0, 1); PG8_SCHED; PG8_LDA(At, 0, 0); PG8_STAGE(PG8_SA(1, 1), a1 + hstep, voffA);
            PG8_WAIT_V(8); PG8_WAIT_L(0); PG8_BAR; PG8_MMA(0, 0, At, B0); PG8_MMA(0, 1, At, B1); PG8_BAR; PG8_SCHED;
            PG8_LDA(At, 0, 1); PG8_STAGE(PG8_SB(0, 0), b2, voffB); PG8_STAGE(PG8_SB(0, 1), b2 + hstep, voffB); PG8_STAGE(PG8_SA(0, 0), a2, voffA);
            PG8_WAIT_V(8); PG8_WAIT_L(0); PG8_BAR; PG8_MMA(1, 0, At, B0); PG8_MMA(1, 1, At, B1); PG8_BAR; PG8_SCHED;
            PG8_LDB(B0, 1, 0); PG8_LDB(B1, 1, 1); PG8_SCHED; PG8_LDA(At, 1, 0); PG8_STAGE(PG8_SA(0, 1), a2 + hstep, voffA);
            PG8_WAIT_V(8); PG8_WAIT_L(0); PG8_BAR; PG8_MMA(0, 0, At, B0); PG8_MMA(0, 1, At, B1); PG8_BAR; PG8_SCHED;
            PG8_LDA(At, 1, 1); PG8_STAGE(PG8_SB(1, 0), b3, voffB); PG8_STAGE(PG8_SB(1, 1), b3 + hstep, voffB); PG8_STAGE(PG8_SA(1, 0), a3, voffA);
            PG8_WAIT_V(8); PG8_WAIT_L(0); PG8_BAR; PG8_MMA(1, 0, At, B0); PG8_MMA(1, 1, At, B1); PG8_BAR; PG8_SCHED;
            } else {
            PG8_LDB(B0, 0, 0); PG8_SCHED; PG8_LDA(At, 0, 0); PG8_STAGE(PG8_SA(1, 1), a1 + hstep, voffA);
            PG8_WAIT_L(8); PG8_BAR; PG8_WAIT_L(0); PG8_MMA(0, 0, At, B0); PG8_BAR; PG8_SCHED;
            PG8_LDB(B1, 0, 1); PG8_STAGE(PG8_SB(0, 0), b2, voffB);
            PG8_BAR; PG8_WAIT_L(0); PG8_MMA(0, 1, At, B1); PG8_BAR;
            PG8_LDA(At, 0, 1); PG8_STAGE(PG8_SA(0, 0), a2, voffA);
            PG8_BAR; PG8_WAIT_L(0); PG8_MMA(1, 0, At, B0); PG8_BAR; PG8_SCHED;
            PG8_STAGE(PG8_SB(0, 1), b2 + hstep, voffB);
            PG8_WAIT_V(6); PG8_BAR; PG8_MMA(1, 1, At, B1); PG8_BAR;
            PG8_LDB(B0, 1, 0); PG8_SCHED; PG8_LDA(At, 1, 0); PG8_STAGE(PG8_SA(0, 1), a2 + hstep, voffA);
            PG8_WAIT_L(8); PG8_BAR; PG8_WAIT_L(0); PG8_MMA(0, 0, At, B0); PG8_BAR; PG8_SCHED;
            PG8_LDB(B1, 1, 1); PG8_STAGE(PG8_SB(1, 0), b3, voffB);
            PG8_BAR; PG8_WAIT_L(0); PG8_MMA(0, 1, At, B1); PG8_BAR;
            PG8_LDA(At, 1, 1); PG8_STAGE(PG8_SA(1, 0), a3, voffA);
            PG8_BAR; PG8_WAIT_L(0); PG8_MMA(1, 0, At, B0); PG8_BAR; PG8_SCHED;
            PG8_STAGE(PG8_SB(1, 1), b3 + hstep, voffB);
            PG8_WAIT_V(6); PG8_BAR; PG8_MMA(1, 1, At, B1); PG8_BAR;
            }
        }
        if constexpr (ALIGN_EPI) { if (wr == 0) PG8_BAR; }
        if constexpr (!Epi::AFTER_DRAIN) { E(acc, cur, wr, wc, fr, fq); S.done(cur); }
        if (!has_next) break;
#pragma unroll
        for (int a = 0; a < 2; ++a)
#pragma unroll
            for (int b = 0; b < 2; ++b)
#pragma unroll
                for (int m = 0; m < 4; ++m)
#pragma unroll
                    for (int n = 0; n < 2; ++n) acc[a][b][m][n] = (f32x4){0.f, 0.f, 0.f, 0.f};
        cur = nxt; cA = nA; cB = nB; ++ui;
        if constexpr (ALIGN_EPI) { if (wr == 1) PG8_BAR; }
    }
    PG8_WAIT_V(0);
    if constexpr (!ALIGN_EPI) { if (wr == 0) PG8_BAR; }
    PG8_BAR;
    if constexpr (Epi::AFTER_DRAIN) { E.fused(acc, cur, wr, wc, fr, fq, lds, wid, lane); S.done(cur); }
#undef PG8_SA
#undef PG8_SB
#undef PG8_STAGE
#undef PG8_LDA
#undef PG8_LDB
#undef PG8_MMA
#undef PG8_WAIT_V
#undef PG8_WAIT_L
#undef PG8_BAR
#undef PG8_SCHED
}
}

constexpr int NW = 8;
constexpr int M = 24576, DM = 2048, DFF = 5632, NZ = 2 * DFF, NQKV = 3072, AW = 2048;
constexpr int SEQ_P = 8192, SEQ_S = 4096, ROWS_P = 2 * SEQ_P;
constexpr float EPS = 1e-6f, LOG2E = 1.4426950408889634f;
constexpr size_t MiB = 1u << 20;
constexpr size_t WS_RS = 0;
constexpr size_t WS_W = 4 * MiB;
constexpr size_t SZ_AIN = (size_t)4096 * 2048 * 2, SZ_SQ = (size_t)2048 * 2048 * 2, SZ_QKV = (size_t)3072 * 2048 * 2, SZ_FIN = (size_t)NZ * 2048 * 2, SZ_FOUT = (size_t)2048 * DFF * 2;
constexpr size_t WS_AIN = WS_W, WS_AOUT = WS_AIN + 2 * SZ_AIN, WS_BQKV = WS_AOUT + 2 * SZ_SQ, WS_BOUT = WS_BQKV + 2 * SZ_QKV, WS_FIN = WS_BOUT + 2 * SZ_SQ, WS_FOUT = WS_FIN + 4 * SZ_FIN;
constexpr size_t WS_XB = WS_FOUT + 4 * SZ_FOUT;
constexpr size_t SZ_ROWS = (size_t)M * 2048 * 2;
constexpr size_t WS_ACT = WS_XB + SZ_ROWS;
constexpr size_t WS_R = WS_ACT + (size_t)M * DFF * 2;
constexpr size_t WS_END = WS_R + (size_t)M * NZ * 2;
constexpr size_t R_U = 0, R_VT2 = SZ_ROWS, R_Y = 2 * SZ_ROWS;
constexpr size_t R_Q = 0, R_K = SZ_ROWS, R_VTA = R_K + (size_t)M * 512 * 2, R_O = R_VTA + (size_t)M * 512 * 2;
constexpr int LDS_BYTES = 131072;

#define LAS __attribute__((address_space(3)))
typedef unsigned short bf16;
typedef float f32x4 __attribute__((ext_vector_type(4)));
typedef short bf16x8 __attribute__((ext_vector_type(8)));
typedef unsigned u32x4v __attribute__((ext_vector_type(4)));
typedef unsigned u32x2v __attribute__((ext_vector_type(2)));
using pg8::cvt_pk_bf16; using pg8::stat_t; using pg8::stat_fix; using pg8::STAT_INV;
__device__ __forceinline__ float bf_lo(unsigned w) { return __uint_as_float(w << 16); }
__device__ __forceinline__ float bf_hi(unsigned w) { return __uint_as_float(w & 0xffff0000u); }
__device__ __forceinline__ float wave_sum(float v) {
#pragma unroll
    for (int o = 1; o < 64; o <<= 1) v += __shfl_xor(v, o);
    return v;
}

struct Args { const float* in[19]; float* out; unsigned char* ws; int ph_lo, ph_hi, coop, pad; };

__device__ __forceinline__ void transpose_item(const float* W, int K, int N, bf16* WT, const float* gain, LAS float* scr, int item, int lane) {
    const int nblk = N / 32, kb = item / nblk, nb = item % nblk, k0 = 64 * kb, n0 = 32 * nb;
#pragma unroll 8
    for (int i = 0; i < 32; ++i) { const int kk = 2 * i + (lane >> 5); float w = W[(size_t)(k0 + kk) * N + n0 + (lane & 31)]; if (gain) w *= gain[k0 + kk]; scr[kk * 33 + (lane & 31)] = w; }
    asm volatile("s_waitcnt lgkmcnt(0)" ::: "memory");
    const int c = lane & 7;
#pragma unroll
    for (int j = 0; j < 4; ++j) { const int n = (lane >> 3) + 8 * j; const LAS float* s = scr + (8 * c) * 33 + n;
        u32x4v o; o.x = cvt_pk_bf16(s[0 * 33], s[1 * 33]); o.y = cvt_pk_bf16(s[2 * 33], s[3 * 33]); o.z = cvt_pk_bf16(s[4 * 33], s[5 * 33]); o.w = cvt_pk_bf16(s[6 * 33], s[7 * 33]);
        *(u32x4v*)(WT + (size_t)(n0 + n) * K + k0 + 8 * c) = o; }
    asm volatile("s_waitcnt lgkmcnt(0)" ::: "memory");
}
__device__ __forceinline__ void transpose_matrix(const float* W, int K, int N, bf16* WT, const float* gain, LAS float* scr, int gw, int ngw, int lane) {
    const int items = (K / 64) * (N / 32);
    for (int it = gw; it < items; it += ngw) transpose_item(W, K, N, WT, gain, scr, it, lane);
}
__device__ __forceinline__ void prologue_phase(const Args& a, LAS unsigned char* lds, int tid, int wave, int lane) {
    unsigned char* ws = a.ws;
    const int G = gridDim.x, gw = blockIdx.x * NW + wave, ngw = G * NW;
    { stat_t* z = (stat_t*)(ws + WS_RS) + M; const int n = 10 * M; for (int i = blockIdx.x * 512 + tid; i < n; i += G * 512) z[i] = 0ull; }
    LAS float* scr = (LAS float*)(lds + wave * 8448);
    const float* mixn = a.in[3]; const float* ffnn = a.in[4];
#pragma unroll 1
    for (int j = 0; j < 2; ++j) {
        transpose_matrix(a.in[6] + (size_t)j * 2048 * 4096, 2048, 4096, (bf16*)(ws + WS_AIN + j * SZ_AIN), mixn + (2 * j) * 2048, scr, gw, ngw, lane);
        transpose_matrix(a.in[11] + (size_t)j * 2048 * 2048, 2048, 2048, (bf16*)(ws + WS_AOUT + j * SZ_SQ), nullptr, scr, gw, ngw, lane);
        transpose_matrix(a.in[12] + (size_t)j * 2048 * 3072, 2048, 3072, (bf16*)(ws + WS_BQKV + j * SZ_QKV), mixn + (2 * j + 1) * 2048, scr, gw, ngw, lane);
        transpose_matrix(a.in[14] + (size_t)j * 2048 * 2048, 2048, 2048, (bf16*)(ws + WS_BOUT + j * SZ_SQ), nullptr, scr, gw, ngw, lane);
    }
#pragma unroll 1
    for (int i = 0; i < 4; ++i) {
        transpose_matrix(a.in[15] + (size_t)i * 2048 * NZ, 2048, NZ, (bf16*)(ws + WS_FIN + i * SZ_FIN), ffnn + i * 2048, scr, gw, ngw, lane);
        transpose_matrix(a.in[18] + (size_t)i * DFF * 2048, DFF, 2048, (bf16*)(ws + WS_FOUT + i * SZ_FOUT), nullptr, scr, gw, ngw, lane);
    }
    stat_t* rs0 = (stat_t*)(ws + WS_RS); bf16* XB = (bf16*)(ws + WS_XB);
    for (int row = gw; row < M; row += ngw) {
        const float* src = row < ROWS_P ? a.in[0] + (size_t)row * DM : a.in[1] + (size_t)(row - ROWS_P) * DM;
        float ss = 0.f;
#pragma unroll
        for (int j = 0; j < 8; ++j) {
            const f32x4 v = *(const f32x4*)(src + j * 256 + lane * 4);
            *(f32x4*)(a.out + (size_t)row * DM + j * 256 + lane * 4) = v;
            ss += (v[0] * v[0] + v[1] * v[1]) + (v[2] * v[2] + v[3] * v[3]);
            u32x2v w; w.x = cvt_pk_bf16(v[0], v[1]); w.y = cvt_pk_bf16(v[2], v[3]);
            *(u32x2v*)(XB + (size_t)row * DM + j * 256 + lane * 4) = w;
        }
        ss = wave_sum(ss);
        if (lane == 0) rs0[row] = stat_fix(ss);
    }
}

__device__ __forceinline__ void a2_phase(LAS unsigned char* lds, const float* Wsp, const float* bs, const float* vn, const stat_t* rsv, const bf16* U, const bf16* VT, bf16* Y,
                                         int tid, int wave, int lane) {
    const int fr = lane & 15, fq = lane >> 4;
    for (int unit = blockIdx.x; unit < 192 * 8; unit += gridDim.x) {
        const int g = unit & 7, chunk = unit >> 3, row0 = chunk * 128;
        __syncthreads();
#pragma unroll
        for (int i = 0; i < 8; ++i) {
            const int idx = tid + 512 * i, p = idx >> 5, q4 = (idx & 31) * 4;
            f32x4 w = *(const f32x4*)(Wsp + (size_t)(g * 128 + p) * 128 + q4);
#pragma unroll
            for (int k = 0; k < 4; ++k) w[k] *= rsqrtf((float)rsv[row0 + q4 + k] * (STAT_INV / 2048.f) + EPS);
            u32x2v o; o.x = cvt_pk_bf16(w[0], w[1]); o.y = cvt_pk_bf16(w[2], w[3]);
            *(LAS u32x2v*)(lds + (p * 136 + q4) * 2) = o;
        }
        bf16x8 vf[2][4];
#pragma unroll
        for (int cf = 0; cf < 2; ++cf)
#pragma unroll
            for (int ks = 0; ks < 4; ++ks) vf[cf][ks] = *(const bf16x8*)(VT + (size_t)(256 * g + 32 * wave + 16 * cf + fr) * M + row0 + 32 * ks + 8 * fq);
        __syncthreads();
        f32x4 acc[8][2];
#pragma unroll
        for (int pf = 0; pf < 8; ++pf)
#pragma unroll
            for (int cf = 0; cf < 2; ++cf) acc[pf][cf] = (f32x4){0.f, 0.f, 0.f, 0.f};
#pragma unroll
        for (int pf = 0; pf < 8; ++pf)
#pragma unroll
            for (int ks = 0; ks < 4; ++ks) {
                const bf16x8 wf = *(const LAS bf16x8*)(lds + ((16 * pf + fr) * 136 + 32 * ks + 8 * fq) * 2);
#pragma unroll
                for (int cf = 0; cf < 2; ++cf) acc[pf][cf] = __builtin_amdgcn_mfma_f32_16x16x32_bf16(vf[cf][ks], wf, acc[pf][cf], 0, 0, 0);
            }
#pragma unroll
        for (int pf = 0; pf < 8; ++pf) {
            const int p = 16 * pf + fr, row = row0 + p; const float b = bs[g * 128 + p];
#pragma unroll
            for (int cf = 0; cf < 2; ++cf) {
                const int c = 256 * g + 32 * wave + 16 * cf + 4 * fq;
                const u32x2v uu = *(const u32x2v*)(U + (size_t)row * AW + c);
                const f32x4 vn4 = *(const f32x4*)(vn + c);
                const f32x4 s = acc[pf][cf];
                const float y0 = bf_lo(uu.x) * (s[0] * vn4[0] + b), y1 = bf_hi(uu.x) * (s[1] * vn4[1] + b), y2 = bf_lo(uu.y) * (s[2] * vn4[2] + b), y3 = bf_hi(uu.y) * (s[3] * vn4[3] + b);
                u32x2v o; o.x = cvt_pk_bf16(y0, y1); o.y = cvt_pk_bf16(y2, y3);
                *(u32x2v*)(Y + (size_t)row * AW + c) = o;
            }
        }
    }
}

__device__ __forceinline__ int t5_bucket(int rel) {
    const int n = rel < 0 ? -rel : rel; int b;
    if (n < 8) b = n; else { b = 8 + (n >= 12) + (n >= 16) + (n >= 23) + (n >= 32) + (n >= 46) + (n >= 64) + (n >= 91) + (n >= 128); if (b > 15) b = 15; }
    return b + (rel > 0 ? 16 : 0);
}
constexpr int AT_KS = 0, AT_VS = 34816, AT_TB = 69632;
__device__ __forceinline__ void attn_phase(LAS unsigned char* lds, const bf16* Q, const bf16* Kb, const bf16* VT, bf16* O, const float* rel_bias, const float* sink,
                                           int tid, int wave, int lane) {
    const int fr = lane & 15, fq = lane >> 4, hh = wave >> 2, wq = wave & 3;
    LAS float* tb = (LAS float*)(lds + AT_TB);
    for (int unit = blockIdx.x; unit < 192 * 8; unit += gridDim.x) {
        const int hp = unit & 1, kvh = (unit >> 1) & 3, blk = unit >> 3, row0 = blk * 128;
        int s0, s1;
        if (row0 < ROWS_P) { s0 = row0 & ~(SEQ_P - 1); s1 = s0 + SEQ_P; } else { s0 = ROWS_P + ((row0 - ROWS_P) & ~(SEQ_S - 1)); s1 = s0 + SEQ_S; }
        const int h = kvh * 4 + hp * 2 + hh;
        __syncthreads();
        for (int i = tid; i < 514; i += 512) { const int th = i / 257, idx = i % 257; tb[th * 264 + idx] = rel_bias[t5_bucket(idx - 128) * 16 + kvh * 4 + hp * 2 + th] * LOG2E; }
        bf16x8 Qf[2][4];
#pragma unroll
        for (int qf = 0; qf < 2; ++qf)
#pragma unroll
            for (int ks = 0; ks < 4; ++ks) Qf[qf][ks] = *(const bf16x8*)(Q + (size_t)(row0 + wq * 32 + qf * 16 + fr) * DM + h * 128 + 32 * ks + 8 * fq);
        float m_run[2], l_run[2];
        f32x4 Oacc[2][8];
#pragma unroll
        for (int qf = 0; qf < 2; ++qf) { m_run[qf] = sink[h] * LOG2E; l_run[qf] = (fq == 0) ? 1.0f : 0.0f;
#pragma unroll
            for (int a = 0; a < 8; ++a) Oacc[qf][a] = (f32x4){0.f, 0.f, 0.f, 0.f}; }
#pragma unroll 1
        for (int kb = -1; kb <= 1; ++kb) {
            const int kr0 = row0 + kb * 128;
            if (kr0 < s0 || kr0 >= s1) continue;
            __syncthreads();
#pragma unroll
            for (int i = 0; i < 4; ++i) {
                const int c = tid + 512 * i, r = c >> 4, cc = (c & 15) * 8;
                const u32x4v kv = *(const u32x4v*)(Kb + (size_t)(kr0 + r) * 512 + kvh * 128 + cc);
                const u32x4v vv = *(const u32x4v*)(VT + (size_t)(kvh * 128 + r) * M + kr0 + cc);
                *(LAS u32x4v*)(lds + AT_KS + (r * 136 + cc) * 2) = kv;
                *(LAS u32x4v*)(lds + AT_VS + (r * 136 + cc) * 2) = vv;
            }
            __syncthreads();
#pragma unroll 1
            for (int kt = 0; kt < 4; ++kt) {
                if ((kb == -1 && kt < wq) || (kb == 1 && kt > wq)) continue;
                f32x4 S[2][2];
#pragma unroll
                for (int qf = 0; qf < 2; ++qf)
#pragma unroll
                    for (int t = 0; t < 2; ++t) S[qf][t] = (f32x4){0.f, 0.f, 0.f, 0.f};
#pragma unroll
                for (int t = 0; t < 2; ++t)
#pragma unroll
                    for (int ks = 0; ks < 4; ++ks) {
                        const bf16x8 kf = *(const LAS bf16x8*)(lds + AT_KS + ((32 * kt + 16 * t + fr) * 136 + 32 * ks + 8 * fq) * 2);
#pragma unroll
                        for (int qf = 0; qf < 2; ++qf) S[qf][t] = __builtin_amdgcn_mfma_f32_16x16x32_bf16(kf, Qf[qf][ks], S[qf][t], 0, 0, 0);
                    }
                bf16x8 pf[2];
#pragma unroll
                for (int qf = 0; qf < 2; ++qf) {
                    const int base = kb * 128 + 32 * kt + 4 * fq - (wq * 32 + qf * 16 + fr) + 128;
                    float l[8]; float mx = -INFINITY;
#pragma unroll
                    for (int t = 0; t < 2; ++t)
#pragma unroll
                        for (int i = 0; i < 4; ++i) {
                            const int idx = base + 16 * t + i; const bool ok = (idx >= 0) && (idx <= 256);
                            const int ci = idx < 0 ? 0 : (idx > 256 ? 256 : idx);
                            const float v = ok ? S[qf][t][i] + tb[hh * 264 + ci] : -INFINITY;
                            l[4 * t + i] = v; mx = fmaxf(mx, v);
                        }
                    mx = fmaxf(mx, __shfl_xor(mx, 16)); mx = fmaxf(mx, __shfl_xor(mx, 32));
                    const float mn = fmaxf(m_run[qf], mx), sc = __builtin_amdgcn_exp2f(m_run[qf] - mn); m_run[qf] = mn;
                    float ps = 0.f;
#pragma unroll
                    for (int j = 0; j < 8; ++j) { l[j] = __builtin_amdgcn_exp2f(l[j] - mn); ps += l[j]; }
                    l_run[qf] = l_run[qf] * sc + ps;
#pragma unroll
                    for (int a = 0; a < 8; ++a) Oacc[qf][a] = Oacc[qf][a] * sc;
                    u32x4v pw; pw.x = cvt_pk_bf16(l[0], l[1]); pw.y = cvt_pk_bf16(l[2], l[3]); pw.z = cvt_pk_bf16(l[4], l[5]); pw.w = cvt_pk_bf16(l[6], l[7]);
                    pf[qf] = __builtin_bit_cast(bf16x8, pw);
                }
#pragma unroll
                for (int a = 0; a < 8; ++a) {
                    const u32x2v v0 = *(const LAS u32x2v*)(lds + AT_VS + ((16 * a + fr) * 136 + 32 * kt + 4 * fq) * 2);
                    const u32x2v v1 = *(const LAS u32x2v*)(lds + AT_VS + ((16 * a + fr) * 136 + 32 * kt + 16 + 4 * fq) * 2);
                    u32x4v vw; vw.x = v0.x; vw.y = v0.y; vw.z = v1.x; vw.w = v1.y;
                    const bf16x8 vf = __builtin_bit_cast(bf16x8, vw);
#pragma unroll
                    for (int qf = 0; qf < 2; ++qf) Oacc[qf][a] = __builtin_amdgcn_mfma_f32_16x16x32_bf16(vf, pf[qf], Oacc[qf][a], 0, 0, 0);
                }
            }
        }
#pragma unroll
        for (int qf = 0; qf < 2; ++qf) {
            float lt = l_run[qf]; lt += __shfl_xor(lt, 16); lt += __shfl_xor(lt, 32);
            const float inv = 1.0f / lt;
            bf16* orow = O + (size_t)(row0 + wq * 32 + qf * 16 + fr) * DM + h * 128 + 4 * fq;
#pragma unroll
            for (int a = 0; a < 8; ++a) { const f32x4 o = Oacc[qf][a] * inv; u32x2v w; w.x = cvt_pk_bf16(o[0], o[1]); w.y = cvt_pk_bf16(o[2], o[3]); *(u32x2v*)(orow + 16 * a) = w; }
        }
    }
}

__device__ __forceinline__ bool seq_start(int t) { return t == 0 || t == SEQ_P || t == ROWS_P || t == ROWS_P + SEQ_S || t >= M; }
__device__ __forceinline__ void f2_phase(const bf16* Z, const float* cw, const float* cb, bf16* ACT, int tid) {
    constexpr int NCC = DFF / 8;
    const int total = (M / 8) * NCC;
    for (int it = blockIdx.x * 512 + tid; it < total; it += gridDim.x * 512) {
        const int rg = it / NCC, cc = it - rg * NCC, t0 = rg * 8, c = cc * 8;
        float w0g[8], w1g[8], w2g[8], bg[8], w0u[8], w1u[8], w2u[8], bu[8];
#pragma unroll
        for (int h = 0; h < 2; ++h) {
            const f32x4 a0 = *(const f32x4*)(cw + c + 4 * h), a1 = *(const f32x4*)(cw + NZ + c + 4 * h), a2 = *(const f32x4*)(cw + 2 * NZ + c + 4 * h), ab = *(const f32x4*)(cb + c + 4 * h);
            const f32x4 u0 = *(const f32x4*)(cw + DFF + c + 4 * h), u1 = *(const f32x4*)(cw + NZ + DFF + c + 4 * h), u2 = *(const f32x4*)(cw + 2 * NZ + DFF + c + 4 * h), ub = *(const f32x4*)(cb + DFF + c + 4 * h);
#pragma unroll
            for (int j = 0; j < 4; ++j) { w0g[4 * h + j] = a0[j]; w1g[4 * h + j] = a1[j]; w2g[4 * h + j] = a2[j]; bg[4 * h + j] = ab[j]; w0u[4 * h + j] = u0[j]; w1u[4 * h + j] = u1[j]; w2u[4 * h + j] = u2[j]; bu[4 * h + j] = ub[j]; }
        }
        const u32x4v zero = (u32x4v){0u, 0u, 0u, 0u};
        const bf16* zp = Z + (size_t)t0 * NZ + c;
        u32x4v gp = zero, up = zero;
        if (!seq_start(t0)) { gp = *(const u32x4v*)(zp - NZ); up = *(const u32x4v*)(zp - NZ + DFF); }
        u32x4v gc = *(const u32x4v*)zp, uc = *(const u32x4v*)(zp + DFF);
#pragma unroll
        for (int r = 0; r < 8; ++r) {
            u32x4v gn = zero, un = zero;
            if (r < 7 || !seq_start(t0 + 8)) { gn = *(const u32x4v*)(zp + (size_t)(r + 1) * NZ); un = *(const u32x4v*)(zp + (size_t)(r + 1) * NZ + DFF); }
            float o[8];
#pragma unroll
            for (int k = 0; k < 4; ++k) {
                {   const float g = w0g[2 * k] * bf_lo(gp[k]) + w1g[2 * k] * bf_lo(gc[k]) + w2g[2 * k] * bf_lo(gn[k]) + bg[2 * k];
                    const float u = w0u[2 * k] * bf_lo(up[k]) + w1u[2 * k] * bf_lo(uc[k]) + w2u[2 * k] * bf_lo(un[k]) + bu[2 * k];
                    o[2 * k] = g * __builtin_amdgcn_rcpf(1.0f + __builtin_amdgcn_exp2f(-LOG2E * g)) * u; }
                {   const float g = w0g[2 * k + 1] * bf_hi(gp[k]) + w1g[2 * k + 1] * bf_hi(gc[k]) + w2g[2 * k + 1] * bf_hi(gn[k]) + bg[2 * k + 1];
                    const float u = w0u[2 * k + 1] * bf_hi(up[k]) + w1u[2 * k + 1] * bf_hi(uc[k]) + w2u[2 * k + 1] * bf_hi(un[k]) + bu[2 * k + 1];
                    o[2 * k + 1] = g * __builtin_amdgcn_rcpf(1.0f + __builtin_amdgcn_exp2f(-LOG2E * g)) * u; }
            }
            u32x4v w; w.x = cvt_pk_bf16(o[0], o[1]); w.y = cvt_pk_bf16(o[2], o[3]); w.z = cvt_pk_bf16(o[4], o[5]); w.w = cvt_pk_bf16(o[6], o[7]);
            *(u32x4v*)(ACT + (size_t)(t0 + r) * DFF + c) = w;
            gp = gc; up = uc; gc = gn; uc = un;
        }
    }
}

__device__ __forceinline__ void final_phase(float* X, const stat_t* rs, const float* gain, int wave, int lane) {
    const int gw = blockIdx.x * NW + wave, ngw = gridDim.x * NW;
    for (int row = gw; row < M; row += ngw) {
        const float r = rsqrtf((float)rs[row] * (STAT_INV / 2048.f) + EPS);
#pragma unroll
        for (int j = 0; j < 8; ++j) {
            float* p = X + (size_t)row * DM + j * 256 + lane * 4;
            const f32x4 v = *(const f32x4*)p, g = *(const f32x4*)(gain + j * 256 + lane * 4);
            *(f32x4*)p = v * r * g;
        }
    }
}

constexpr int N_PHASES = 26;
__global__ void __launch_bounds__(NW * 64, 2) fwd_kernel(Args a) {
    extern __shared__ __attribute__((aligned(16))) unsigned char lds_raw[];
    LAS unsigned char* lds = (LAS unsigned char*)lds_raw;
    unsigned char* ws = a.ws;
    stat_t* RS = (stat_t*)(ws + WS_RS); stat_t* RSV = RS + 9 * M;
    bf16* XB = (bf16*)(ws + WS_XB); bf16* ACT = (bf16*)(ws + WS_ACT); unsigned char* R = ws + WS_R;
    const int G = gridDim.x;
#pragma unroll 1
    for (int ph = a.ph_lo; ph < a.ph_hi; ++ph) {
        int tid_ = threadIdx.x; asm volatile("" : "+v"(tid_));
        const int tid = tid_, lane = tid & 63, wave = __builtin_amdgcn_readfirstlane(tid >> 6);
        int bx_ = blockIdx.x; asm volatile("" : "+s"(bx_)); const int bx = bx_;
        if (ph == 0) prologue_phase(a, lds, tid, wave, lane);
        else if (ph == N_PHASES - 1) final_phase(a.out, RS + 8 * M, a.in[5], wave, lane);
        else {
            const int li = (ph - 1) / 6, sp = (ph - 1) % 6, j = li >> 1; const bool isA = (li & 1) == 0;
            if (sp == 0 && isA) {
                pg8::Gemm g{XB, (const bf16*)(ws + WS_AIN + j * SZ_AIN), M, 4096, 2048}; pg8::StaticOrder S; S.init(M, 4096, G, bx);
                pg8::EpiGeluUV E{RS + (2 * li) * M, a.in[7] + j * 4096, (bf16*)(R + R_U), (bf16*)(R + R_VT2), RSV + j * M};
                pg8::gemm_phase<pg8::EpiGeluUV, pg8::StaticOrder, true, true>(lds, g, S, E);
            } else if (sp == 0) {
                pg8::Gemm g{XB, (const bf16*)(ws + WS_BQKV + j * SZ_QKV), M, NQKV, 2048}; pg8::StaticOrder S; S.init(M, NQKV, G, bx);
                pg8::EpiQKV E{RS + (2 * li) * M, (bf16*)(R + R_Q), (bf16*)(R + R_K), (bf16*)(R + R_VTA), 0.08838834764831845f * LOG2E};
                pg8::gemm_phase<pg8::EpiQKV, pg8::StaticOrder, true, true>(lds, g, S, E);
            } else if (sp == 1 && isA) {
                a2_phase(lds, a.in[9] + (size_t)j * 8 * 128 * 128, a.in[10] + j * 8 * 128, a.in[8] + j * 2048, RSV + j * M, (const bf16*)(R + R_U), (const bf16*)(R + R_VT2), (bf16*)(R + R_Y), tid, wave, lane);
            } else if (sp == 1) {
                attn_phase(lds, (const bf16*)(R + R_Q), (const bf16*)(R + R_K), (const bf16*)(R + R_VTA), (bf16*)(R + R_O), a.in[2], a.in[13] + j * 16, tid, wave, lane);
            } else if (sp == 2 || sp == 5) {
                const bf16* A; const bf16* Bt; int K; stat_t* rsn;
                if (sp == 2) { A = isA ? (const bf16*)(R + R_Y) : (const bf16*)(R + R_O); Bt = isA ? (const bf16*)(ws + WS_AOUT + j * SZ_SQ) : (const bf16*)(ws + WS_BOUT + j * SZ_SQ); K = 2048; rsn = RS + (2 * li + 1) * M; }
                else { A = ACT; Bt = (const bf16*)(ws + WS_FOUT + li * SZ_FOUT); K = DFF; rsn = RS + (2 * li + 2) * M; }
                pg8::Gemm g{A, Bt, M, 2048, K}; pg8::StaticOrder S; S.init(M, 2048, G, bx);
                pg8::EpiResid E{a.out, XB, rsn};
                pg8::gemm_phase<pg8::EpiResid, pg8::StaticOrder, true, true>(lds, g, S, E);
            } else if (sp == 3) {
                pg8::Gemm g{XB, (const bf16*)(ws + WS_FIN + li * SZ_FIN), M, NZ, 2048}; pg8::StaticOrder S; S.init(M, NZ, G, bx);
                pg8::EpiZ E{RS + (2 * li + 1) * M, (bf16*)R, NZ};
                pg8::gemm_phase<pg8::EpiZ, pg8::StaticOrder, true, true>(lds, g, S, E);
            } else {
                f2_phase((const bf16*)R, a.in[16] + (size_t)li * 3 * NZ, a.in[17] + (size_t)li * NZ, ACT, tid);
            }
        }
        if (a.coop && ph + 1 < a.ph_hi) cg::this_grid().sync();
    }
}

extern "C" void kernel_launch(void* const* d_in, const int* in_sizes, int n_in, void* d_out, int out_size, void* d_ws, size_t ws_size, hipStream_t stream) {
    static int grid = 0;
    if (grid == 0) {
        if (n_in != 19 || out_size != M * DM || ws_size < WS_END) { fprintf(stderr, "kernel_launch: unexpected shapes (n_in %d out %d ws %zu need %zu)\n", n_in, out_size, ws_size, (size_t)WS_END); grid = -1; return; }
        int dev = 0, cus = 0, per_cu = 0;
        hipGetDevice(&dev); hipDeviceGetAttribute(&cus, hipDeviceAttributeMultiprocessorCount, dev);
        hipFuncSetAttribute((const void*)fwd_kernel, hipFuncAttributeMaxDynamicSharedMemorySize, LDS_BYTES);
        if (hipOccupancyMaxActiveBlocksPerMultiprocessor(&per_cu, (const void*)fwd_kernel, NW * 64, LDS_BYTES) != hipSuccess || per_cu < 1) { fprintf(stderr, "kernel_launch: occupancy query says %d\n", per_cu); per_cu = 1; }
        (void)hipGetLastError();
        grid = cus > 0 ? cus : 256;
    }
    if (grid < 0) return;
    Args a{};
    for (int i = 0; i < 19; ++i) a.in[i] = (const float*)d_in[i];
    a.out = (float*)d_out; a.ws = (unsigned char*)d_ws; a.pad = 0;
#if MK_COOP
    a.ph_lo = 0; a.ph_hi = N_PHASES; a.coop = 1;
    void* kargs[] = {&a};
    hipError_t e = hipLaunchCooperativeKernel((const void*)fwd_kernel, dim3(grid), dim3(NW * 64), kargs, LDS_BYTES, stream);
    if (e != hipSuccess) fprintf(stderr, "cooperative launch failed: %s (grid %d)\n", hipGetErrorString(e), grid);
#else
    a.coop = 0;
    for (int ph = 0; ph < N_PHASES; ++ph) { a.ph_lo = ph; a.ph_hi = ph + 1; hipLaunchKernelGGL(fwd_kernel, dim3(grid), dim3(NW * 64), LDS_BYTES, stream, a); }
#endif
}
```

```cpp
#include <hip/hip_runtime.h>
#include <hip/hip_cooperative_groups.h>
#include <cstdio>
#include <cstdint>
namespace cg = cooperative_groups;
#ifndef MK_COOP
#define MK_COOP 1
#endif
namespace pg8 {
#define PG8_LAS __attribute__((address_space(3)))
typedef unsigned short bf16_t;
typedef short bf16x8 __attribute__((ext_vector_type(8)));
typedef float f32x4 __attribute__((ext_vector_type(4)));
typedef unsigned u32x4 __attribute__((ext_vector_type(4)));
constexpr int BM = 256, BK = 64, HALF = 128, HTB = HALF * BK * 2  , STAGE_BYTES = 8 * HTB, NXCD = 8, WGM = 4;

__host__ __device__ __forceinline__ int lds_byte(int r, int c) { const int st = (r >> 4) * 2 + (c >> 5), rr = r & 15, cc = c & 31, ob = rr * 64 + cc * 2; return st * 1024 + (ob ^ (((ob >> 9) & 1) << 5)); }
__host__ __device__ __forceinline__ void stage_rc(int b, int& R, int& C) { const int st = b / 1024, sb = b % 1024, swz = sb ^ (((sb >> 9) & 1) << 5); R = (st >> 1) * 16 + swz / 64; C = (st & 1) * 32 + (swz % 64) / 2; }
__host__ __device__ __forceinline__ int perm32(int rho) { const int n = rho >> 4, i = rho & 15; return 8 * (i >> 2) + 4 * n + (i & 3); }

struct Unit { int pm, pn; };
struct Gemm { const bf16_t* A; const bf16_t* Bt; int M, N, K; };

struct StaticOrder {
    int nM, nN, nwg, G, c;
    __host__ __device__ void init(int M, int N, int G_, int c_) { nM = M / BM; nN = N / BM; nwg = nM * nN; G = G_; c = c_; }
    __host__ __device__ bool next(int i, Unit& u) const {
        const long L = (long)i * G + c; if (L >= nwg) return false;
        int wgid = (int)L; { const int q = nwg / NXCD, r = nwg % NXCD, xcd = wgid % NXCD, off = wgid / NXCD; wgid = (xcd < r ? xcd * (q + 1) : r * (q + 1) + (xcd - r) * q) + off; }
        const int nig = WGM * nN, gid = wgid / nig, fm = gid * WGM, gsz = (nM - fm) < WGM ? (nM - fm) : WGM;
        u.pm = fm + ((wgid % nig) % gsz); u.pn = (wgid % nig) / gsz; return true;
    }
    __device__ __forceinline__ void a_ready(const Unit&) const {}
    __device__ __forceinline__ void done(const Unit&) const {}
};

__device__ __forceinline__ unsigned cvt_pk_bf16(float lo, float hi) { unsigned r; asm volatile("v_cvt_pk_bf16_f32 %0, %1, %2" : "=v"(r) : "v"(lo), "v"(hi)); return r; }

constexpr int MROWS = 24576;
constexpr float NORM_EPS = 1e-6f;
typedef unsigned long long stat_t;
constexpr float STAT_SCALE = 16777216.0f, STAT_INV = 1.0f / 16777216.0f;
__device__ __forceinline__ stat_t stat_fix(float ss) { return (stat_t)(ss * STAT_SCALE + 0.5f); }
__device__ __forceinline__ float rstd2048(const stat_t* rs, int row) { return rsqrtf((float)rs[row] * (STAT_INV / 2048.0f) + NORM_EPS); }
__device__ __forceinline__ float gelu_tanh(float x) {
    const float t = x * (1.5957691216057308f + 0.07135481627f * x * x);
    const float e = __builtin_amdgcn_exp2f(-1.4426950408889634f * t);
    return x * __builtin_amdgcn_rcpf(1.0f + e);
}
__device__ __forceinline__ bf16_t f2bf_rne(float f) { return (bf16_t)(cvt_pk_bf16(f, 0.f) & 0xffffu); }

struct EpiGeluUV {
    static constexpr bool PERM = true, AFTER_DRAIN = false, APERM = true;
    const stat_t* rs; const float* bias; bf16_t* U; bf16_t* VT; stat_t* rsv;
    __device__ __forceinline__ void operator()(const f32x4 (&acc)[2][2][4][2], const Unit& u, int wr, int wc, int fr_, int fq_) const {
        int fr = fr_, fq = fq_; asm volatile("" : "+v"(fr), "+v"(fq));
        typedef unsigned u32x2v __attribute__((ext_vector_type(2)));
        const int rowb = u.pm * BM + wr * 64 + 4 * fr, colt = u.pn * BM, cl = wc * 32 + 8 * fq;
        f32x4 bv[2][2];
#pragma unroll
        for (int bj = 0; bj < 2; ++bj)
#pragma unroll
            for (int n = 0; n < 2; ++n) bv[bj][n] = *(const f32x4*)(bias + colt + bj * HALF + cl + 4 * n);
        const bool isV = u.pn >= 8;
        float rr[2][4];
#pragma unroll
        for (int ai = 0; ai < 2; ++ai)
#pragma unroll
            for (int m = 0; m < 4; ++m) rr[ai][m] = rstd2048(rs, rowb + ai * HALF + m);
#pragma unroll
        for (int ai = 0; ai < 2; ++ai) {
            float ss[4] = {0.f, 0.f, 0.f, 0.f};
#pragma unroll
            for (int bj = 0; bj < 2; ++bj) {
                float v[4][8];
#pragma unroll
                for (int m = 0; m < 4; ++m)
#pragma unroll
                    for (int n = 0; n < 2; ++n)
#pragma unroll
                        for (int j = 0; j < 4; ++j) v[m][4 * n + j] = gelu_tanh(acc[ai][bj][m][n][j] * rr[ai][m] + bv[bj][n][j]);
                if (!isV) {
#pragma unroll
                    for (int m = 0; m < 4; ++m) {
                        u32x4 w; w.x = cvt_pk_bf16(v[m][0], v[m][1]); w.y = cvt_pk_bf16(v[m][2], v[m][3]); w.z = cvt_pk_bf16(v[m][4], v[m][5]); w.w = cvt_pk_bf16(v[m][6], v[m][7]);
                        *(u32x4*)(U + (size_t)(rowb + ai * HALF + m) * 2048 + colt + bj * HALF + cl) = w; }
                } else {
                    const int c0 = colt - 2048 + bj * HALF + cl, row = rowb + ai * HALF;
                    bf16_t* vp = VT + ((size_t)(row >> 7) * 2048 + c0) * 128 + (row & 127);
#pragma unroll
                    for (int j = 0; j < 8; ++j) {
                        u32x2v w; w.x = cvt_pk_bf16(v[0][j], v[1][j]); w.y = cvt_pk_bf16(v[2][j], v[3][j]);
                        *(u32x2v*)(vp + (size_t)j * 128) = w;
#pragma unroll
                        for (int m = 0; m < 4; ++m) ss[m] += v[m][j] * v[m][j];
                    }
                }
            }
            if (isV) {
#pragma unroll
                for (int m = 0; m < 4; ++m) { float s = ss[m]; s += __shfl_xor(s, 16); s += __shfl_xor(s, 32); if (fq == 0) atomicAdd(rsv + rowb + ai * HALF + m, stat_fix(s)); }
            }
        }
    }
};
struct EpiResid {
    static constexpr bool PERM = true, AFTER_DRAIN = false, APERM = false;
    bf16_t* XB; stat_t* rs_next;
    __device__ __forceinline__ void operator()(const f32x4 (&acc)[2][2][4][2], const Unit& u, int wr, int wc, int fr, int fq) const {
        const int row0 = u.pm * BM + wr * 64 + fr, col0 = u.pn * BM + wc * 32 + 8 * fq;
        u32x4 xv[2][4][2];
#pragma unroll
        for (int ai = 0; ai < 2; ++ai)
#pragma unroll
            for (int m = 0; m < 4; ++m)
#pragma unroll
                for (int bj = 0; bj < 2; ++bj) xv[ai][m][bj] = *(const u32x4*)(XB + (size_t)(row0 + ai * HALF + m * 16) * 2048 + col0 + bj * HALF);
#pragma unroll
        for (int ai = 0; ai < 2; ++ai)
#pragma unroll
            for (int m = 0; m < 4; ++m) {
                const int row = row0 + ai * HALF + m * 16; bf16_t* p = XB + (size_t)row * 2048 + col0; float ss = 0.f;
#pragma unroll
                for (int bj = 0; bj < 2; ++bj) {
                    u32x4 w;
#pragma unroll
                    for (int k = 0; k < 4; ++k) {
                        const float lo = __uint_as_float(xv[ai][m][bj][k] << 16) + acc[ai][bj][m][k >> 1][(k & 1) * 2], hi = __uint_as_float(xv[ai][m][bj][k] & 0xffff0000u) + acc[ai][bj][m][k >> 1][(k & 1) * 2 + 1];
                        const unsigned pk = cvt_pk_bf16(lo, hi); w[k] = pk;
                        const float rl = __uint_as_float(pk << 16), rh = __uint_as_float(pk & 0xffff0000u);
                        ss += rl * rl + rh * rh;
                    }
                    *(u32x4*)(p + bj * HALF) = w;
                }
                ss += __shfl_xor(ss, 16); ss += __shfl_xor(ss, 32); if (fq == 0) atomicAdd(rs_next + row, stat_fix(ss));
            }
    }
};
struct EpiQKV {
    static constexpr bool PERM = true, AFTER_DRAIN = false, APERM = true;
    const stat_t* rs; bf16_t* Q; bf16_t* Kb; bf16_t* VT; float qscale;
    __device__ __forceinline__ void operator()(const f32x4 (&acc)[2][2][4][2], const Unit& u, int wr, int wc, int fr_, int fq_) const {
        int fr = fr_, fq = fq_; asm volatile("" : "+v"(fr), "+v"(fq));
        typedef unsigned u32x2v __attribute__((ext_vector_type(2)));
        const int rowb = u.pm * BM + wr * 64 + 4 * fr, colt = u.pn * BM, cl = wc * 32 + 8 * fq;
        const bool isq = u.pn < 8;
        const unsigned long long ob = (unsigned long long)(isq ? Q : Kb);
        bf16_t* obase = (bf16_t*)(((unsigned long long)(unsigned)__builtin_amdgcn_readfirstlane((int)(ob >> 32)) << 32) | (unsigned)__builtin_amdgcn_readfirstlane((int)ob));
        const int oldc = isq ? 2048 : 512, ocol = isq ? colt : colt - 2048;
        float rr[2][4];
#pragma unroll
        for (int ai = 0; ai < 2; ++ai)
#pragma unroll
            for (int m = 0; m < 4; ++m) { rr[ai][m] = rstd2048(rs, rowb + ai * HALF + m); if (isq) rr[ai][m] *= qscale; }
#pragma unroll
        for (int ai = 0; ai < 2; ++ai)
#pragma unroll
            for (int bj = 0; bj < 2; ++bj) {
                if (u.pn < 10) {
#pragma unroll
                    for (int m = 0; m < 4; ++m) {
                        const f32x4 v0 = acc[ai][bj][m][0] * rr[ai][m], v1 = acc[ai][bj][m][1] * rr[ai][m]; const int row = rowb + ai * HALF + m;
                        u32x4 w; w.x = cvt_pk_bf16(v0[0], v0[1]); w.y = cvt_pk_bf16(v0[2], v0[3]); w.z = cvt_pk_bf16(v1[0], v1[1]); w.w = cvt_pk_bf16(v1[2], v1[3]);
                        *(u32x4*)(obase + (size_t)row * oldc + ocol + bj * HALF + cl) = w; }
                } else {
                    bf16_t* vp = VT + (size_t)(colt - 2560 + bj * HALF + cl) * MROWS + rowb + ai * HALF;
#pragma unroll
                    for (int n = 0; n < 2; ++n)
#pragma unroll
                        for (int j = 0; j < 4; ++j) {
                            u32x2v w; w.x = cvt_pk_bf16(acc[ai][bj][0][n][j] * rr[ai][0], acc[ai][bj][1][n][j] * rr[ai][1]); w.y = cvt_pk_bf16(acc[ai][bj][2][n][j] * rr[ai][2], acc[ai][bj][3][n][j] * rr[ai][3]);
                            *(u32x2v*)(vp + (size_t)(4 * n + j) * MROWS) = w; }
                }
            }
    }
};
__device__ __forceinline__ float dpp_shr1(float old, float v) { return __builtin_bit_cast(float, __builtin_amdgcn_update_dpp(__builtin_bit_cast(int, old), __builtin_bit_cast(int, v), 0x111, 0xf, 0xf, false)); }
__device__ __forceinline__ float dpp_shl1(float old, float v) { return __builtin_bit_cast(float, __builtin_amdgcn_update_dpp(__builtin_bit_cast(int, old), __builtin_bit_cast(int, v), 0x101, 0xf, 0xf, false)); }
__device__ __forceinline__ float fma_s(float a, float b, float c) { float d; asm("v_fma_f32 %0, %1, %2, %3" : "=v"(d) : "v"(a), "v"(b), "v"(c)); return d; }
__device__ __forceinline__ float silu_f(float g) { return g * __builtin_amdgcn_rcpf(1.0f + __builtin_amdgcn_exp2f(-1.4426950408889634f * g)); }
struct EpiConvGate {
    static constexpr bool PERM = true, AFTER_DRAIN = false, APERM = true;
    static constexpr int DFF_ = 5632, NZ_ = 11264;
    const stat_t* rs; const float* cw; const float* cb; bf16_t* ACT; float* HZ; PG8_LAS unsigned char* xch;
    __device__ __forceinline__ void operator()(const f32x4 (&acc)[2][2][4][2], const Unit& u, int wr, int wc, int fr_, int fq_) const {
        typedef unsigned u32x2v __attribute__((ext_vector_type(2)));
        int fr = fr_, fq = fq_; asm volatile("" : "+v"(fr), "+v"(fq));
        f32x4 z[2][2][4][2];
        const int rowb = u.pm * BM + wr * 64 + 4 * fr;
#pragma unroll
        for (int ai = 0; ai < 2; ++ai)
#pragma unroll
            for (int m = 0; m < 4; ++m) { const float r = rstd2048(rs, rowb + ai * HALF + m);
#pragma unroll
                for (int bj = 0; bj < 2; ++bj)
#pragma unroll
                    for (int n = 0; n < 2; ++n) z[ai][bj][m][n] = acc[ai][bj][m][n] * r; }
        PG8_LAS f32x4* X4 = (PG8_LAS f32x4*)xch;
#define XIDX(wr_, ai_, fl_) ((((((wr_) * 4 + wc) * 2 + (ai_)) * 2 + (fl_)) * 4 + fq) * 4)
#pragma unroll
        for (int ai = 0; ai < 2; ++ai) {
            if (fr == 0) {
#pragma unroll
                for (int bj = 0; bj < 2; ++bj)
#pragma unroll
                    for (int n = 0; n < 2; ++n) X4[XIDX(wr, ai, 0) + bj * 2 + n] = z[ai][bj][0][n]; }
            if (fr == 15) {
#pragma unroll
                for (int bj = 0; bj < 2; ++bj)
#pragma unroll
                    for (int n = 0; n < 2; ++n) X4[XIDX(wr, ai, 1) + bj * 2 + n] = z[ai][bj][3][n]; }
        }
        {   const int hcol = u.pn * BM + wc * 32 + 8 * fq;
            if (wr == 0 && fr == 0) {
#pragma unroll
                for (int m = 0; m < 2; ++m)
#pragma unroll
                    for (int bj = 0; bj < 2; ++bj)
#pragma unroll
                        for (int n = 0; n < 2; ++n) *(f32x4*)(HZ + (size_t)(u.pm * 4 + m) * NZ_ + hcol + bj * HALF + 4 * n) = z[0][bj][m][n]; }
            if (wr == 1 && fr == 15) {
#pragma unroll
                for (int m = 2; m < 4; ++m)
#pragma unroll
                    for (int bj = 0; bj < 2; ++bj)
#pragma unroll
                        for (int n = 0; n < 2; ++n) *(f32x4*)(HZ + (size_t)(u.pm * 4 + m) * NZ_ + hcol + bj * HALF + 4 * n) = z[1][bj][m][n]; }
        }
        asm volatile("s_waitcnt lgkmcnt(0)" ::: "memory"); __builtin_amdgcn_s_barrier(); asm volatile("" ::: "memory");
        const int ch0 = u.pn * HALF + wc * 32 + 8 * fq;
        const f32x4 zero4 = (f32x4){0.f, 0.f, 0.f, 0.f};
#pragma unroll
        for (int ai = 0; ai < 2; ++ai) {
            unsigned ow[4][4];
#pragma unroll
            for (int n = 0; n < 2; ++n) {
                const int ch = ch0 + 4 * n;
                const f32x4 w0g = *(const f32x4*)(cw + ch), w1g = *(const f32x4*)(cw + NZ_ + ch), w2g = *(const f32x4*)(cw + 2 * NZ_ + ch), bg = *(const f32x4*)(cb + ch);
                const f32x4 w0u = *(const f32x4*)(cw + DFF_ + ch), w1u = *(const f32x4*)(cw + NZ_ + DFF_ + ch), w2u = *(const f32x4*)(cw + 2 * NZ_ + DFF_ + ch), bu = *(const f32x4*)(cb + DFF_ + ch);
                f32x4 pBg = zero4, pBu = zero4, nBg = zero4, nBu = zero4;
                if (wr == 1) { pBg = X4[XIDX(0, ai, 1) + n]; pBu = X4[XIDX(0, ai, 1) + 2 + n]; }
                else if (ai == 1) { pBg = X4[XIDX(1, 0, 1) + n]; pBu = X4[XIDX(1, 0, 1) + 2 + n]; }
                if (wr == 0) { nBg = X4[XIDX(1, ai, 0) + n]; nBu = X4[XIDX(1, ai, 0) + 2 + n]; }
                else if (ai == 0) { nBg = X4[XIDX(0, 1, 0) + n]; nBu = X4[XIDX(0, 1, 0) + 2 + n]; }
                float o[4][4];
#pragma unroll
                for (int h = 0; h < 2; ++h) {
                    typedef float f32x2 __attribute__((ext_vector_type(2)));
#define PAIR(v) (h == 0 ? __builtin_shufflevector(v, v, 0, 1) : __builtin_shufflevector(v, v, 2, 3))
                    const f32x2 g0 = PAIR(z[ai][0][0][n]), g1 = PAIR(z[ai][0][1][n]), g2 = PAIR(z[ai][0][2][n]), g3 = PAIR(z[ai][0][3][n]);
                    const f32x2 u0 = PAIR(z[ai][1][0][n]), u1 = PAIR(z[ai][1][1][n]), u2 = PAIR(z[ai][1][2][n]), u3 = PAIR(z[ai][1][3][n]);
                    const f32x2 pBg2 = PAIR(pBg), nBg2 = PAIR(nBg), pBu2 = PAIR(pBu), nBu2 = PAIR(nBu);
                    f32x2 pg, ng, pu, nu;
                    pg.x = dpp_shr1(pBg2.x, g3.x); pg.y = dpp_shr1(pBg2.y, g3.y); ng.x = dpp_shl1(nBg2.x, g0.x); ng.y = dpp_shl1(nBg2.y, g0.y);
                    pu.x = dpp_shr1(pBu2.x, u3.x); pu.y = dpp_shr1(pBu2.y, u3.y); nu.x = dpp_shl1(nBu2.x, u0.x); nu.y = dpp_shl1(nBu2.y, u0.y);
                    const f32x2 A0 = PAIR(w0g), A1 = PAIR(w1g), A2 = PAIR(w2g), AB = PAIR(bg), C0 = PAIR(w0u), C1 = PAIR(w1u), C2 = PAIR(w2u), CB = PAIR(bu);
                    f32x2 G[4], U[4];
                    G[0] = A0 * pg + (A1 * g0 + (A2 * g1 + AB)); G[1] = A0 * g0 + (A1 * g1 + (A2 * g2 + AB)); G[2] = A0 * g1 + (A1 * g2 + (A2 * g3 + AB)); G[3] = A0 * g2 + (A1 * g3 + (A2 * ng + AB));
                    U[0] = C0 * pu + (C1 * u0 + (C2 * u1 + CB)); U[1] = C0 * u0 + (C1 * u1 + (C2 * u2 + CB)); U[2] = C0 * u1 + (C1 * u2 + (C2 * u3 + CB)); U[3] = C0 * u2 + (C1 * u3 + (C2 * nu + CB));
#pragma unroll
                    for (int m = 0; m < 4; ++m) {
                        const f32x2 t = G[m] * (-1.4426950408889634f);
                        f32x2 e; e.x = __builtin_amdgcn_exp2f(t.x); e.y = __builtin_amdgcn_exp2f(t.y);
                        const f32x2 d = e + 1.0f;
                        f32x2 r; r.x = __builtin_amdgcn_rcpf(d.x); r.y = __builtin_amdgcn_rcpf(d.y);
                        const f32x2 q = (G[m] * U[m]) * r;
                        o[m][2 * h] = q.x; o[m][2 * h + 1] = q.y;
                    }
#undef PAIR
                }
#pragma unroll
                for (int m = 0; m < 4; ++m) { ow[m][2 * n] = cvt_pk_bf16(o[m][0], o[m][1]); ow[m][2 * n + 1] = cvt_pk_bf16(o[m][2], o[m][3]); }
            }
#pragma unroll
            for (int m = 0; m < 4; ++m) { u32x4 w; w.x = ow[m][0]; w.y = ow[m][1]; w.z = ow[m][2]; w.w = ow[m][3];
                *(u32x4*)(ACT + (size_t)(rowb + ai * HALF + m) * DFF_ + ch0) = w; }
            asm volatile("" ::: "memory");
        }
#undef XIDX
    }
};

template <class Epi, class Sched, bool ALIGN_EPI = false, bool SP2 = false>
__device__ __forceinline__ void gemm_phase(PG8_LAS unsigned char* lds, const Gemm g, const Sched& S, const Epi& E) {
    int tid_ = threadIdx.x; asm volatile("" : "+v"(tid_)); const int tid = tid_, wid = __builtin_amdgcn_readfirstlane(tid >> 6), lane = tid & 63, wr = wid >> 2, wc = wid & 3, fr = lane & 15, fq = lane >> 4;
    const int K = g.K, nt = K / BK;
    unsigned voffA[2], voffB[2];
#pragma unroll
    for (int i = 0; i < 2; ++i) { int R, C; stage_rc(tid * 16 + i * 8192, R, C); const int Rb = Epi::PERM ? ((R & ~31) + perm32(R & 31)) : R;
        const int Ra = Epi::APERM ? ((R & ~63) + ((R & 15) << 2) + ((R >> 4) & 3)) : R;
        voffA[i] = (unsigned)(Ra * K + C) * 2u; voffB[i] = (unsigned)(Rb * K + C) * 2u; }
    const size_t kstep = (size_t)(BK * 2);
    const size_t hstep = (size_t)HALF * K * 2;
    const size_t tstep = 2 * hstep;
    const unsigned ldsw = (unsigned)wid * 1024u;
    const int aoff = lds_byte(wr * 64 + fr, fq * 8), boff = lds_byte(wc * 32 + fr, fq * 8);
#define PG8_SA(b, h) (((b) * 2 + (h)) * HTB)
#define PG8_SB(b, h) ((4 + (b) * 2 + (h)) * HTB)
#define PG8_STAGE(bufoff, gbase, voff) do { _Pragma("unroll") for (int _i = 0; _i < 2; ++_i) \
        __builtin_amdgcn_global_load_lds((const unsigned*)((const char*)(gbase) + (voff)[_i]), (PG8_LAS unsigned*)(lds + (bufoff) + ldsw + _i * 8192), 16, 0, 0); } while (0)
#define PG8_LDA(dst, b, h) do { _Pragma("unroll") for (int m = 0; m < 4; ++m) _Pragma("unroll") for (int k = 0; k < 2; ++k) dst[m][k] = *(const PG8_LAS bf16x8*)(lds + PG8_SA(b, h) + aoff + m * 2048 + k * 1024); } while (0)
#define PG8_LDB(dst, b, h) do { _Pragma("unroll") for (int n = 0; n < 2; ++n) _Pragma("unroll") for (int k = 0; k < 2; ++k) dst[n][k] = *(const PG8_LAS bf16x8*)(lds + PG8_SB(b, h) + boff + n * 2048 + k * 1024); } while (0)
#define PG8_MMA(ai, bj, At, Bt) do { __builtin_amdgcn_s_setprio(1); _Pragma("unroll") for (int m = 0; m < 4; ++m) _Pragma("unroll") for (int n = 0; n < 2; ++n) _Pragma("unroll") for (int k = 0; k < 2; ++k) \
        acc[ai][bj][m][n] = __builtin_amdgcn_mfma_f32_16x16x32_bf16(Bt[n][k], At[m][k], acc[ai][bj][m][n], 0, 0, 0); __builtin_amdgcn_s_setprio(0); } while (0)
#define PG8_WAIT_V(n) asm volatile("s_waitcnt vmcnt(" #n ")" ::: "memory")
#define PG8_WAIT_L(n) asm volatile("s_waitcnt lgkmcnt(" #n ")" ::: "memory")
#define PG8_BAR __builtin_amdgcn_s_barrier()
#define PG8_SCHED __builtin_amdgcn_sched_barrier(0)
    Unit cur, nxt; int ui = 0;
    if (!S.next(0, cur)) return;
    f32x4 acc[2][2][4][2];
#pragma unroll
    for (int a = 0; a < 2; ++a)
#pragma unroll
        for (int b = 0; b < 2; ++b)
#pragma unroll
            for (int m = 0; m < 4; ++m)
#pragma unroll
                for (int n = 0; n < 2; ++n) acc[a][b][m][n] = (f32x4){0.f, 0.f, 0.f, 0.f};
    bf16x8 At[4][2], B0[2][2], B1[2][2];
    const char* cA = (const char*)g.A + (size_t)cur.pm * tstep; const char* cB = (const char*)g.Bt + (size_t)cur.pn * tstep;
    S.a_ready(cur);
    if constexpr (SP2) {
        PG8_STAGE(PG8_SB(0, 0), cB, voffB); PG8_STAGE(PG8_SB(0, 1), cB + hstep, voffB); PG8_STAGE(PG8_SA(0, 0), cA, voffA); PG8_STAGE(PG8_SA(0, 1), cA + hstep, voffA);
        if (wr == 1) PG8_BAR;
        PG8_WAIT_V(2); PG8_BAR;
        PG8_STAGE(PG8_SB(1, 0), cB + kstep, voffB); PG8_STAGE(PG8_SA(1, 0), cA + kstep, voffA); PG8_STAGE(PG8_SB(1, 1), cB + hstep + kstep, voffB);
        PG8_WAIT_V(6); PG8_BAR;
    } else {
        PG8_STAGE(PG8_SB(0, 0), cB, voffB); PG8_STAGE(PG8_SA(0, 0), cA, voffA); PG8_STAGE(PG8_SB(0, 1), cB + hstep, voffB); PG8_STAGE(PG8_SA(0, 1), cA + hstep, voffA);
        if (wr == 1) PG8_BAR;
        PG8_WAIT_V(4); PG8_BAR;
        PG8_STAGE(PG8_SB(1, 0), cB + kstep, voffB); PG8_STAGE(PG8_SA(1, 0), cA + kstep, voffA); PG8_STAGE(PG8_SB(1, 1), cB + hstep + kstep, voffB);
        PG8_WAIT_V(6); PG8_BAR;
    }
    for (;;) {
        const bool has_next = S.next(ui + 1, nxt);
        const char* nA = has_next ? (const char*)g.A + (size_t)nxt.pm * tstep : cA; const char* nB = has_next ? (const char*)g.Bt + (size_t)nxt.pn * tstep : cB;
        for (int t = 0; t < nt; t += 2) {
            const bool last = (t == nt - 2);
            const char* a1 = cA + (size_t)(t + 1) * kstep;
            const char* a2 = last ? nA : cA + (size_t)(t + 2) * kstep; const char* b2 = last ? nB : cB + (size_t)(t + 2) * kstep;
            const char* a3 = a2 + kstep; const char* b3 = b2 + kstep;
            if (last && has_next) S.a_ready(nxt);
            if constexpr (SP2) {
            PG8_LDB(B0, 0, 0); PG8_LDB(B1, 0, 1); PG8_SCHED; PG8_LDA(At, 0, 0); PG8_STAGE(PG8_SA(1, 1), a1 + hstep, voffA);
            PG8_WAIT_V(8); PG8_WAIT_L(0); PG8_BAR; PG8_MMA(0, 0, At, B0); PG8_MMA(0, 1, At, B1); PG8_BAR; PG8_SCHED;
            PG8_LDA(At, 0, 1); PG8_STAGE(PG8_SB(0, 0), b2, voffB); PG8_STAGE(PG8_SB(0, 1), b2 + hstep, voffB); PG8_STAGE(PG8_SA(0, 0), a2, voffA);
            PG8_WAIT_V(8); PG8_WAIT_L(0); PG8_BAR; PG8_MMA(1, 0, At, B0); PG8_MMA(1, 1, At, B1); PG8_BAR; PG8_SCHED;
            PG8_LDB(B0, 1, 0); PG8_LDB(B1, 1, 1); PG8_SCHED; PG8_LDA(At, 1, 0); PG8_STAGE(PG8_SA(0, 1), a2 + hstep, voffA);
            PG8_WAIT_V(8); PG8_WAIT_L(0); PG8_BAR; PG8_MMA(0, 0, At, B0); PG8_MMA(0, 1, At, B1); PG8_BAR; PG8_SCHED;
            PG8_LDA(At, 1, 1); PG8_STAGE(PG8_SB(1, 0), b3, voffB); PG8_STAGE(PG8_SB(1, 1), b3 + hstep, voffB); PG8_STAGE(PG8_SA(1, 0), a3, voffA);
            PG8_WAIT_V(8); PG8_WAIT_L(0); PG8_BAR; PG8_MMA(1, 0, At, B0); PG8_MMA(1, 1, At, B1); PG8_BAR; PG8_SCHED;
            } else {
            PG8_LDB(B0, 0, 0); PG8_SCHED; PG8_LDA(At, 0, 0); PG8_STAGE(PG8_SA(1, 1), a1 + hstep, voffA);
            PG8_WAIT_L(8); PG8_BAR; PG8_WAIT_L(0); PG8_MMA(0, 0, At, B0); PG8_BAR; PG8_SCHED;
            PG8_LDB(B1, 0, 1); PG8_STAGE(PG8_SB(0, 0), b2, voffB);
            PG8_BAR; PG8_WAIT_L(0); PG8_MMA(0, 1, At, B1); PG8_BAR;
            PG8_LDA(At, 0, 1); PG8_STAGE(PG8_SA(0, 0), a2, voffA);
            PG8_BAR; PG8_WAIT_L(0); PG8_MMA(1, 0, At, B0); PG8_BAR; PG8_SCHED;
            PG8_STAGE(PG8_SB(0, 1), b2 + hstep, voffB);
            PG8_WAIT_V(6); PG8_BAR; PG8_MMA(1, 1, At, B1); PG8_BAR;
            PG8_LDB(B0, 1, 0); PG8_SCHED; PG8_LDA(At, 1, 0); PG8_STAGE(PG8_SA(0, 1), a2 + hstep, voffA);
            PG8_WAIT_L(8); PG8_BAR; PG8_WAIT_L(0); PG8_MMA(0, 0, At, B0); PG8_BAR; PG8_SCHED;
            PG8_LDB(B1, 1, 1); PG8_STAGE(PG8_SB(1, 0), b3, voffB);
            PG8_BAR; PG8_WAIT_L(0); PG8_MMA(0, 1, At, B1); PG8_BAR;
            PG8_LDA(At, 1, 1); PG8_STAGE(PG8_SA(1, 0), a3, voffA);
            PG8_BAR; PG8_WAIT_L(0); PG8_MMA(1, 0, At, B0); PG8_BAR; PG8_SCHED;
            PG8_STAGE(PG8_SB(1, 1), b3 + hstep, voffB);
            PG8_WAIT_V(6); PG8_BAR; PG8_MMA(1, 1, At, B1); PG8_BAR;
            }
        }
        if constexpr (ALIGN_EPI) { if (wr == 0) PG8_BAR; }
        if constexpr (!Epi::AFTER_DRAIN) { E(acc, cur, wr, wc, fr, fq); S.done(cur); }
        if (!has_next) break;
#pragma unroll
        for (int a = 0; a < 2; ++a)
#pragma unroll
            for (int b = 0; b < 2; ++b)
#pragma unroll
                for (int m = 0; m < 4; ++m)
#pragma unroll
                    for (int n = 0; n < 2; ++n) acc[a][b][m][n] = (f32x4){0.f, 0.f, 0.f, 0.f};
        cur = nxt; cA = nA; cB = nB; ++ui;
        if constexpr (ALIGN_EPI) { if (wr == 1) PG8_BAR; }
    }
    PG8_WAIT_V(0);
    if constexpr (!ALIGN_EPI) { if (wr == 0) PG8_BAR; }
    PG8_BAR;
    if constexpr (Epi::AFTER_DRAIN) { E.fused(acc, cur, wr, wc, fr, fq, lds, wid, lane); S.done(cur); }
#undef PG8_SA
#undef PG8_SB
#undef PG8_STAGE
#undef PG8_LDA
#undef PG8_LDB
#undef PG8_MMA
#undef PG8_WAIT_V
#undef PG8_WAIT_L
#undef PG8_BAR
#undef PG8_SCHED
}
}

constexpr int NW = 8;
constexpr int M = 24576, DM = 2048, DFF = 5632, NZ = 2 * DFF, NQKV = 3072, AW = 2048;
constexpr int SEQ_P = 8192, SEQ_S = 4096, ROWS_P = 2 * SEQ_P;
constexpr float EPS = 1e-6f, LOG2E = 1.4426950408889634f;
constexpr size_t MiB = 1u << 20;
constexpr size_t WS_RS = 0;
constexpr size_t WS_BAR = 3 * MiB;
constexpr size_t WS_W = 4 * MiB;
constexpr size_t SZ_AIN = (size_t)4096 * 2048 * 2, SZ_SQ = (size_t)2048 * 2048 * 2, SZ_QKV = (size_t)3072 * 2048 * 2, SZ_FIN = (size_t)NZ * 2048 * 2, SZ_FOUT = (size_t)2048 * DFF * 2;
constexpr size_t WS_AIN = WS_W, WS_AOUT = WS_AIN + 2 * SZ_AIN, WS_BQKV = WS_AOUT + 2 * SZ_SQ, WS_BOUT = WS_BQKV + 2 * SZ_QKV, WS_FIN = WS_BOUT + 2 * SZ_SQ, WS_FOUT = WS_FIN + 4 * SZ_FIN;
constexpr size_t WS_XB = WS_FOUT + 4 * SZ_FOUT;
constexpr size_t SZ_ROWS = (size_t)M * 2048 * 2;
constexpr size_t WS_ACT = WS_XB + SZ_ROWS;
constexpr size_t WS_HZ = WS_ACT + (size_t)M * DFF * 2;
constexpr size_t WS_R = WS_HZ + (size_t)96 * 4 * NZ * 4;
constexpr size_t WS_END = WS_R + 3 * SZ_ROWS;
constexpr size_t R_U = 0, R_VT2 = SZ_ROWS, R_Y = 2 * SZ_ROWS;
constexpr size_t R_Q = 0, R_K = SZ_ROWS, R_VTA = R_K + (size_t)M * 512 * 2, R_O = R_VTA + (size_t)M * 512 * 2;
constexpr int XCH_OFF = 131072, BARST_OFF = 131072 + 8192, LDS_BYTES = 131072 + 8192 + 16;

#define LAS __attribute__((address_space(3)))
typedef unsigned short bf16;
typedef float f32x4 __attribute__((ext_vector_type(4)));
typedef short bf16x8 __attribute__((ext_vector_type(8)));
typedef unsigned u32x4v __attribute__((ext_vector_type(4)));
typedef unsigned u32x2v __attribute__((ext_vector_type(2)));
using pg8::cvt_pk_bf16; using pg8::stat_t; using pg8::stat_fix; using pg8::STAT_INV;
__device__ __forceinline__ float bf_lo(unsigned w) { return __uint_as_float(w << 16); }
__device__ __forceinline__ float bf_hi(unsigned w) { return __uint_as_float(w & 0xffff0000u); }
__device__ __forceinline__ float wave_sum(float v) {
#pragma unroll
    for (int o = 1; o < 64; o <<= 1) v += __shfl_xor(v, o);
    return v;
}

struct Args { const float* in[19]; float* out; unsigned char* ws; int ph_lo, ph_hi, coop, pad; };

__device__ __forceinline__ void transpose_item(const float* W, int K, int N, bf16* WT, const float* gain, LAS float* scr, int item, int lane, bool ffn_perm) {
    const int nblk = N / 64, kb = item / nblk, nb = item % nblk, k0 = 64 * kb, n0 = 64 * nb;
    int d0 = n0; if (ffn_perm) { const int half = n0 >= DFF, cc = n0 - half * DFF; d0 = (cc >> 7) * 256 + half * 128 + (cc & 127); }
    const int lr = lane >> 4, lc = (lane & 15) * 4;
    const float* src = W + (size_t)(k0 + lr) * N + n0 + lc;
    f32x4 v[16];
#pragma unroll
    for (int i = 0; i < 16; ++i) v[i] = __builtin_nontemporal_load((const f32x4*)(src + (size_t)(4 * i) * N));
#pragma unroll
    for (int i = 0; i < 16; ++i) { LAS float* d = scr + (4 * i + lr) * 65 + lc; d[0] = v[i][0]; d[1] = v[i][1]; d[2] = v[i][2]; d[3] = v[i][3]; }
    asm volatile("s_waitcnt lgkmcnt(0)" ::: "memory");
    const int c = lane & 7;
    f32x4 g0 = (f32x4){1.f, 1.f, 1.f, 1.f}, g1 = g0;
    if (gain) { g0 = *(const f32x4*)(gain + k0 + 8 * c); g1 = *(const f32x4*)(gain + k0 + 8 * c + 4); }
#pragma unroll
    for (int j = 0; j < 8; ++j) { const int n = (lane >> 3) + 8 * j; const LAS float* s = scr + (8 * c) * 65 + n;
        u32x4v o; o.x = cvt_pk_bf16(s[0 * 65] * g0[0], s[1 * 65] * g0[1]); o.y = cvt_pk_bf16(s[2 * 65] * g0[2], s[3 * 65] * g0[3]); o.z = cvt_pk_bf16(s[4 * 65] * g1[0], s[5 * 65] * g1[1]); o.w = cvt_pk_bf16(s[6 * 65] * g1[2], s[7 * 65] * g1[3]);
        *(u32x4v*)(WT + (size_t)(d0 + n) * K + k0 + 8 * c) = o; }
    asm volatile("s_waitcnt lgkmcnt(0)" ::: "memory");
}
__device__ __forceinline__ void transpose_matrix(const float* W, int K, int N, bf16* WT, const float* gain, LAS float* scr, int gw, int ngw, int lane, bool ffn_perm = false) {
    const int items = (K / 64) * (N / 64);
    for (int it = gw; it < items; it += ngw) transpose_item(W, K, N, WT, gain, scr, it, lane, ffn_perm);
}
__device__ __forceinline__ void prologue_phase(const Args& a, LAS unsigned char* lds, int tid, int wave, int lane) {
    unsigned char* ws = a.ws;
    const int G = gridDim.x, gw = blockIdx.x * NW + wave, ngw = G * NW;
    { stat_t* z = (stat_t*)(ws + WS_RS) + M; const int n = 10 * M; for (int i = blockIdx.x * 512 + tid; i < n; i += G * 512) z[i] = 0ull; }
    LAS float* scr = (LAS float*)(lds + wave * 16640);
    const float* mixn = a.in[3]; const float* ffnn = a.in[4];
#pragma unroll 1
    for (int j = 0; j < 2; ++j) {
        transpose_matrix(a.in[6] + (size_t)j * 2048 * 4096, 2048, 4096, (bf16*)(ws + WS_AIN + j * SZ_AIN), mixn + (2 * j) * 2048, scr, gw, ngw, lane);
        transpose_matrix(a.in[11] + (size_t)j * 2048 * 2048, 2048, 2048, (bf16*)(ws + WS_AOUT + j * SZ_SQ), nullptr, scr, gw, ngw, lane);
        transpose_matrix(a.in[12] + (size_t)j * 2048 * 3072, 2048, 3072, (bf16*)(ws + WS_BQKV + j * SZ_QKV), mixn + (2 * j + 1) * 2048, scr, gw, ngw, lane);
        transpose_matrix(a.in[14] + (size_t)j * 2048 * 2048, 2048, 2048, (bf16*)(ws + WS_BOUT + j * SZ_SQ), nullptr, scr, gw, ngw, lane);
    }
#pragma unroll 1
    for (int i = 0; i < 4; ++i) {
        transpose_matrix(a.in[15] + (size_t)i * 2048 * NZ, 2048, NZ, (bf16*)(ws + WS_FIN + i * SZ_FIN), ffnn + i * 2048, scr, gw, ngw, lane, true);
        transpose_matrix(a.in[18] + (size_t)i * DFF * 2048, DFF, 2048, (bf16*)(ws + WS_FOUT + i * SZ_FOUT), nullptr, scr, gw, ngw, lane);
    }
    stat_t* rs0 = (stat_t*)(ws + WS_RS); bf16* XB = (bf16*)(ws + WS_XB);
    for (int row = gw; row < M; row += ngw) {
        const float* src = row < ROWS_P ? a.in[0] + (size_t)row * DM : a.in[1] + (size_t)(row - ROWS_P) * DM;
        float ss = 0.f;
#pragma unroll
        for (int j = 0; j < 8; ++j) {
            const f32x4 v = *(const f32x4*)(src + j * 256 + lane * 4);
            u32x2v w; w.x = cvt_pk_bf16(v[0], v[1]); w.y = cvt_pk_bf16(v[2], v[3]);
            const float r0 = bf_lo(w.x), r1 = bf_hi(w.x), r2 = bf_lo(w.y), r3 = bf_hi(w.y);
            ss += (r0 * r0 + r1 * r1) + (r2 * r2 + r3 * r3);
            *(u32x2v*)(XB + (size_t)row * DM + j * 256 + lane * 4) = w;
        }
        ss = wave_sum(ss);
        if (lane == 0) rs0[row] = stat_fix(ss);
    }
}

__device__ __forceinline__ void a2_phase(LAS unsigned char* lds, const float* Wsp, const float* bs, const float* vn, const stat_t* rsv, const bf16* U, const bf16* VT, bf16* Y,
                                         int tid, int wave, int lane) {
    const int fr = lane & 15, fq = lane >> 4;
    const int q4 = (tid & 31) * 4, p0 = tid >> 5;
    const int crow = 8 * (fr >> 2) + (fr & 3);
    for (int unit = blockIdx.x; unit < 192 * 8; unit += gridDim.x) {
        const int g = unit & 7, chunk = unit >> 3, row0 = chunk * 128;
        f32x4 wv[8];
#pragma unroll
        for (int i = 0; i < 8; ++i) wv[i] = *(const f32x4*)(Wsp + (size_t)(g * 128 + p0 + 16 * i) * 128 + q4);
        stat_t sq[4];
#pragma unroll
        for (int k = 0; k < 4; ++k) sq[k] = rsv[row0 + q4 + k];
        bf16x8 vf[2][4];
#pragma unroll
        for (int cf = 0; cf < 2; ++cf)
#pragma unroll
            for (int ks = 0; ks < 4; ++ks) vf[cf][ks] = *(const bf16x8*)(VT + ((size_t)chunk * 2048 + 256 * g + 32 * wave + crow + 4 * cf) * 128 + 32 * ks + 8 * fq);
        const int c0 = 256 * g + 32 * wave + 8 * fq;
        u32x4v uu[8]; float bsv[8];
#pragma unroll
        for (int pf = 0; pf < 8; ++pf) { uu[pf] = *(const u32x4v*)(U + (size_t)(row0 + 16 * pf + fr) * AW + c0); bsv[pf] = bs[g * 128 + 16 * pf + fr]; }
        const f32x4 vn0 = *(const f32x4*)(vn + c0), vn1 = *(const f32x4*)(vn + c0 + 4);
        __syncthreads();
        float rv[4];
#pragma unroll
        for (int k = 0; k < 4; ++k) rv[k] = rsqrtf((float)sq[k] * (STAT_INV / 2048.f) + EPS);
#pragma unroll
        for (int i = 0; i < 8; ++i) {
            u32x2v o; o.x = cvt_pk_bf16(wv[i][0] * rv[0], wv[i][1] * rv[1]); o.y = cvt_pk_bf16(wv[i][2] * rv[2], wv[i][3] * rv[3]);
            *(LAS u32x2v*)(lds + ((p0 + 16 * i) * 136 + q4) * 2) = o;
        }
        __syncthreads();
        f32x4 acc[8][2];
#pragma unroll
        for (int pf = 0; pf < 8; ++pf)
#pragma unroll
            for (int cf = 0; cf < 2; ++cf) acc[pf][cf] = (f32x4){0.f, 0.f, 0.f, 0.f};
#pragma unroll
        for (int pf = 0; pf < 8; ++pf)
#pragma unroll
            for (int ks = 0; ks < 4; ++ks) {
                const bf16x8 wf = *(const LAS bf16x8*)(lds + ((16 * pf + fr) * 136 + 32 * ks + 8 * fq) * 2);
#pragma unroll
                for (int cf = 0; cf < 2; ++cf) acc[pf][cf] = __builtin_amdgcn_mfma_f32_16x16x32_bf16(vf[cf][ks], wf, acc[pf][cf], 0, 0, 0);
            }
#pragma unroll
        for (int pf = 0; pf < 8; ++pf) {
            const float b = bsv[pf]; const f32x4 s0 = acc[pf][0], s1 = acc[pf][1]; const u32x4v u4 = uu[pf];
            u32x4v o;
            o.x = cvt_pk_bf16(bf_lo(u4.x) * (s0[0] * vn0[0] + b), bf_hi(u4.x) * (s0[1] * vn0[1] + b));
            o.y = cvt_pk_bf16(bf_lo(u4.y) * (s0[2] * vn0[2] + b), bf_hi(u4.y) * (s0[3] * vn0[3] + b));
            o.z = cvt_pk_bf16(bf_lo(u4.z) * (s1[0] * vn1[0] + b), bf_hi(u4.z) * (s1[1] * vn1[1] + b));
            o.w = cvt_pk_bf16(bf_lo(u4.w) * (s1[2] * vn1[2] + b), bf_hi(u4.w) * (s1[3] * vn1[3] + b));
            *(u32x4v*)(Y + (size_t)(row0 + 16 * pf + fr) * AW + c0) = o;
        }
    }
}

__device__ __forceinline__ int t5_bucket(int rel) {
    const int n = rel < 0 ? -rel : rel; int b;
    if (n < 8) b = n; else { b = 8 + (n >= 12) + (n >= 16) + (n >= 23) + (n >= 32) + (n >= 46) + (n >= 64) + (n >= 91) + (n >= 128); if (b > 15) b = 15; }
    return b + (rel > 0 ? 16 : 0);
}
constexpr int AT_KS = 0, AT_VS = 34816, AT_TB = 69632;
__device__ __forceinline__ void attn_seq(int row0, int& s0, int& s1) {
    if (row0 < ROWS_P) { s0 = row0 & ~(SEQ_P - 1); s1 = s0 + SEQ_P; } else { s0 = ROWS_P + ((row0 - ROWS_P) & ~(SEQ_S - 1)); s1 = s0 + SEQ_S; }
}
__device__ __forceinline__ void attn_phase(LAS unsigned char* lds, const bf16* Q, const bf16* Kb, const bf16* VT, bf16* O, const float* rel_bias, const float* sink,
                                           int tid, int wave, int lane) {
    constexpr int NU = 192 * 8;
    const int fr = lane & 15, fq = lane >> 4, hh = wave >> 2, wq = wave & 3;
    const int G = gridDim.x;
    LAS float* tb = (LAS float*)(lds + AT_TB);
    const int sr = tid >> 4, scc = (tid & 15) * 8;
    int unit = blockIdx.x;
    if (unit >= NU) return;
    int s0, s1; attn_seq((unit >> 3) * 128, s0, s1);
    int kb = ((unit >> 3) * 128 - 128 >= s0) ? -1 : 0;
    bool ustart = true;
    bf16x8 Qf[2][4]; float l_run[2]; f32x4 Oacc[2][8];
#pragma unroll 1
    while (unit < NU) {
        const int hp = unit & 1, kvh = (unit >> 1) & 3, row0 = (unit >> 3) * 128, h = kvh * 4 + hp * 2 + hh;
        int nunit = unit, nkb = kb + 1;
        if (nkb > 1 || row0 + nkb * 128 >= s1) { nunit = unit + G; nkb = 0; if (nunit < NU) { int t0, t1; attn_seq((nunit >> 3) * 128, t0, t1); nkb = ((nunit >> 3) * 128 - 128 >= t0) ? -1 : 0; } }
        u32x4v kreg[4], vreg[4];
        {   const int kr0 = row0 + kb * 128;
#pragma unroll
            for (int i = 0; i < 4; ++i) { kreg[i] = *(const u32x4v*)(Kb + (size_t)(kr0 + sr + 32 * i) * 512 + kvh * 128 + scc); vreg[i] = *(const u32x4v*)(VT + (size_t)(kvh * 128 + sr + 32 * i) * M + kr0 + scc); } }
        if (ustart) {
#pragma unroll
            for (int qf = 0; qf < 2; ++qf)
#pragma unroll
                for (int ks = 0; ks < 4; ++ks) Qf[qf][ks] = *(const bf16x8*)(Q + (size_t)(row0 + wq * 32 + qf * 16 + fr) * DM + h * 128 + 32 * ks + 8 * fq);
#pragma unroll
            for (int qf = 0; qf < 2; ++qf) { l_run[qf] = (fq == 0) ? 1.0f : 0.0f;
#pragma unroll
                for (int a = 0; a < 8; ++a) Oacc[qf][a] = (f32x4){0.f, 0.f, 0.f, 0.f}; }
        }
        __syncthreads();
#pragma unroll
        for (int i = 0; i < 4; ++i) { *(LAS u32x4v*)(lds + AT_KS + ((sr + 32 * i) * 136 + scc) * 2) = kreg[i]; *(LAS u32x4v*)(lds + AT_VS + ((sr + 32 * i) * 136 + scc) * 2) = vreg[i]; }
        if (ustart) {
#pragma unroll
            for (int i = 0; i < 2; ++i) { const int e = tid + 512 * i, th = e >> 9, rel = (e & 511) - 256, hd = kvh * 4 + hp * 2 + th; const bool in = rel >= -128 && rel <= 128;
                tb[e] = in ? (rel_bias[t5_bucket(rel) * 16 + hd] - sink[hd]) * LOG2E : -INFINITY; }
        }
        __syncthreads();
        {
        const int kt_lo = (kb == -1) ? wq : 0, kt_hi = (kb == 1) ? wq : 3;
        bf16x8 kf[2][4];
#pragma unroll
        for (int t = 0; t < 2; ++t)
#pragma unroll
            for (int ks = 0; ks < 4; ++ks) kf[t][ks] = *(const LAS bf16x8*)(lds + AT_KS + ((32 * kt_lo + 16 * t + fr) * 136 + 32 * ks + 8 * fq) * 2);
#pragma unroll 1
        for (int kt = kt_lo; kt <= kt_hi; ++kt) {
            f32x4 S[2][2];
#pragma unroll
            for (int qf = 0; qf < 2; ++qf)
#pragma unroll
                for (int t = 0; t < 2; ++t) S[qf][t] = (f32x4){0.f, 0.f, 0.f, 0.f};
#pragma unroll
            for (int t = 0; t < 2; ++t)
#pragma unroll
                for (int ks = 0; ks < 4; ++ks)
#pragma unroll
                    for (int qf = 0; qf < 2; ++qf) S[qf][t] = __builtin_amdgcn_mfma_f32_16x16x32_bf16(kf[t][ks], Qf[qf][ks], S[qf][t], 0, 0, 0);
            __builtin_amdgcn_sched_barrier(0);
            const LAS float* tp0 = tb + hh * 512 + (kb * 128 + 32 * kt + 4 * fq - (wq * 32 + fr) + 256);
            float bias[2][8];
#pragma unroll
            for (int qf = 0; qf < 2; ++qf)
#pragma unroll
                for (int t = 0; t < 2; ++t)
#pragma unroll
                    for (int i = 0; i < 4; ++i) bias[qf][4 * t + i] = tp0[16 * t + i - 16 * qf];
            u32x2v vr[4][2], vr2[4][2];
#pragma unroll
            for (int a = 0; a < 4; ++a) {
                vr[a][0] = *(const LAS u32x2v*)(lds + AT_VS + ((16 * a + fr) * 136 + 32 * kt + 4 * fq) * 2);
                vr[a][1] = *(const LAS u32x2v*)(lds + AT_VS + ((16 * a + fr) * 136 + 32 * kt + 16 + 4 * fq) * 2);
            }
            bf16x8 pf[2];
#pragma unroll
            for (int qf = 0; qf < 2; ++qf) {
                float p[8]; float ps = 0.f;
#pragma unroll
                for (int t = 0; t < 2; ++t)
#pragma unroll
                    for (int i = 0; i < 4; ++i) { p[4 * t + i] = __builtin_amdgcn_exp2f(S[qf][t][i] + bias[qf][4 * t + i]); ps += p[4 * t + i]; }
                l_run[qf] += ps;
                u32x4v pw; pw.x = cvt_pk_bf16(p[0], p[1]); pw.y = cvt_pk_bf16(p[2], p[3]); pw.z = cvt_pk_bf16(p[4], p[5]); pw.w = cvt_pk_bf16(p[6], p[7]);
                pf[qf] = __builtin_bit_cast(bf16x8, pw);
            }
            __builtin_amdgcn_sched_barrier(0);
#pragma unroll
            for (int a = 0; a < 4; ++a) {
                vr2[a][0] = *(const LAS u32x2v*)(lds + AT_VS + ((16 * (a + 4) + fr) * 136 + 32 * kt + 4 * fq) * 2);
                vr2[a][1] = *(const LAS u32x2v*)(lds + AT_VS + ((16 * (a + 4) + fr) * 136 + 32 * kt + 16 + 4 * fq) * 2);
            }
#pragma unroll
            for (int a = 0; a < 4; ++a) {
                u32x4v vw; vw.x = vr[a][0].x; vw.y = vr[a][0].y; vw.z = vr[a][1].x; vw.w = vr[a][1].y;
                const bf16x8 vf = __builtin_bit_cast(bf16x8, vw);
#pragma unroll
                for (int qf = 0; qf < 2; ++qf) Oacc[qf][a] = __builtin_amdgcn_mfma_f32_16x16x32_bf16(vf, pf[qf], Oacc[qf][a], 0, 0, 0);
            }
            __builtin_amdgcn_sched_barrier(0);
            if (kt < kt_hi) {
#pragma unroll
                for (int t = 0; t < 2; ++t)
#pragma unroll
                    for (int ks = 0; ks < 4; ++ks) kf[t][ks] = *(const LAS bf16x8*)(lds + AT_KS + ((32 * (kt + 1) + 16 * t + fr) * 136 + 32 * ks + 8 * fq) * 2);
            }
#pragma unroll
            for (int a = 0; a < 4; ++a) {
                u32x4v vw; vw.x = vr2[a][0].x; vw.y = vr2[a][0].y; vw.z = vr2[a][1].x; vw.w = vr2[a][1].y;
                const bf16x8 vf = __builtin_bit_cast(bf16x8, vw);
#pragma unroll
                for (int qf = 0; qf < 2; ++qf) Oacc[qf][a + 4] = __builtin_amdgcn_mfma_f32_16x16x32_bf16(vf, pf[qf], Oacc[qf][a + 4], 0, 0, 0);
            }
        }
        }
        if (nunit != unit) {
#pragma unroll
            for (int qf = 0; qf < 2; ++qf) {
                float lt = l_run[qf]; lt += __shfl_xor(lt, 16); lt += __shfl_xor(lt, 32);
                const float inv = 1.0f / lt;
                bf16* orow = O + (size_t)(row0 + wq * 32 + qf * 16 + fr) * DM + h * 128 + 4 * fq;
#pragma unroll
                for (int a = 0; a < 8; ++a) { const f32x4 o = Oacc[qf][a] * inv; u32x2v w; w.x = cvt_pk_bf16(o[0], o[1]); w.y = cvt_pk_bf16(o[2], o[3]); *(u32x2v*)(orow + 16 * a) = w; }
            }
            if (nunit < NU) attn_seq((nunit >> 3) * 128, s0, s1);
        }
        ustart = (nunit != unit); unit = nunit; kb = nkb;
    }
}

__device__ __forceinline__ bool seq_start(int t) { return t == 0 || t == SEQ_P || t == ROWS_P || t == ROWS_P + SEQ_S || t >= M; }
__device__ __forceinline__ void ffn_fix_phase(const float* HZ, const float* cw, const float* cb, bf16* ACT, int tid) {
    constexpr int NC4 = DFF / 4;
    const int total = 192 * NC4;
    const f32x4 zero4 = (f32x4){0.f, 0.f, 0.f, 0.f};
    for (int it = blockIdx.x * 512 + tid; it < total; it += gridDim.x * 512) {
        const int ri = it / NC4, c4 = it - ri * NC4, pm = ri >> 1, last = ri & 1, t = pm * 256 + last * 255, ch = 4 * c4;
        const int gi = (ch >> 7) * 256 + (ch & 127), ui = gi + 128;
        const float* hp = last ? HZ + (size_t)(pm * 4 + 2) * NZ : (seq_start(t) ? nullptr : HZ + (size_t)(pm * 4 - 1) * NZ);
        const float* hc = HZ + (size_t)(pm * 4 + (last ? 3 : 0)) * NZ;
        const float* hn = last ? (seq_start(t + 1) ? nullptr : HZ + (size_t)(pm * 4 + 4) * NZ) : HZ + (size_t)(pm * 4 + 1) * NZ;
        const f32x4 pg = hp ? *(const f32x4*)(hp + gi) : zero4, pu = hp ? *(const f32x4*)(hp + ui) : zero4;
        const f32x4 cg_ = *(const f32x4*)(hc + gi), cu = *(const f32x4*)(hc + ui);
        const f32x4 ng = hn ? *(const f32x4*)(hn + gi) : zero4, nu = hn ? *(const f32x4*)(hn + ui) : zero4;
        const f32x4 w0g = *(const f32x4*)(cw + ch), w1g = *(const f32x4*)(cw + NZ + ch), w2g = *(const f32x4*)(cw + 2 * NZ + ch), bg = *(const f32x4*)(cb + ch);
        const f32x4 w0u = *(const f32x4*)(cw + DFF + ch), w1u = *(const f32x4*)(cw + NZ + DFF + ch), w2u = *(const f32x4*)(cw + 2 * NZ + DFF + ch), bu = *(const f32x4*)(cb + DFF + ch);
        float o[4];
#pragma unroll
        for (int j = 0; j < 4; ++j) {
            const float g = w0g[j] * pg[j] + w1g[j] * cg_[j] + w2g[j] * ng[j] + bg[j];
            const float u = w0u[j] * pu[j] + w1u[j] * cu[j] + w2u[j] * nu[j] + bu[j];
            o[j] = pg8::silu_f(g) * u;
        }
        u32x2v w; w.x = cvt_pk_bf16(o[0], o[1]); w.y = cvt_pk_bf16(o[2], o[3]);
        *(u32x2v*)(ACT + (size_t)t * DFF + ch) = w;
    }
}

__device__ __forceinline__ void final_phase(const bf16* XB, float* out, const stat_t* rs, const float* gain, int wave, int lane) {
    const int gw = blockIdx.x * NW + wave, ngw = gridDim.x * NW;
    for (int row = gw; row < M; row += ngw) {
        const float r = rsqrtf((float)rs[row] * (STAT_INV / 2048.f) + EPS);
#pragma unroll
        for (int j = 0; j < 8; ++j) {
            const u32x2v w = *(const u32x2v*)(XB + (size_t)row * DM + j * 256 + lane * 4);
            const f32x4 g = *(const f32x4*)(gain + j * 256 + lane * 4);
            f32x4 v; v[0] = bf_lo(w.x) * r * g[0]; v[1] = bf_hi(w.x) * r * g[1]; v[2] = bf_lo(w.y) * r * g[2]; v[3] = bf_hi(w.y) * r * g[3];
            *(f32x4*)(out + (size_t)row * DM + j * 256 + lane * 4) = v;
        }
    }
}

#define XB_TMO      128
#define XB_XCNT(j)  (256  + 64 * (j))
#define XB_XSUB(j)  (1280 + 64 * (j))
#define XB_XGEN(j)  (2304 + 64 * (j))
#define XB_TOP      3328
#define XB_TOPGEN   3392
#define XCD_BAR_WORDS 3456
#define XB_SPIN_CAP (1u << 18)

__device__ __forceinline__ unsigned xb_ld(unsigned* p)              { return __hip_atomic_load(p, __ATOMIC_RELAXED, __HIP_MEMORY_SCOPE_AGENT); }
__device__ __forceinline__ unsigned xb_add(unsigned* p, unsigned v) { return __hip_atomic_fetch_add(p, v, __ATOMIC_RELAXED, __HIP_MEMORY_SCOPE_AGENT); }
__device__ __forceinline__ unsigned xb_xcc_id() { return (unsigned)__builtin_amdgcn_s_getreg((3 << 11) | 20) & 0xFu; }
#define XB_SPIN(cond, bar) do { unsigned _sp = 0; while (cond) { __builtin_amdgcn_s_sleep(1); \
    if ((++_sp & 255u) == 0u) { if (xb_ld(&(bar)[XB_TMO])) break; if (_sp > XB_SPIN_CAP) { atomicAdd(&(bar)[XB_TMO], 1u); break; } } } } while (0)

struct XcdBarrier {
    unsigned* bar; unsigned x;
    volatile LAS unsigned* st;
};

__device__ __forceinline__ XcdBarrier xcd_barrier_post(unsigned* bar, volatile LAS unsigned* st) {
    XcdBarrier b; b.bar = bar; b.x = xb_xcc_id(); b.st = st;
    if (threadIdx.x == 0) (void)xb_add(&bar[XB_XCNT(b.x)], 1u);
    return b;
}
__device__ __forceinline__ void xcd_barrier_complete(unsigned* bar, unsigned x, unsigned& nloc, unsigned& nx) {
    const unsigned G = gridDim.x * gridDim.y * gridDim.z;
    unsigned sum, cnt, mine, sp = 0u;
    for (;;) {
        sum = 0u; cnt = 0u; mine = 0u;
#pragma unroll
        for (unsigned j = 0; j < 16; ++j) { const unsigned c = xb_ld(&bar[XB_XCNT(j)]); sum += c; cnt += (c > 0u) ? 1u : 0u; mine = (j == x) ? c : mine; }
        if (sum == G) break;
        __builtin_amdgcn_s_sleep(1);
        if ((++sp & 255u) == 0u) { if (xb_ld(&bar[XB_TMO])) break; if (sp > XB_SPIN_CAP) { atomicAdd(&bar[XB_TMO], 1u); break; } }
    }
    nloc = mine > 0u ? mine : 1u; nx = cnt > 0u ? cnt : 1u;
}

__device__ __forceinline__ void xcd_barrier(const XcdBarrier& b) {
    asm volatile("s_waitcnt vmcnt(0)" ::: "memory");
    __syncthreads();
    if (threadIdx.x == 0) {
        unsigned* bar = b.bar;
        __builtin_amdgcn_s_waitcnt(0);
        unsigned nloc = b.st[0], nx = b.st[1];
        if (nloc == 0u) { xcd_barrier_complete(bar, b.x, nloc, nx); b.st[0] = nloc; b.st[1] = nx; }
        const unsigned old = xb_add(&bar[XB_XSUB(b.x)], 1u);
        const unsigned gen = old / nloc;
        if (old + 1u == (gen + 1u) * nloc) {
            __builtin_amdgcn_fence(__ATOMIC_RELEASE, "agent");
            asm volatile("s_waitcnt vmcnt(0)" ::: "memory");
            const unsigned og = xb_add(&bar[XB_TOP], 1u);
            const unsigned tg = og / nx;
            if (og + 1u == (tg + 1u) * nx) xb_add(&bar[XB_TOPGEN], 1u);
            else XB_SPIN(xb_ld(&bar[XB_TOPGEN]) == tg, bar);
            __builtin_amdgcn_fence(__ATOMIC_ACQUIRE, "agent");
            xb_add(&bar[XB_XGEN(b.x)], 1u);
            asm volatile("s_waitcnt vmcnt(0)" ::: "memory");
        } else {
            XB_SPIN(xb_ld(&bar[XB_XGEN(b.x)]) == gen, bar);
            __builtin_amdgcn_fence(__ATOMIC_ACQUIRE, "agent");
            asm volatile("s_waitcnt vmcnt(0)" ::: "memory");
        }
    }
    __syncthreads();
}

constexpr int N_PHASES = 26;
__global__ void __launch_bounds__(NW * 64, 2) fwd_kernel(Args a) {
    extern __shared__ __attribute__((aligned(16))) unsigned char lds_raw[];
    LAS unsigned char* lds = (LAS unsigned char*)lds_raw;
    unsigned char* ws = a.ws;
    stat_t* RS = (stat_t*)(ws + WS_RS); stat_t* RSV = RS + 9 * M;
    bf16* XB = (bf16*)(ws + WS_XB); bf16* ACT = (bf16*)(ws + WS_ACT); unsigned char* R = ws + WS_R;
    const int G = gridDim.x;
    if (threadIdx.x < 4) ((LAS unsigned*)(lds + BARST_OFF))[threadIdx.x] = 0u;
    if (a.ph_lo == 0 && blockIdx.x == 0) { unsigned* bw = (unsigned*)(ws + WS_BAR); for (int i = threadIdx.x; i < XCD_BAR_WORDS; i += NW * 64) bw[i] = 0u; }
    __syncthreads();
    XcdBarrier bar; bar.bar = (unsigned*)(ws + WS_BAR); bar.x = 0; bar.st = (volatile LAS unsigned*)(lds + BARST_OFF);
#pragma unroll 1
    for (int ph = a.ph_lo; ph < a.ph_hi; ++ph) {
        int tid_ = threadIdx.x; asm volatile("" : "+v"(tid_));
        const int tid = tid_, lane = tid & 63, wave = __builtin_amdgcn_readfirstlane(tid >> 6);
        int bx_ = blockIdx.x; asm volatile("" : "+s"(bx_)); const int bx = bx_;
        if (ph == 0) prologue_phase(a, lds, tid, wave, lane);
        else if (ph == N_PHASES - 1) final_phase(XB, a.out, RS + 8 * M, a.in[5], wave, lane);
        else {
            const int li = (ph - 1) / 6, sp = (ph - 1) % 6, j = li >> 1; const bool isA = (li & 1) == 0;
            if (sp == 0 && isA) {
                pg8::Gemm g{XB, (const bf16*)(ws + WS_AIN + j * SZ_AIN), M, 4096, 2048}; pg8::StaticOrder S; S.init(M, 4096, G, bx);
                pg8::EpiGeluUV E{RS + (2 * li) * M, a.in[7] + j * 4096, (bf16*)(R + R_U), (bf16*)(R + R_VT2), RSV + j * M};
                pg8::gemm_phase<pg8::EpiGeluUV, pg8::StaticOrder, true, true>(lds, g, S, E);
            } else if (sp == 0) {
                pg8::Gemm g{XB, (const bf16*)(ws + WS_BQKV + j * SZ_QKV), M, NQKV, 2048}; pg8::StaticOrder S; S.init(M, NQKV, G, bx);
                pg8::EpiQKV E{RS + (2 * li) * M, (bf16*)(R + R_Q), (bf16*)(R + R_K), (bf16*)(R + R_VTA), 0.08838834764831845f * LOG2E};
                pg8::gemm_phase<pg8::EpiQKV, pg8::StaticOrder, true, true>(lds, g, S, E);
            } else if (sp == 1 && isA) {
                a2_phase(lds, a.in[9] + (size_t)j * 8 * 128 * 128, a.in[10] + j * 8 * 128, a.in[8] + j * 2048, RSV + j * M, (const bf16*)(R + R_U), (const bf16*)(R + R_VT2), (bf16*)(R + R_Y), tid, wave, lane);
            } else if (sp == 1) {
                attn_phase(lds, (const bf16*)(R + R_Q), (const bf16*)(R + R_K), (const bf16*)(R + R_VTA), (bf16*)(R + R_O), a.in[2], a.in[13] + j * 16, tid, wave, lane);
            } else if (sp == 2 || sp == 5) {
                const bf16* A; const bf16* Bt; int K; stat_t* rsn;
                if (sp == 2) { A = isA ? (const bf16*)(R + R_Y) : (const bf16*)(R + R_O); Bt = isA ? (const bf16*)(ws + WS_AOUT + j * SZ_SQ) : (const bf16*)(ws + WS_BOUT + j * SZ_SQ); K = 2048; rsn = RS + (2 * li + 1) * M; }
                else { A = ACT; Bt = (const bf16*)(ws + WS_FOUT + li * SZ_FOUT); K = DFF; rsn = RS + (2 * li + 2) * M; }
                pg8::Gemm g{A, Bt, M, 2048, K}; pg8::StaticOrder S; S.init(M, 2048, G, bx);
                pg8::EpiResid E{XB, rsn};
                pg8::gemm_phase<pg8::EpiResid, pg8::StaticOrder, true, true>(lds, g, S, E);
            } else if (sp == 3) {
                pg8::Gemm g{XB, (const bf16*)(ws + WS_FIN + li * SZ_FIN), M, NZ, 2048}; pg8::StaticOrder S; S.init(M, NZ, G, bx);
                pg8::EpiConvGate E{RS + (2 * li + 1) * M, a.in[16] + (size_t)li * 3 * NZ, a.in[17] + (size_t)li * NZ, ACT, (float*)(ws + WS_HZ), lds + XCH_OFF};
                pg8::gemm_phase<pg8::EpiConvGate, pg8::StaticOrder, true, true>(lds, g, S, E);
            } else {
                ffn_fix_phase((const float*)(ws + WS_HZ), a.in[16] + (size_t)li * 3 * NZ, a.in[17] + (size_t)li * NZ, ACT, tid);
            }
        }
        if (a.coop && ph + 1 < a.ph_hi) {
            if (ph == 0) { cg::this_grid().sync(); bar = xcd_barrier_post((unsigned*)(ws + WS_BAR), (volatile LAS unsigned*)(lds + BARST_OFF)); }
            else xcd_barrier(bar);
        }
    }
}

extern "C" void kernel_launch(void* const* d_in, const int* in_sizes, int n_in, void* d_out, int out_size, void* d_ws, size_t ws_size, hipStream_t stream) {
    static int grid = 0;
    if (grid == 0) {
        if (n_in != 19 || out_size != M * DM || ws_size < WS_END) { fprintf(stderr, "kernel_launch: unexpected shapes (n_in %d out %d ws %zu need %zu)\n", n_in, out_size, ws_size, (size_t)WS_END); grid = -1; return; }
        int dev = 0, cus = 0, per_cu = 0;
        hipGetDevice(&dev); hipDeviceGetAttribute(&cus, hipDeviceAttributeMultiprocessorCount, dev);
        hipFuncSetAttribute((const void*)fwd_kernel, hipFuncAttributeMaxDynamicSharedMemorySize, LDS_BYTES);
        if (hipOccupancyMaxActiveBlocksPerMultiprocessor(&per_cu, (const void*)fwd_kernel, NW * 64, LDS_BYTES) != hipSuccess || per_cu < 1) { fprintf(stderr, "kernel_launch: occupancy query says %d\n", per_cu); per_cu = 1; }
        (void)hipGetLastError();
        grid = cus > 0 ? cus : 256;
    }
    if (grid < 0) return;
    Args a{};
    for (int i = 0; i < 19; ++i) a.in[i] = (const float*)d_in[i];
    a.out = (float*)d_out; a.ws = (unsigned char*)d_ws; a.pad = 0;
#if MK_COOP
    a.ph_lo = 0; a.ph_hi = N_PHASES; a.coop = 1;
    void* kargs[] = {&a};
    hipError_t e = hipLaunchCooperativeKernel((const void*)fwd_kernel, dim3(grid), dim3(NW * 64), kargs, LDS_BYTES, stream);
    if (e != hipSuccess) fprintf(stderr, "cooperative launch failed: %s (grid %d)\n", hipGetErrorString(e), grid);
#else
    a.coop = 0;
    for (int ph = 0; ph < N_PHASES; ++ph) { a.ph_lo = ph; a.ph_hi = ph + 1; hipLaunchKernelGGL(fwd_kernel, dim3(grid), dim3(NW * 64), LDS_BYTES, stream, a); }
#endif
}
```

```cpp
#include <hip/hip_runtime.h>
#include <hip/hip_cooperative_groups.h>
#include <cstdio>
#include <cstdint>
namespace cg = cooperative_groups;
#ifndef MK_COOP
#define MK_COOP 1
#endif
namespace pg8 {
#define PG8_LAS __attribute__((address_space(3)))
typedef unsigned short bf16_t;
typedef short bf16x8 __attribute__((ext_vector_type(8)));
typedef float f32x4 __attribute__((ext_vector_type(4)));
typedef unsigned u32x4 __attribute__((ext_vector_type(4)));
constexpr int BM = 256, BK = 64, HALF = 128, HTB = HALF * BK * 2  , STAGE_BYTES = 8 * HTB, NXCD = 8, WGM = 4;

__host__ __device__ __forceinline__ int lds_byte(int r, int c) { const int st = (r >> 4) * 2 + (c >> 5), rr = r & 15, cc = c & 31, ob = rr * 64 + cc * 2; return st * 1024 + (ob ^ (((ob >> 9) & 1) << 5)); }
__host__ __device__ __forceinline__ void stage_rc(int b, int& R, int& C) { const int st = b / 1024, sb = b % 1024, swz = sb ^ (((sb >> 9) & 1) << 5); R = (st >> 1) * 16 + swz / 64; C = (st & 1) * 32 + (swz % 64) / 2; }
__host__ __device__ __forceinline__ int perm32(int rho) { const int n = rho >> 4, i = rho & 15; return 8 * (i >> 2) + 4 * n + (i & 3); }

struct Unit { int pm, pn; };
struct Gemm { const bf16_t* A; const bf16_t* Bt; int M, N, K; };

struct StaticOrder {
    int nM, nN, nwg, G, c;
    __host__ __device__ void init(int M, int N, int G_, int c_) { nM = M / BM; nN = N / BM; nwg = nM * nN; G = G_; c = c_; }
    __host__ __device__ bool next(int i, Unit& u) const {
        const long L = (long)i * G + c; if (L >= nwg) return false;
        int wgid = (int)L; { const int q = nwg / NXCD, r = nwg % NXCD, xcd = wgid % NXCD, off = wgid / NXCD; wgid = (xcd < r ? xcd * (q + 1) : r * (q + 1) + (xcd - r) * q) + off; }
        const int nig = WGM * nN, gid = wgid / nig, fm = gid * WGM, gsz = (nM - fm) < WGM ? (nM - fm) : WGM;
        u.pm = fm + ((wgid % nig) % gsz); u.pn = (wgid % nig) / gsz; return true;
    }
    __device__ __forceinline__ void a_ready(const Unit&) const {}
    __device__ __forceinline__ void done(const Unit&) const {}
};

__device__ __forceinline__ unsigned cvt_pk_bf16(float lo, float hi) { unsigned r; asm volatile("v_cvt_pk_bf16_f32 %0, %1, %2" : "=v"(r) : "v"(lo), "v"(hi)); return r; }

constexpr int MROWS = 24576;
constexpr float NORM_EPS = 1e-6f;
typedef unsigned long long stat_t;
constexpr float STAT_SCALE = 16777216.0f, STAT_INV = 1.0f / 16777216.0f;
__device__ __forceinline__ stat_t stat_fix(float ss) { return (stat_t)(ss * STAT_SCALE + 0.5f); }
__device__ __forceinline__ float rstd2048(const stat_t* rs, int row) { return rsqrtf((float)rs[row] * (STAT_INV / 2048.0f) + NORM_EPS); }
__device__ __forceinline__ float gelu_tanh(float x) {
    const float t = x * (1.5957691216057308f + 0.07135481627f * x * x);
    const float e = __builtin_amdgcn_exp2f(-1.4426950408889634f * t);
    return x * __builtin_amdgcn_rcpf(1.0f + e);
}
__device__ __forceinline__ bf16_t f2bf_rne(float f) { return (bf16_t)(cvt_pk_bf16(f, 0.f) & 0xffffu); }

struct EpiGeluUV {
    static constexpr bool PERM = true, AFTER_DRAIN = false, APERM = true, I8 = false;
    const stat_t* rs; const float* bias; bf16_t* U; bf16_t* VT; stat_t* rsv;
    __device__ __forceinline__ void operator()(const f32x4 (&acc)[2][2][4][2], const Unit& u, int wr, int wc, int fr_, int fq_) const {
        int fr = fr_, fq = fq_; asm volatile("" : "+v"(fr), "+v"(fq));
        typedef unsigned u32x2v __attribute__((ext_vector_type(2)));
        const int rowb = u.pm * BM + wr * 64 + 4 * fr, colt = u.pn * BM, cl = wc * 32 + 8 * fq;
        f32x4 bv[2][2];
#pragma unroll
        for (int bj = 0; bj < 2; ++bj)
#pragma unroll
            for (int n = 0; n < 2; ++n) bv[bj][n] = *(const f32x4*)(bias + colt + bj * HALF + cl + 4 * n);
        const bool isV = u.pn >= 8;
        float rr[2][4];
#pragma unroll
        for (int ai = 0; ai < 2; ++ai)
#pragma unroll
            for (int m = 0; m < 4; ++m) rr[ai][m] = rstd2048(rs, rowb + ai * HALF + m);
#pragma unroll
        for (int ai = 0; ai < 2; ++ai) {
            float ss[4] = {0.f, 0.f, 0.f, 0.f};
#pragma unroll
            for (int bj = 0; bj < 2; ++bj) {
                float v[4][8];
#pragma unroll
                for (int m = 0; m < 4; ++m)
#pragma unroll
                    for (int n = 0; n < 2; ++n)
#pragma unroll
                        for (int j = 0; j < 4; ++j) v[m][4 * n + j] = gelu_tanh(acc[ai][bj][m][n][j] * rr[ai][m] + bv[bj][n][j]);
                if (!isV) {
#pragma unroll
                    for (int m = 0; m < 4; ++m) {
                        u32x4 w; w.x = cvt_pk_bf16(v[m][0], v[m][1]); w.y = cvt_pk_bf16(v[m][2], v[m][3]); w.z = cvt_pk_bf16(v[m][4], v[m][5]); w.w = cvt_pk_bf16(v[m][6], v[m][7]);
                        *(u32x4*)(U + (size_t)(rowb + ai * HALF + m) * 2048 + colt + bj * HALF + cl) = w; }
                } else {
                    const int c0 = colt - 2048 + bj * HALF + cl, row = rowb + ai * HALF;
                    bf16_t* vp = VT + ((size_t)(row >> 7) * 2048 + c0) * 128 + (row & 127);
#pragma unroll
                    for (int j = 0; j < 8; ++j) {
                        u32x2v w; w.x = cvt_pk_bf16(v[0][j], v[1][j]); w.y = cvt_pk_bf16(v[2][j], v[3][j]);
                        *(u32x2v*)(vp + (size_t)j * 128) = w;
#pragma unroll
                        for (int m = 0; m < 4; ++m) ss[m] += v[m][j] * v[m][j];
                    }
                }
            }
            if (isV) {
#pragma unroll
                for (int m = 0; m < 4; ++m) { float s = ss[m]; s += __shfl_xor(s, 16); s += __shfl_xor(s, 32); if (fq == 0) atomicAdd(rsv + rowb + ai * HALF + m, stat_fix(s)); }
            }
        }
    }
};
struct EpiResid {
    static constexpr bool PERM = true, AFTER_DRAIN = false, APERM = false, I8 = false;
    bf16_t* XB; stat_t* rs_next;
    __device__ __forceinline__ void operator()(const f32x4 (&acc)[2][2][4][2], const Unit& u, int wr, int wc, int fr, int fq) const {
        const int row0 = u.pm * BM + wr * 64 + fr, col0 = u.pn * BM + wc * 32 + 8 * fq;
        u32x4 xv[2][4][2];
#pragma unroll
        for (int ai = 0; ai < 2; ++ai)
#pragma unroll
            for (int m = 0; m < 4; ++m)
#pragma unroll
                for (int bj = 0; bj < 2; ++bj) xv[ai][m][bj] = *(const u32x4*)(XB + (size_t)(row0 + ai * HALF + m * 16) * 2048 + col0 + bj * HALF);
#pragma unroll
        for (int ai = 0; ai < 2; ++ai)
#pragma unroll
            for (int m = 0; m < 4; ++m) {
                const int row = row0 + ai * HALF + m * 16; bf16_t* p = XB + (size_t)row * 2048 + col0; float ss = 0.f;
#pragma unroll
                for (int bj = 0; bj < 2; ++bj) {
                    u32x4 w;
#pragma unroll
                    for (int k = 0; k < 4; ++k) {
                        const float lo = __uint_as_float(xv[ai][m][bj][k] << 16) + acc[ai][bj][m][k >> 1][(k & 1) * 2], hi = __uint_as_float(xv[ai][m][bj][k] & 0xffff0000u) + acc[ai][bj][m][k >> 1][(k & 1) * 2 + 1];
                        const unsigned pk = cvt_pk_bf16(lo, hi); w[k] = pk;
                        const float rl = __uint_as_float(pk << 16), rh = __uint_as_float(pk & 0xffff0000u);
                        ss += rl * rl + rh * rh;
                    }
                    *(u32x4*)(p + bj * HALF) = w;
                }
                ss += __shfl_xor(ss, 16); ss += __shfl_xor(ss, 32); if (fq == 0) atomicAdd(rs_next + row, stat_fix(ss));
            }
    }
};
struct EpiQKV {
    static constexpr bool PERM = true, AFTER_DRAIN = false, APERM = true, I8 = false;
    const stat_t* rs; bf16_t* Q; bf16_t* Kb; bf16_t* VT; float qscale;
    __device__ __forceinline__ void operator()(const f32x4 (&acc)[2][2][4][2], const Unit& u, int wr, int wc, int fr_, int fq_) const {
        int fr = fr_, fq = fq_; asm volatile("" : "+v"(fr), "+v"(fq));
        typedef unsigned u32x2v __attribute__((ext_vector_type(2)));
        const int rowb = u.pm * BM + wr * 64 + 4 * fr, colt = u.pn * BM, cl = wc * 32 + 8 * fq;
        const bool isq = u.pn < 8;
        const unsigned long long ob = (unsigned long long)(isq ? Q : Kb);
        bf16_t* obase = (bf16_t*)(((unsigned long long)(unsigned)__builtin_amdgcn_readfirstlane((int)(ob >> 32)) << 32) | (unsigned)__builtin_amdgcn_readfirstlane((int)ob));
        const int oldc = isq ? 2048 : 512, ocol = isq ? colt : colt - 2048;
        float rr[2][4];
#pragma unroll
        for (int ai = 0; ai < 2; ++ai)
#pragma unroll
            for (int m = 0; m < 4; ++m) { rr[ai][m] = rstd2048(rs, rowb + ai * HALF + m); if (isq) rr[ai][m] *= qscale; }
#pragma unroll
        for (int ai = 0; ai < 2; ++ai)
#pragma unroll
            for (int bj = 0; bj < 2; ++bj) {
                if (u.pn < 10) {
#pragma unroll
                    for (int m = 0; m < 4; ++m) {
                        const f32x4 v0 = acc[ai][bj][m][0] * rr[ai][m], v1 = acc[ai][bj][m][1] * rr[ai][m]; const int row = rowb + ai * HALF + m;
                        u32x4 w; w.x = cvt_pk_bf16(v0[0], v0[1]); w.y = cvt_pk_bf16(v0[2], v0[3]); w.z = cvt_pk_bf16(v1[0], v1[1]); w.w = cvt_pk_bf16(v1[2], v1[3]);
                        *(u32x4*)(obase + (size_t)row * oldc + ocol + bj * HALF + cl) = w; }
                } else {
                    bf16_t* vp = VT + (size_t)(colt - 2560 + bj * HALF + cl) * MROWS + rowb + ai * HALF;
#pragma unroll
                    for (int n = 0; n < 2; ++n)
#pragma unroll
                        for (int j = 0; j < 4; ++j) {
                            u32x2v w; w.x = cvt_pk_bf16(acc[ai][bj][0][n][j] * rr[ai][0], acc[ai][bj][1][n][j] * rr[ai][1]); w.y = cvt_pk_bf16(acc[ai][bj][2][n][j] * rr[ai][2], acc[ai][bj][3][n][j] * rr[ai][3]);
                            *(u32x2v*)(vp + (size_t)(4 * n + j) * MROWS) = w; }
                }
            }
    }
};
__device__ __forceinline__ float dpp_shr1(float old, float v) { return __builtin_bit_cast(float, __builtin_amdgcn_update_dpp(__builtin_bit_cast(int, old), __builtin_bit_cast(int, v), 0x111, 0xf, 0xf, false)); }
__device__ __forceinline__ float dpp_shl1(float old, float v) { return __builtin_bit_cast(float, __builtin_amdgcn_update_dpp(__builtin_bit_cast(int, old), __builtin_bit_cast(int, v), 0x101, 0xf, 0xf, false)); }
__device__ __forceinline__ float fma_s(float a, float b, float c) { float d; asm("v_fma_f32 %0, %1, %2, %3" : "=v"(d) : "v"(a), "v"(b), "v"(c)); return d; }
__device__ __forceinline__ float silu_f(float g) { return g * __builtin_amdgcn_rcpf(1.0f + __builtin_amdgcn_exp2f(-1.4426950408889634f * g)); }
struct EpiConvGate {
    static constexpr bool PERM = true, AFTER_DRAIN = false, APERM = true, I8 = true;
    static constexpr int DFF_ = 5632, NZ_ = 11264;
    const stat_t* rs; const float* cw; const float* cb; bf16_t* ACT; float* HZ; PG8_LAS unsigned char* xch; const float* sx; const float* sw;
    __device__ __forceinline__ void operator()(const f32x4 (&acc)[2][2][4][2], const Unit& u, int wr, int wc, int fr_, int fq_) const {
        typedef unsigned u32x2v __attribute__((ext_vector_type(2)));
        int fr = fr_, fq = fq_; asm volatile("" : "+v"(fr), "+v"(fq));
        f32x4 z[2][2][4][2];
        const int rowb = u.pm * BM + wr * 64 + 4 * fr;
        f32x4 swv[2][2];
#pragma unroll
        for (int bj = 0; bj < 2; ++bj)
#pragma unroll
            for (int n = 0; n < 2; ++n) swv[bj][n] = *(const f32x4*)(sw + u.pn * BM + bj * HALF + wc * 32 + 8 * fq + 4 * n);
#pragma unroll
        for (int ai = 0; ai < 2; ++ai)
#pragma unroll
            for (int m = 0; m < 4; ++m) { const float r = rstd2048(rs, rowb + ai * HALF + m) * sx[rowb + ai * HALF + m];
#pragma unroll
                for (int bj = 0; bj < 2; ++bj)
#pragma unroll
                    for (int n = 0; n < 2; ++n) { typedef int i32x4 __attribute__((ext_vector_type(4)));
                        z[ai][bj][m][n] = __builtin_convertvector(__builtin_bit_cast(i32x4, acc[ai][bj][m][n]), f32x4) * (swv[bj][n] * r); } }
        PG8_LAS f32x4* X4 = (PG8_LAS f32x4*)xch;
#define XIDX(wr_, ai_, fl_) ((((((wr_) * 4 + wc) * 2 + (ai_)) * 2 + (fl_)) * 4 + fq) * 4)
#pragma unroll
        for (int ai = 0; ai < 2; ++ai) {
            if (fr == 0) {
#pragma unroll
                for (int bj = 0; bj < 2; ++bj)
#pragma unroll
                    for (int n = 0; n < 2; ++n) X4[XIDX(wr, ai, 0) + bj * 2 + n] = z[ai][bj][0][n]; }
            if (fr == 15) {
#pragma unroll
                for (int bj = 0; bj < 2; ++bj)
#pragma unroll
                    for (int n = 0; n < 2; ++n) X4[XIDX(wr, ai, 1) + bj * 2 + n] = z[ai][bj][3][n]; }
        }
        {   const int hcol = u.pn * BM + wc * 32 + 8 * fq;
            if (wr == 0 && fr == 0) {
#pragma unroll
                for (int m = 0; m < 2; ++m)
#pragma unroll
                    for (int bj = 0; bj < 2; ++bj)
#pragma unroll
                        for (int n = 0; n < 2; ++n) *(f32x4*)(HZ + (size_t)(u.pm * 4 + m) * NZ_ + hcol + bj * HALF + 4 * n) = z[0][bj][m][n]; }
            if (wr == 1 && fr == 15) {
#pragma unroll
                for (int m = 2; m < 4; ++m)
#pragma unroll
                    for (int bj = 0; bj < 2; ++bj)
#pragma unroll
                        for (int n = 0; n < 2; ++n) *(f32x4*)(HZ + (size_t)(u.pm * 4 + m) * NZ_ + hcol + bj * HALF + 4 * n) = z[1][bj][m][n]; }
        }
        asm volatile("s_waitcnt lgkmcnt(0)" ::: "memory"); __builtin_amdgcn_s_barrier(); asm volatile("" ::: "memory");
        const int ch0 = u.pn * HALF + wc * 32 + 8 * fq;
        const f32x4 zero4 = (f32x4){0.f, 0.f, 0.f, 0.f};
#pragma unroll
        for (int ai = 0; ai < 2; ++ai) {
            unsigned ow[4][4];
#pragma unroll
            for (int n = 0; n < 2; ++n) {
                const int ch = ch0 + 4 * n;
                const f32x4 w0g = *(const f32x4*)(cw + ch), w1g = *(const f32x4*)(cw + NZ_ + ch), w2g = *(const f32x4*)(cw + 2 * NZ_ + ch), bg = *(const f32x4*)(cb + ch);
                const f32x4 w0u = *(const f32x4*)(cw + DFF_ + ch), w1u = *(const f32x4*)(cw + NZ_ + DFF_ + ch), w2u = *(const f32x4*)(cw + 2 * NZ_ + DFF_ + ch), bu = *(const f32x4*)(cb + DFF_ + ch);
                f32x4 pBg = zero4, pBu = zero4, nBg = zero4, nBu = zero4;
                if (wr == 1) { pBg = X4[XIDX(0, ai, 1) + n]; pBu = X4[XIDX(0, ai, 1) + 2 + n]; }
                else if (ai == 1) { pBg = X4[XIDX(1, 0, 1) + n]; pBu = X4[XIDX(1, 0, 1) + 2 + n]; }
                if (wr == 0) { nBg = X4[XIDX(1, ai, 0) + n]; nBu = X4[XIDX(1, ai, 0) + 2 + n]; }
                else if (ai == 0) { nBg = X4[XIDX(0, 1, 0) + n]; nBu = X4[XIDX(0, 1, 0) + 2 + n]; }
                float o[4][4];
#pragma unroll
                for (int h = 0; h < 2; ++h) {
                    typedef float f32x2 __attribute__((ext_vector_type(2)));
#define PAIR(v) (h == 0 ? __builtin_shufflevector(v, v, 0, 1) : __builtin_shufflevector(v, v, 2, 3))
                    const f32x2 g0 = PAIR(z[ai][0][0][n]), g1 = PAIR(z[ai][0][1][n]), g2 = PAIR(z[ai][0][2][n]), g3 = PAIR(z[ai][0][3][n]);
                    const f32x2 u0 = PAIR(z[ai][1][0][n]), u1 = PAIR(z[ai][1][1][n]), u2 = PAIR(z[ai][1][2][n]), u3 = PAIR(z[ai][1][3][n]);
                    const f32x2 pBg2 = PAIR(pBg), nBg2 = PAIR(nBg), pBu2 = PAIR(pBu), nBu2 = PAIR(nBu);
                    f32x2 pg, ng, pu, nu;
                    pg.x = dpp_shr1(pBg2.x, g3.x); pg.y = dpp_shr1(pBg2.y, g3.y); ng.x = dpp_shl1(nBg2.x, g0.x); ng.y = dpp_shl1(nBg2.y, g0.y);
                    pu.x = dpp_shr1(pBu2.x, u3.x); pu.y = dpp_shr1(pBu2.y, u3.y); nu.x = dpp_shl1(nBu2.x, u0.x); nu.y = dpp_shl1(nBu2.y, u0.y);
                    const f32x2 A0 = PAIR(w0g), A1 = PAIR(w1g), A2 = PAIR(w2g), AB = PAIR(bg), C0 = PAIR(w0u), C1 = PAIR(w1u), C2 = PAIR(w2u), CB = PAIR(bu);
                    f32x2 G[4], U[4];
                    G[0] = A0 * pg + (A1 * g0 + (A2 * g1 + AB)); G[1] = A0 * g0 + (A1 * g1 + (A2 * g2 + AB)); G[2] = A0 * g1 + (A1 * g2 + (A2 * g3 + AB)); G[3] = A0 * g2 + (A1 * g3 + (A2 * ng + AB));
                    U[0] = C0 * pu + (C1 * u0 + (C2 * u1 + CB)); U[1] = C0 * u0 + (C1 * u1 + (C2 * u2 + CB)); U[2] = C0 * u1 + (C1 * u2 + (C2 * u3 + CB)); U[3] = C0 * u2 + (C1 * u3 + (C2 * nu + CB));
#pragma unroll
                    for (int m = 0; m < 4; ++m) {
                        const f32x2 t = G[m] * (-1.4426950408889634f);
                        f32x2 e; e.x = __builtin_amdgcn_exp2f(t.x); e.y = __builtin_amdgcn_exp2f(t.y);
                        const f32x2 d = e + 1.0f;
                        f32x2 r; r.x = __builtin_amdgcn_rcpf(d.x); r.y = __builtin_amdgcn_rcpf(d.y);
                        const f32x2 q = (G[m] * U[m]) * r;
                        o[m][2 * h] = q.x; o[m][2 * h + 1] = q.y;
                    }
#undef PAIR
                }
#pragma unroll
                for (int m = 0; m < 4; ++m) { ow[m][2 * n] = cvt_pk_bf16(o[m][0], o[m][1]); ow[m][2 * n + 1] = cvt_pk_bf16(o[m][2], o[m][3]); }
            }
#pragma unroll
            for (int m = 0; m < 4; ++m) { u32x4 w; w.x = ow[m][0]; w.y = ow[m][1]; w.z = ow[m][2]; w.w = ow[m][3];
                *(u32x4*)(ACT + (size_t)(rowb + ai * HALF + m) * DFF_ + ch0) = w; }
            asm volatile("" ::: "memory");
        }
#undef XIDX
    }
};

template <bool I8> __device__ __forceinline__ f32x4 mma16(bf16x8 b, bf16x8 a, f32x4 c) {
    if constexpr (I8) { typedef int i32x4 __attribute__((ext_vector_type(4)));
        return __builtin_bit_cast(f32x4, __builtin_amdgcn_mfma_i32_16x16x64_i8(__builtin_bit_cast(i32x4, b), __builtin_bit_cast(i32x4, a), __builtin_bit_cast(i32x4, c), 0, 0, 0)); }
    else return __builtin_amdgcn_mfma_f32_16x16x32_bf16(b, a, c, 0, 0, 0);
}
template <class Epi, class Sched, bool ALIGN_EPI = false, bool SP2 = false>
__device__ __forceinline__ void gemm_phase(PG8_LAS unsigned char* lds, const Gemm g, const Sched& S, const Epi& E) {
    int tid_ = threadIdx.x; asm volatile("" : "+v"(tid_)); const int tid = tid_, wid = __builtin_amdgcn_readfirstlane(tid >> 6), lane = tid & 63, wr = wid >> 2, wc = wid & 3, fr = lane & 15, fq = lane >> 4;
    const int K = g.K, nt = K / BK;
    unsigned voffA[2], voffB[2];
#pragma unroll
    for (int i = 0; i < 2; ++i) { int R, C; stage_rc(tid * 16 + i * 8192, R, C); const int Rb = Epi::PERM ? ((R & ~31) + perm32(R & 31)) : R;
        const int Ra = Epi::APERM ? ((R & ~63) + ((R & 15) << 2) + ((R >> 4) & 3)) : R;
        voffA[i] = (unsigned)(Ra * K + C) * 2u; voffB[i] = (unsigned)(Rb * K + C) * 2u; }
    const size_t kstep = (size_t)(BK * 2);
    const size_t hstep = (size_t)HALF * K * 2;
    const size_t tstep = 2 * hstep;
    const unsigned ldsw = (unsigned)wid * 1024u;
    const int aoff = lds_byte(wr * 64 + fr, fq * 8), boff = lds_byte(wc * 32 + fr, fq * 8);
#define PG8_SA(b, h) (((b) * 2 + (h)) * HTB)
#define PG8_SB(b, h) ((4 + (b) * 2 + (h)) * HTB)
#define PG8_STAGE(bufoff, gbase, voff) do { _Pragma("unroll") for (int _i = 0; _i < 2; ++_i) \
        __builtin_amdgcn_global_load_lds((const unsigned*)((const char*)(gbase) + (voff)[_i]), (PG8_LAS unsigned*)(lds + (bufoff) + ldsw + _i * 8192), 16, 0, 0); } while (0)
#define PG8_LDA(dst, b, h) do { _Pragma("unroll") for (int m = 0; m < 4; ++m) _Pragma("unroll") for (int k = 0; k < 2; ++k) dst[m][k] = *(const PG8_LAS bf16x8*)(lds + PG8_SA(b, h) + aoff + m * 2048 + k * 1024); } while (0)
#define PG8_LDB(dst, b, h) do { _Pragma("unroll") for (int n = 0; n < 2; ++n) _Pragma("unroll") for (int k = 0; k < 2; ++k) dst[n][k] = *(const PG8_LAS bf16x8*)(lds + PG8_SB(b, h) + boff + n * 2048 + k * 1024); } while (0)
#define PG8_MMA(ai, bj, At, Bt) do { __builtin_amdgcn_s_setprio(1); _Pragma("unroll") for (int m = 0; m < 4; ++m) _Pragma("unroll") for (int n = 0; n < 2; ++n) _Pragma("unroll") for (int k = 0; k < 2; ++k) \
        acc[ai][bj][m][n] = mma16<Epi::I8>(Bt[n][k], At[m][k], acc[ai][bj][m][n]); __builtin_amdgcn_s_setprio(0); } while (0)
#define PG8_WAIT_V(n) asm volatile("s_waitcnt vmcnt(" #n ")" ::: "memory")
#define PG8_WAIT_L(n) asm volatile("s_waitcnt lgkmcnt(" #n ")" ::: "memory")
#define PG8_BAR __builtin_amdgcn_s_barrier()
#define PG8_SCHED __builtin_amdgcn_sched_barrier(0)
    Unit cur, nxt; int ui = 0;
    if (!S.next(0, cur)) return;
    f32x4 acc[2][2][4][2];
#pragma unroll
    for (int a = 0; a < 2; ++a)
#pragma unroll
        for (int b = 0; b < 2; ++b)
#pragma unroll
            for (int m = 0; m < 4; ++m)
#pragma unroll
                for (int n = 0; n < 2; ++n) acc[a][b][m][n] = (f32x4){0.f, 0.f, 0.f, 0.f};
    bf16x8 At[4][2], B0[2][2], B1[2][2];
    const char* cA = (const char*)g.A + (size_t)cur.pm * tstep; const char* cB = (const char*)g.Bt + (size_t)cur.pn * tstep;
    S.a_ready(cur);
    if constexpr (SP2) {
        PG8_STAGE(PG8_SB(0, 0), cB, voffB); PG8_STAGE(PG8_SB(0, 1), cB + hstep, voffB); PG8_STAGE(PG8_SA(0, 0), cA, voffA); PG8_STAGE(PG8_SA(0, 1), cA + hstep, voffA);
        if (wr == 1) PG8_BAR;
        PG8_WAIT_V(2); PG8_BAR;
        PG8_STAGE(PG8_SB(1, 0), cB + kstep, voffB); PG8_STAGE(PG8_SA(1, 0), cA + kstep, voffA); PG8_STAGE(PG8_SB(1, 1), cB + hstep + kstep, voffB);
        PG8_WAIT_V(6); PG8_BAR;
    } else {
        PG8_STAGE(PG8_SB(0, 0), cB, voffB); PG8_STAGE(PG8_SA(0, 0), cA, voffA); PG8_STAGE(PG8_SB(0, 1), cB + hstep, voffB); PG8_STAGE(PG8_SA(0, 1), cA + hstep, voffA);
        if (wr == 1) PG8_BAR;
        PG8_WAIT_V(4); PG8_BAR;
        PG8_STAGE(PG8_SB(1, 0), cB + kstep, voffB); PG8_STAGE(PG8_SA(1, 0), cA + kstep, voffA); PG8_STAGE(PG8_SB(1, 1), cB + hstep + kstep, voffB);
        PG8_WAIT_V(6); PG8_BAR;
    }
    for (;;) {
        const bool has_next = S.next(ui + 1, nxt);
        const char* nA = has_next ? (const char*)g.A + (size_t)nxt.pm * tstep : cA; const char* nB = has_next ? (const char*)g.Bt + (size_t)nxt.pn * tstep : cB;
        for (int t = 0; t < nt; t += 2) {
            const bool last = (t == nt - 2);
            const char* a1 = cA + (size_t)(t + 1) * kstep;
            const char* a2 = last ? nA : cA + (size_t)(t + 2) * kstep; const char* b2 = last ? nB : cB + (size_t)(t + 2) * kstep;
            const char* a3 = a2 + kstep; const char* b3 = b2 + kstep;
            if (last && has_next) S.a_ready(nxt);
            if constexpr (SP2) {
            PG8_LDB(B0, 0, 0); PG8_LDB(B1, 0, 1); PG8_SCHED; PG8_LDA(At, 0, 0); PG8_STAGE(PG8_SA(1, 1), a1 + hstep, voffA);
            PG8_WAIT_V(8); PG8_WAIT_L(0); PG8_BAR; PG8_MMA(0, 0, At, B0); PG8_MMA(0, 1, At, B1); PG8_BAR; PG8_SCHED;
            PG8_LDA(At, 0, 1); PG8_STAGE(PG8_SB(0, 0), b2, voffB); PG8_STAGE(PG8_SB(0, 1), b2 + hstep, voffB); PG8_STAGE(PG8_SA(0, 0), a2, voffA);
            PG8_WAIT_V(8); PG8_WAIT_L(0); PG8_BAR; PG8_MMA(1, 0, At, B0); PG8_MMA(1, 1, At, B1); PG8_BAR; PG8_SCHED;
            PG8_LDB(B0, 1, 0); PG8_LDB(B1, 1, 1); PG8_SCHED; PG8_LDA(At, 1, 0); PG8_STAGE(PG8_SA(0, 1), a2 + hstep, voffA);
            PG8_WAIT_V(8); PG8_WAIT_L(0); PG8_BAR; PG8_MMA(0, 0, At, B0); PG8_MMA(0, 1, At, B1); PG8_BAR; PG8_SCHED;
            PG8_LDA(At, 1, 1); PG8_STAGE(PG8_SB(1, 0), b3, voffB); PG8_STAGE(PG8_SB(1, 1), b3 + hstep, voffB); PG8_STAGE(PG8_SA(1, 0), a3, voffA);
            PG8_WAIT_V(8); PG8_WAIT_L(0); PG8_BAR; PG8_MMA(1, 0, At, B0); PG8_MMA(1, 1, At, B1); PG8_BAR; PG8_SCHED;
            } else {
            PG8_LDB(B0, 0, 0); PG8_SCHED; PG8_LDA(At, 0, 0); PG8_STAGE(PG8_SA(1, 1), a1 + hstep, voffA);
            PG8_WAIT_L(8); PG8_BAR; PG8_WAIT_L(0); PG8_MMA(0, 0, At, B0); PG8_BAR; PG8_SCHED;
            PG8_LDB(B1, 0, 1); PG8_STAGE(PG8_SB(0, 0), b2, voffB);
            PG8_BAR; PG8_WAIT_L(0); PG8_MMA(0, 1, At, B1); PG8_BAR;
            PG8_LDA(At, 0, 1); PG8_STAGE(PG8_SA(0, 0), a2, voffA);
            PG8_BAR; PG8_WAIT_L(0); PG8_MMA(1, 0, At, B0); PG8_BAR; PG8_SCHED;
            PG8_STAGE(PG8_SB(0, 1), b2 + hstep, voffB);
            PG8_WAIT_V(6); PG8_BAR; PG8_MMA(1, 1, At, B1); PG8_BAR;
            PG8_LDB(B0, 1, 0); PG8_SCHED; PG8_LDA(At, 1, 0); PG8_STAGE(PG8_SA(0, 1), a2 + hstep, voffA);
            PG8_WAIT_L(8); PG8_BAR; PG8_WAIT_L(0); PG8_MMA(0, 0, At, B0); PG8_BAR; PG8_SCHED;
            PG8_LDB(B1, 1, 1); PG8_STAGE(PG8_SB(1, 0), b3, voffB);
            PG8_BAR; PG8_WAIT_L(0); PG8_MMA(0, 1, At, B1); PG8_BAR;
            PG8_LDA(At, 1, 1); PG8_STAGE(PG8_SA(1, 0), a3, voffA);
            PG8_BAR; PG8_WAIT_L(0); PG8_MMA(1, 0, At, B0); PG8_BAR; PG8_SCHED;
            PG8_STAGE(PG8_SB(1, 1), b3 + hstep, voffB);
            PG8_WAIT_V(6); PG8_BAR; PG8_MMA(1, 1, At, B1); PG8_BAR;
            }
        }
        if constexpr (ALIGN_EPI) { if (wr == 0) PG8_BAR; }
        if constexpr (!Epi::AFTER_DRAIN) { E(acc, cur, wr, wc, fr, fq); S.done(cur); }
        if (!has_next) break;
#pragma unroll
        for (int a = 0; a < 2; ++a)
#pragma unroll
            for (int b = 0; b < 2; ++b)
#pragma unroll
                for (int m = 0; m < 4; ++m)
#pragma unroll
                    for (int n = 0; n < 2; ++n) acc[a][b][m][n] = (f32x4){0.f, 0.f, 0.f, 0.f};
        cur = nxt; cA = nA; cB = nB; ++ui;
        if constexpr (ALIGN_EPI) { if (wr == 1) PG8_BAR; }
    }
    PG8_WAIT_V(0);
    if constexpr (!ALIGN_EPI) { if (wr == 0) PG8_BAR; }
    PG8_BAR;
    if constexpr (Epi::AFTER_DRAIN) { E.fused(acc, cur, wr, wc, fr, fq, lds, wid, lane); S.done(cur); }
#undef PG8_SA
#undef PG8_SB
#undef PG8_STAGE
#undef PG8_LDA
#undef PG8_LDB
#undef PG8_MMA
#undef PG8_WAIT_V
#undef PG8_WAIT_L
#undef PG8_BAR
#undef PG8_SCHED
}
}

constexpr int NW = 8;
constexpr int M = 24576, DM = 2048, DFF = 5632, NZ = 2 * DFF, NQKV = 3072, AW = 2048;
constexpr int SEQ_P = 8192, SEQ_S = 4096, ROWS_P = 2 * SEQ_P;
constexpr float EPS = 1e-6f, LOG2E = 1.4426950408889634f;
constexpr size_t MiB = 1u << 20;
constexpr size_t WS_RS = 0;
constexpr size_t WS_BAR = 3 * MiB;
constexpr size_t WS_W = 4 * MiB;
constexpr size_t SZ_AIN = (size_t)4096 * 2048 * 2, SZ_SQ = (size_t)2048 * 2048 * 2, SZ_QKV = (size_t)3072 * 2048 * 2, SZ_FIN = (size_t)NZ * 2048 * 2, SZ_FOUT = (size_t)2048 * DFF * 2;
constexpr size_t WS_AIN = WS_W, WS_AOUT = WS_AIN + 2 * SZ_AIN, WS_BQKV = WS_AOUT + 2 * SZ_SQ, WS_BOUT = WS_BQKV + 2 * SZ_QKV, WS_FIN = WS_BOUT + 2 * SZ_SQ, WS_FOUT = WS_FIN + 4 * SZ_FIN;
constexpr size_t WS_XB = WS_FOUT + 4 * SZ_FOUT;
constexpr size_t SZ_ROWS = (size_t)M * 2048 * 2;
constexpr size_t WS_ACT = WS_XB + SZ_ROWS;
constexpr size_t WS_HZ = WS_ACT + (size_t)M * DFF * 2;
constexpr size_t WS_R = WS_HZ + (size_t)96 * 4 * NZ * 4;
constexpr size_t WS_XQ = WS_R + 3 * SZ_ROWS;
constexpr size_t WS_FINQ = WS_XQ + (size_t)M * 2048;
constexpr size_t WS_END = WS_FINQ + (size_t)4 * NZ * 2048;
constexpr size_t WS_SX = 3 * MiB + 131072, WS_SW = 3 * MiB + 262144;
constexpr size_t R_U = 0, R_VT2 = SZ_ROWS, R_Y = 2 * SZ_ROWS;
constexpr size_t R_Q = 0, R_K = SZ_ROWS, R_VTA = R_K + (size_t)M * 512 * 2, R_O = R_VTA + (size_t)M * 512 * 2;
constexpr int XCH_OFF = 131072, BARST_OFF = 131072 + 8192, LDS_BYTES = 131072 + 8192 + 16;

#define LAS __attribute__((address_space(3)))
typedef unsigned short bf16;
typedef float f32x4 __attribute__((ext_vector_type(4)));
typedef short bf16x8 __attribute__((ext_vector_type(8)));
typedef unsigned u32x4v __attribute__((ext_vector_type(4)));
typedef unsigned u32x2v __attribute__((ext_vector_type(2)));
using pg8::cvt_pk_bf16; using pg8::stat_t; using pg8::stat_fix; using pg8::STAT_INV;
__device__ __forceinline__ float bf_lo(unsigned w) { return __uint_as_float(w << 16); }
__device__ __forceinline__ float bf_hi(unsigned w) { return __uint_as_float(w & 0xffff0000u); }
__device__ __forceinline__ float wave_sum(float v) {
#pragma unroll
    for (int o = 1; o < 64; o <<= 1) v += __shfl_xor(v, o);
    return v;
}

struct Args { const float* in[19]; float* out; unsigned char* ws; int ph_lo, ph_hi, coop, pad; };

__device__ __forceinline__ void transpose_item(const float* W, int K, int N, bf16* WT, const float* gain, LAS float* scr, int item, int lane, bool ffn_perm) {
    const int nblk = N / 64, kb = item / nblk, nb = item % nblk, k0 = 64 * kb, n0 = 64 * nb;
    int d0 = n0; if (ffn_perm) { const int half = n0 >= DFF, cc = n0 - half * DFF; d0 = (cc >> 7) * 256 + half * 128 + (cc & 127); }
    const int lr = lane >> 4, lc = (lane & 15) * 4;
    const float* src = W + (size_t)(k0 + lr) * N + n0 + lc;
    f32x4 v[16];
#pragma unroll
    for (int i = 0; i < 16; ++i) v[i] = __builtin_nontemporal_load((const f32x4*)(src + (size_t)(4 * i) * N));
#pragma unroll
    for (int i = 0; i < 16; ++i) { LAS float* d = scr + (4 * i + lr) * 65 + lc; d[0] = v[i][0]; d[1] = v[i][1]; d[2] = v[i][2]; d[3] = v[i][3]; }
    asm volatile("s_waitcnt lgkmcnt(0)" ::: "memory");
    const int c = lane & 7;
    f32x4 g0 = (f32x4){1.f, 1.f, 1.f, 1.f}, g1 = g0;
    if (gain) { g0 = *(const f32x4*)(gain + k0 + 8 * c); g1 = *(const f32x4*)(gain + k0 + 8 * c + 4); }
#pragma unroll
    for (int j = 0; j < 8; ++j) { const int n = (lane >> 3) + 8 * j; const LAS float* s = scr + (8 * c) * 65 + n;
        u32x4v o; o.x = cvt_pk_bf16(s[0 * 65] * g0[0], s[1 * 65] * g0[1]); o.y = cvt_pk_bf16(s[2 * 65] * g0[2], s[3 * 65] * g0[3]); o.z = cvt_pk_bf16(s[4 * 65] * g1[0], s[5 * 65] * g1[1]); o.w = cvt_pk_bf16(s[6 * 65] * g1[2], s[7 * 65] * g1[3]);
        *(u32x4v*)(WT + (size_t)(d0 + n) * K + k0 + 8 * c) = o; }
    asm volatile("s_waitcnt lgkmcnt(0)" ::: "memory");
}
__device__ __forceinline__ void transpose_matrix(const float* W, int K, int N, bf16* WT, const float* gain, LAS float* scr, int gw, int ngw, int lane, bool ffn_perm = false) {
    const int items = (K / 64) * (N / 64);
    for (int it = gw; it < items; it += ngw) transpose_item(W, K, N, WT, gain, scr, it, lane, ffn_perm);
}
__device__ __forceinline__ void prologue_phase(const Args& a, LAS unsigned char* lds, int tid, int wave, int lane) {
    unsigned char* ws = a.ws;
    const int G = gridDim.x, gw = blockIdx.x * NW + wave, ngw = G * NW;
    { stat_t* z = (stat_t*)(ws + WS_RS) + M; const int n = 10 * M; for (int i = blockIdx.x * 512 + tid; i < n; i += G * 512) z[i] = 0ull; }
    LAS float* scr = (LAS float*)(lds + wave * 16640);
    const float* mixn = a.in[3]; const float* ffnn = a.in[4];
#pragma unroll 1
    for (int j = 0; j < 2; ++j) {
        transpose_matrix(a.in[6] + (size_t)j * 2048 * 4096, 2048, 4096, (bf16*)(ws + WS_AIN + j * SZ_AIN), mixn + (2 * j) * 2048, scr, gw, ngw, lane);
        transpose_matrix(a.in[11] + (size_t)j * 2048 * 2048, 2048, 2048, (bf16*)(ws + WS_AOUT + j * SZ_SQ), nullptr, scr, gw, ngw, lane);
        transpose_matrix(a.in[12] + (size_t)j * 2048 * 3072, 2048, 3072, (bf16*)(ws + WS_BQKV + j * SZ_QKV), mixn + (2 * j + 1) * 2048, scr, gw, ngw, lane);
        transpose_matrix(a.in[14] + (size_t)j * 2048 * 2048, 2048, 2048, (bf16*)(ws + WS_BOUT + j * SZ_SQ), nullptr, scr, gw, ngw, lane);
    }
#pragma unroll 1
    for (int i = 0; i < 4; ++i) {
        transpose_matrix(a.in[15] + (size_t)i * 2048 * NZ, 2048, NZ, (bf16*)(ws + WS_FIN + i * SZ_FIN), ffnn + i * 2048, scr, gw, ngw, lane, true);
        transpose_matrix(a.in[18] + (size_t)i * DFF * 2048, DFF, 2048, (bf16*)(ws + WS_FOUT + i * SZ_FOUT), nullptr, scr, gw, ngw, lane);
    }
    stat_t* rs0 = (stat_t*)(ws + WS_RS); bf16* XB = (bf16*)(ws + WS_XB);
    for (int row = gw; row < M; row += ngw) {
        const float* src = row < ROWS_P ? a.in[0] + (size_t)row * DM : a.in[1] + (size_t)(row - ROWS_P) * DM;
        float ss = 0.f;
#pragma unroll
        for (int j = 0; j < 8; ++j) {
            const f32x4 v = *(const f32x4*)(src + j * 256 + lane * 4);
            u32x2v w; w.x = cvt_pk_bf16(v[0], v[1]); w.y = cvt_pk_bf16(v[2], v[3]);
            const float r0 = bf_lo(w.x), r1 = bf_hi(w.x), r2 = bf_lo(w.y), r3 = bf_hi(w.y);
            ss += (r0 * r0 + r1 * r1) + (r2 * r2 + r3 * r3);
            *(u32x2v*)(XB + (size_t)row * DM + j * 256 + lane * 4) = w;
        }
        ss = wave_sum(ss);
        if (lane == 0) rs0[row] = stat_fix(ss);
    }
}

__device__ __forceinline__ void a2_phase(LAS unsigned char* lds, const float* Wsp, const float* bs, const float* vn, const stat_t* rsv, const bf16* U, const bf16* VT, bf16* Y,
                                         int tid, int wave, int lane) {
    const int fr = lane & 15, fq = lane >> 4;
    const int q4 = (tid & 31) * 4, p0 = tid >> 5;
    const int crow = 8 * (fr >> 2) + (fr & 3);
    for (int unit = blockIdx.x; unit < 192 * 8; unit += gridDim.x) {
        const int g = unit & 7, chunk = unit >> 3, row0 = chunk * 128;
        f32x4 wv[8];
#pragma unroll
        for (int i = 0; i < 8; ++i) wv[i] = *(const f32x4*)(Wsp + (size_t)(g * 128 + p0 + 16 * i) * 128 + q4);
        stat_t sq[4];
#pragma unroll
        for (int k = 0; k < 4; ++k) sq[k] = rsv[row0 + q4 + k];
        bf16x8 vf[2][4];
#pragma unroll
        for (int cf = 0; cf < 2; ++cf)
#pragma unroll
            for (int ks = 0; ks < 4; ++ks) vf[cf][ks] = *(const bf16x8*)(VT + ((size_t)chunk * 2048 + 256 * g + 32 * wave + crow + 4 * cf) * 128 + 32 * ks + 8 * fq);
        const int c0 = 256 * g + 32 * wave + 8 * fq;
        u32x4v uu[8]; float bsv[8];
#pragma unroll
        for (int pf = 0; pf < 8; ++pf) { uu[pf] = *(const u32x4v*)(U + (size_t)(row0 + 16 * pf + fr) * AW + c0); bsv[pf] = bs[g * 128 + 16 * pf + fr]; }
        const f32x4 vn0 = *(const f32x4*)(vn + c0), vn1 = *(const f32x4*)(vn + c0 + 4);
        __syncthreads();
        float rv[4];
#pragma unroll
        for (int k = 0; k < 4; ++k) rv[k] = rsqrtf((float)sq[k] * (STAT_INV / 2048.f) + EPS);
#pragma unroll
        for (int i = 0; i < 8; ++i) {
            u32x2v o; o.x = cvt_pk_bf16(wv[i][0] * rv[0], wv[i][1] * rv[1]); o.y = cvt_pk_bf16(wv[i][2] * rv[2], wv[i][3] * rv[3]);
            *(LAS u32x2v*)(lds + ((p0 + 16 * i) * 136 + q4) * 2) = o;
        }
        __syncthreads();
        f32x4 acc[8][2];
#pragma unroll
        for (int pf = 0; pf < 8; ++pf)
#pragma unroll
            for (int cf = 0; cf < 2; ++cf) acc[pf][cf] = (f32x4){0.f, 0.f, 0.f, 0.f};
#pragma unroll
        for (int pf = 0; pf < 8; ++pf)
#pragma unroll
            for (int ks = 0; ks < 4; ++ks) {
                const bf16x8 wf = *(const LAS bf16x8*)(lds + ((16 * pf + fr) * 136 + 32 * ks + 8 * fq) * 2);
#pragma unroll
                for (int cf = 0; cf < 2; ++cf) acc[pf][cf] = __builtin_amdgcn_mfma_f32_16x16x32_bf16(vf[cf][ks], wf, acc[pf][cf], 0, 0, 0);
            }
#pragma unroll
        for (int pf = 0; pf < 8; ++pf) {
            const float b = bsv[pf]; const f32x4 s0 = acc[pf][0], s1 = acc[pf][1]; const u32x4v u4 = uu[pf];
            u32x4v o;
            o.x = cvt_pk_bf16(bf_lo(u4.x) * (s0[0] * vn0[0] + b), bf_hi(u4.x) * (s0[1] * vn0[1] + b));
            o.y = cvt_pk_bf16(bf_lo(u4.y) * (s0[2] * vn0[2] + b), bf_hi(u4.y) * (s0[3] * vn0[3] + b));
            o.z = cvt_pk_bf16(bf_lo(u4.z) * (s1[0] * vn1[0] + b), bf_hi(u4.z) * (s1[1] * vn1[1] + b));
            o.w = cvt_pk_bf16(bf_lo(u4.w) * (s1[2] * vn1[2] + b), bf_hi(u4.w) * (s1[3] * vn1[3] + b));
            *(u32x4v*)(Y + (size_t)(row0 + 16 * pf + fr) * AW + c0) = o;
        }
    }
}

__device__ __forceinline__ int t5_bucket(int rel) {
    const int n = rel < 0 ? -rel : rel; int b;
    if (n < 8) b = n; else { b = 8 + (n >= 12) + (n >= 16) + (n >= 23) + (n >= 32) + (n >= 46) + (n >= 64) + (n >= 91) + (n >= 128); if (b > 15) b = 15; }
    return b + (rel > 0 ? 16 : 0);
}
constexpr int AT_KS = 0, AT_VS = 34816, AT_TB = 69632;
__device__ __forceinline__ void attn_seq(int row0, int& s0, int& s1) {
    if (row0 < ROWS_P) { s0 = row0 & ~(SEQ_P - 1); s1 = s0 + SEQ_P; } else { s0 = ROWS_P + ((row0 - ROWS_P) & ~(SEQ_S - 1)); s1 = s0 + SEQ_S; }
}
__device__ __forceinline__ void attn_phase(LAS unsigned char* lds, const bf16* Q, const bf16* Kb, const bf16* VT, bf16* O, const float* rel_bias, const float* sink,
                                           int tid, int wave, int lane) {
    constexpr int NU = 192 * 8;
    const int fr = lane & 15, fq = lane >> 4, hh = wave >> 2, wq = wave & 3;
    const int G = gridDim.x;
    LAS float* tb = (LAS float*)(lds + AT_TB);
    const int sr = tid >> 4, scc = (tid & 15) * 8;
    int unit = blockIdx.x;
    if (unit >= NU) return;
    int s0, s1; attn_seq((unit >> 3) * 128, s0, s1);
    int kb = ((unit >> 3) * 128 - 128 >= s0) ? -1 : 0;
    bool ustart = true;
    bf16x8 Qf[2][4]; float l_run[2]; f32x4 Oacc[2][8];
#pragma unroll 1
    while (unit < NU) {
        const int hp = unit & 1, kvh = (unit >> 1) & 3, row0 = (unit >> 3) * 128, h = kvh * 4 + hp * 2 + hh;
        int nunit = unit, nkb = kb + 1;
        if (nkb > 1 || row0 + nkb * 128 >= s1) { nunit = unit + G; nkb = 0; if (nunit < NU) { int t0, t1; attn_seq((nunit >> 3) * 128, t0, t1); nkb = ((nunit >> 3) * 128 - 128 >= t0) ? -1 : 0; } }
        u32x4v kreg[4], vreg[4];
        {   const int kr0 = row0 + kb * 128;
#pragma unroll
            for (int i = 0; i < 4; ++i) { kreg[i] = *(const u32x4v*)(Kb + (size_t)(kr0 + sr + 32 * i) * 512 + kvh * 128 + scc); vreg[i] = *(const u32x4v*)(VT + (size_t)(kvh * 128 + sr + 32 * i) * M + kr0 + scc); } }
        if (ustart) {
#pragma unroll
            for (int qf = 0; qf < 2; ++qf)
#pragma unroll
                for (int ks = 0; ks < 4; ++ks) Qf[qf][ks] = *(const bf16x8*)(Q + (size_t)(row0 + wq * 32 + qf * 16 + fr) * DM + h * 128 + 32 * ks + 8 * fq);
#pragma unroll
            for (int qf = 0; qf < 2; ++qf) { l_run[qf] = (fq == 0) ? 1.0f : 0.0f;
#pragma unroll
                for (int a = 0; a < 8; ++a) Oacc[qf][a] = (f32x4){0.f, 0.f, 0.f, 0.f}; }
        }
        __syncthreads();
#pragma unroll
        for (int i = 0; i < 4; ++i) { *(LAS u32x4v*)(lds + AT_KS + ((sr + 32 * i) * 136 + scc) * 2) = kreg[i]; *(LAS u32x4v*)(lds + AT_VS + ((sr + 32 * i) * 136 + scc) * 2) = vreg[i]; }
        if (ustart) {
#pragma unroll
            for (int i = 0; i < 2; ++i) { const int e = tid + 512 * i, th = e >> 9, rel = (e & 511) - 256, hd = kvh * 4 + hp * 2 + th; const bool in = rel >= -128 && rel <= 128;
                tb[e] = in ? (rel_bias[t5_bucket(rel) * 16 + hd] - sink[hd]) * LOG2E : -INFINITY; }
        }
        __syncthreads();
        {
        const int kt_lo = (kb == -1) ? wq : 0, kt_hi = (kb == 1) ? wq : 3;
        bf16x8 kf[2][4];
#pragma unroll
        for (int t = 0; t < 2; ++t)
#pragma unroll
            for (int ks = 0; ks < 4; ++ks) kf[t][ks] = *(const LAS bf16x8*)(lds + AT_KS + ((32 * kt_lo + 16 * t + fr) * 136 + 32 * ks + 8 * fq) * 2);
#pragma unroll 1
        for (int kt = kt_lo; kt <= kt_hi; ++kt) {
            f32x4 S[2][2];
#pragma unroll
            for (int qf = 0; qf < 2; ++qf)
#pragma unroll
                for (int t = 0; t < 2; ++t) S[qf][t] = (f32x4){0.f, 0.f, 0.f, 0.f};
#pragma unroll
            for (int t = 0; t < 2; ++t)
#pragma unroll
                for (int ks = 0; ks < 4; ++ks)
#pragma unroll
                    for (int qf = 0; qf < 2; ++qf) S[qf][t] = __builtin_amdgcn_mfma_f32_16x16x32_bf16(kf[t][ks], Qf[qf][ks], S[qf][t], 0, 0, 0);
            __builtin_amdgcn_sched_barrier(0);
            const LAS float* tp0 = tb + hh * 512 + (kb * 128 + 32 * kt + 4 * fq - (wq * 32 + fr) + 256);
            float bias[2][8];
#pragma unroll
            for (int qf = 0; qf < 2; ++qf)
#pragma unroll
                for (int t = 0; t < 2; ++t)
#pragma unroll
                    for (int i = 0; i < 4; ++i) bias[qf][4 * t + i] = tp0[16 * t + i - 16 * qf];
            u32x2v vr[4][2], vr2[4][2];
#pragma unroll
            for (int a = 0; a < 4; ++a) {
                vr[a][0] = *(const LAS u32x2v*)(lds + AT_VS + ((16 * a + fr) * 136 + 32 * kt + 4 * fq) * 2);
                vr[a][1] = *(const LAS u32x2v*)(lds + AT_VS + ((16 * a + fr) * 136 + 32 * kt + 16 + 4 * fq) * 2);
            }
            bf16x8 pf[2];
#pragma unroll
            for (int qf = 0; qf < 2; ++qf) {
                float p[8]; float ps = 0.f;
#pragma unroll
                for (int t = 0; t < 2; ++t)
#pragma unroll
                    for (int i = 0; i < 4; ++i) { p[4 * t + i] = __builtin_amdgcn_exp2f(S[qf][t][i] + bias[qf][4 * t + i]); ps += p[4 * t + i]; }
                l_run[qf] += ps;
                u32x4v pw; pw.x = cvt_pk_bf16(p[0], p[1]); pw.y = cvt_pk_bf16(p[2], p[3]); pw.z = cvt_pk_bf16(p[4], p[5]); pw.w = cvt_pk_bf16(p[6], p[7]);
                pf[qf] = __builtin_bit_cast(bf16x8, pw);
            }
            __builtin_amdgcn_sched_barrier(0);
#pragma unroll
            for (int a = 0; a < 4; ++a) {
                vr2[a][0] = *(const LAS u32x2v*)(lds + AT_VS + ((16 * (a + 4) + fr) * 136 + 32 * kt + 4 * fq) * 2);
                vr2[a][1] = *(const LAS u32x2v*)(lds + AT_VS + ((16 * (a + 4) + fr) * 136 + 32 * kt + 16 + 4 * fq) * 2);
            }
#pragma unroll
            for (int a = 0; a < 4; ++a) {
                u32x4v vw; vw.x = vr[a][0].x; vw.y = vr[a][0].y; vw.z = vr[a][1].x; vw.w = vr[a][1].y;
                const bf16x8 vf = __builtin_bit_cast(bf16x8, vw);
#pragma unroll
                for (int qf = 0; qf < 2; ++qf) Oacc[qf][a] = __builtin_amdgcn_mfma_f32_16x16x32_bf16(vf, pf[qf], Oacc[qf][a], 0, 0, 0);
            }
            __builtin_amdgcn_sched_barrier(0);
            if (kt < kt_hi) {
#pragma unroll
                for (int t = 0; t < 2; ++t)
#pragma unroll
                    for (int ks = 0; ks < 4; ++ks) kf[t][ks] = *(const LAS bf16x8*)(lds + AT_KS + ((32 * (kt + 1) + 16 * t + fr) * 136 + 32 * ks + 8 * fq) * 2);
            }
#pragma unroll
            for (int a = 0; a < 4; ++a) {
                u32x4v vw; vw.x = vr2[a][0].x; vw.y = vr2[a][0].y; vw.z = vr2[a][1].x; vw.w = vr2[a][1].y;
                const bf16x8 vf = __builtin_bit_cast(bf16x8, vw);
#pragma unroll
                for (int qf = 0; qf < 2; ++qf) Oacc[qf][a + 4] = __builtin_amdgcn_mfma_f32_16x16x32_bf16(vf, pf[qf], Oacc[qf][a + 4], 0, 0, 0);
            }
        }
        }
        if (nunit != unit) {
#pragma unroll
            for (int qf = 0; qf < 2; ++qf) {
                float lt = l_run[qf]; lt += __shfl_xor(lt, 16); lt += __shfl_xor(lt, 32);
                const float inv = 1.0f / lt;
                bf16* orow = O + (size_t)(row0 + wq * 32 + qf * 16 + fr) * DM + h * 128 + 4 * fq;
#pragma unroll
                for (int a = 0; a < 8; ++a) { const f32x4 o = Oacc[qf][a] * inv; u32x2v w; w.x = cvt_pk_bf16(o[0], o[1]); w.y = cvt_pk_bf16(o[2], o[3]); *(u32x2v*)(orow + 16 * a) = w; }
            }
            if (nunit < NU) attn_seq((nunit >> 3) * 128, s0, s1);
        }
        ustart = (nunit != unit); unit = nunit; kb = nkb;
    }
}

__device__ __forceinline__ bool seq_start(int t) { return t == 0 || t == SEQ_P || t == ROWS_P || t == ROWS_P + SEQ_S || t >= M; }
__device__ __forceinline__ void ffn_fix_phase(const float* HZ, const float* cw, const float* cb, bf16* ACT, int tid) {
    constexpr int NC4 = DFF / 4;
    const int total = 192 * NC4;
    const f32x4 zero4 = (f32x4){0.f, 0.f, 0.f, 0.f};
    for (int it = blockIdx.x * 512 + tid; it < total; it += gridDim.x * 512) {
        const int ri = it / NC4, c4 = it - ri * NC4, pm = ri >> 1, last = ri & 1, t = pm * 256 + last * 255, ch = 4 * c4;
        const int gi = (ch >> 7) * 256 + (ch & 127), ui = gi + 128;
        const float* hp = last ? HZ + (size_t)(pm * 4 + 2) * NZ : (seq_start(t) ? nullptr : HZ + (size_t)(pm * 4 - 1) * NZ);
        const float* hc = HZ + (size_t)(pm * 4 + (last ? 3 : 0)) * NZ;
        const float* hn = last ? (seq_start(t + 1) ? nullptr : HZ + (size_t)(pm * 4 + 4) * NZ) : HZ + (size_t)(pm * 4 + 1) * NZ;
        const f32x4 pg = hp ? *(const f32x4*)(hp + gi) : zero4, pu = hp ? *(const f32x4*)(hp + ui) : zero4;
        const f32x4 cg_ = *(const f32x4*)(hc + gi), cu = *(const f32x4*)(hc + ui);
        const f32x4 ng = hn ? *(const f32x4*)(hn + gi) : zero4, nu = hn ? *(const f32x4*)(hn + ui) : zero4;
        const f32x4 w0g = *(const f32x4*)(cw + ch), w1g = *(const f32x4*)(cw + NZ + ch), w2g = *(const f32x4*)(cw + 2 * NZ + ch), bg = *(const f32x4*)(cb + ch);
        const f32x4 w0u = *(const f32x4*)(cw + DFF + ch), w1u = *(const f32x4*)(cw + NZ + DFF + ch), w2u = *(const f32x4*)(cw + 2 * NZ + DFF + ch), bu = *(const f32x4*)(cb + DFF + ch);
        float o[4];
#pragma unroll
        for (int j = 0; j < 4; ++j) {
            const float g = w0g[j] * pg[j] + w1g[j] * cg_[j] + w2g[j] * ng[j] + bg[j];
            const float u = w0u[j] * pu[j] + w1u[j] * cu[j] + w2u[j] * nu[j] + bu[j];
            o[j] = pg8::silu_f(g) * u;
        }
        u32x2v w; w.x = cvt_pk_bf16(o[0], o[1]); w.y = cvt_pk_bf16(o[2], o[3]);
        *(u32x2v*)(ACT + (size_t)t * DFF + ch) = w;
    }
}

__device__ __forceinline__ void quant_rows_phase(const bf16* src, unsigned char* dst, float* scale, int R, int wave, int lane) {
    const int gw = blockIdx.x * NW + wave, ngw = gridDim.x * NW;
    for (int row = gw; row < R; row += ngw) {
        const u32x4v* p = (const u32x4v*)(src + (size_t)row * 2048 + lane * 32);
        u32x4v v[4];
#pragma unroll
        for (int i = 0; i < 4; ++i) v[i] = p[i];
        float f[32]; float mx = 0.f;
#pragma unroll
        for (int i = 0; i < 4; ++i)
#pragma unroll
            for (int k = 0; k < 4; ++k) { f[8 * i + 2 * k] = bf_lo(v[i][k]); f[8 * i + 2 * k + 1] = bf_hi(v[i][k]); mx = fmaxf(mx, fmaxf(fabsf(f[8 * i + 2 * k]), fabsf(f[8 * i + 2 * k + 1]))); }
#pragma unroll
        for (int o = 1; o < 64; o <<= 1) mx = fmaxf(mx, __shfl_xor(mx, o));
        const float inv = mx > 0.f ? 127.0f / mx : 0.f;
        if (lane == 0) scale[row] = mx * (1.0f / 127.0f);
        u32x4v o[2];
#pragma unroll
        for (int d = 0; d < 8; ++d) {
            const int q0 = (int)__builtin_rintf(f[4 * d] * inv), q1 = (int)__builtin_rintf(f[4 * d + 1] * inv), q2 = (int)__builtin_rintf(f[4 * d + 2] * inv), q3 = (int)__builtin_rintf(f[4 * d + 3] * inv);
            o[d >> 2][d & 3] = (unsigned)(q0 & 255) | ((unsigned)(q1 & 255) << 8) | ((unsigned)(q2 & 255) << 16) | ((unsigned)q3 << 24);
        }
        u32x4v* q = (u32x4v*)(dst + (size_t)row * 2048 + lane * 32);
        q[0] = o[0]; q[1] = o[1];
    }
}

__device__ __forceinline__ void final_phase(const bf16* XB, float* out, const stat_t* rs, const float* gain, int wave, int lane) {
    const int gw = blockIdx.x * NW + wave, ngw = gridDim.x * NW;
    for (int row = gw; row < M; row += ngw) {
        const float r = rsqrtf((float)rs[row] * (STAT_INV / 2048.f) + EPS);
#pragma unroll
        for (int j = 0; j < 8; ++j) {
            const u32x2v w = *(const u32x2v*)(XB + (size_t)row * DM + j * 256 + lane * 4);
            const f32x4 g = *(const f32x4*)(gain + j * 256 + lane * 4);
            f32x4 v; v[0] = bf_lo(w.x) * r * g[0]; v[1] = bf_hi(w.x) * r * g[1]; v[2] = bf_lo(w.y) * r * g[2]; v[3] = bf_hi(w.y) * r * g[3];
            *(f32x4*)(out + (size_t)row * DM + j * 256 + lane * 4) = v;
        }
    }
}

#define XB_TMO      128
#define XB_XCNT(j)  (256  + 64 * (j))
#define XB_XSUB(j)  (1280 + 64 * (j))
#define XB_XGEN(j)  (2304 + 64 * (j))
#define XB_TOP      3328
#define XB_TOPGEN   3392
#define XCD_BAR_WORDS 3456
#define XB_SPIN_CAP (1u << 18)

__device__ __forceinline__ unsigned xb_ld(unsigned* p)              { return __hip_atomic_load(p, __ATOMIC_RELAXED, __HIP_MEMORY_SCOPE_AGENT); }
__device__ __forceinline__ unsigned xb_add(unsigned* p, unsigned v) { return __hip_atomic_fetch_add(p, v, __ATOMIC_RELAXED, __HIP_MEMORY_SCOPE_AGENT); }
__device__ __forceinline__ unsigned xb_xcc_id() { return (unsigned)__builtin_amdgcn_s_getreg((3 << 11) | 20) & 0xFu; }
#define XB_SPIN(cond, bar) do { unsigned _sp = 0; while (cond) { __builtin_amdgcn_s_sleep(1); \
    if ((++_sp & 255u) == 0u) { if (xb_ld(&(bar)[XB_TMO])) break; if (_sp > XB_SPIN_CAP) { atomicAdd(&(bar)[XB_TMO], 1u); break; } } } } while (0)

struct XcdBarrier {
    unsigned* bar; unsigned x;
    volatile LAS unsigned* st;
};

__device__ __forceinline__ XcdBarrier xcd_barrier_post(unsigned* bar, volatile LAS unsigned* st) {
    XcdBarrier b; b.bar = bar; b.x = xb_xcc_id(); b.st = st;
    if (threadIdx.x == 0) (void)xb_add(&bar[XB_XCNT(b.x)], 1u);
    return b;
}
__device__ __forceinline__ void xcd_barrier_complete(unsigned* bar, unsigned x, unsigned& nloc, unsigned& nx) {
    const unsigned G = gridDim.x * gridDim.y * gridDim.z;
    unsigned sum, cnt, mine, sp = 0u;
    for (;;) {
        sum = 0u; cnt = 0u; mine = 0u;
#pragma unroll
        for (unsigned j = 0; j < 16; ++j) { const unsigned c = xb_ld(&bar[XB_XCNT(j)]); sum += c; cnt += (c > 0u) ? 1u : 0u; mine = (j == x) ? c : mine; }
        if (sum == G) break;
        __builtin_amdgcn_s_sleep(1);
        if ((++sp & 255u) == 0u) { if (xb_ld(&bar[XB_TMO])) break; if (sp > XB_SPIN_CAP) { atomicAdd(&bar[XB_TMO], 1u); break; } }
    }
    nloc = mine > 0u ? mine : 1u; nx = cnt > 0u ? cnt : 1u;
}

__device__ __forceinline__ void xcd_barrier(const XcdBarrier& b) {
    asm volatile("s_waitcnt vmcnt(0)" ::: "memory");
    __syncthreads();
    if (threadIdx.x == 0) {
        unsigned* bar = b.bar;
        __builtin_amdgcn_s_waitcnt(0);
        unsigned nloc = b.st[0], nx = b.st[1];
        if (nloc == 0u) { xcd_barrier_complete(bar, b.x, nloc, nx); b.st[0] = nloc; b.st[1] = nx; }
        const unsigned old = xb_add(&bar[XB_XSUB(b.x)], 1u);
        const unsigned gen = old / nloc;
        if (old + 1u == (gen + 1u) * nloc) {
            __builtin_amdgcn_fence(__ATOMIC_RELEASE, "agent");
            asm volatile("s_waitcnt vmcnt(0)" ::: "memory");
            const unsigned og = xb_add(&bar[XB_TOP], 1u);
            const unsigned tg = og / nx;
            if (og + 1u == (tg + 1u) * nx) xb_add(&bar[XB_TOPGEN], 1u);
            else XB_SPIN(xb_ld(&bar[XB_TOPGEN]) == tg, bar);
            __builtin_amdgcn_fence(__ATOMIC_ACQUIRE, "agent");
            xb_add(&bar[XB_XGEN(b.x)], 1u);
            asm volatile("s_waitcnt vmcnt(0)" ::: "memory");
        } else {
            XB_SPIN(xb_ld(&bar[XB_XGEN(b.x)]) == gen, bar);
            __builtin_amdgcn_fence(__ATOMIC_ACQUIRE, "agent");
            asm volatile("s_waitcnt vmcnt(0)" ::: "memory");
        }
    }
    __syncthreads();
}

constexpr int N_PHASES = 31;
__global__ void __launch_bounds__(NW * 64, 2) fwd_kernel(Args a) {
    extern __shared__ __attribute__((aligned(16))) unsigned char lds_raw[];
    LAS unsigned char* lds = (LAS unsigned char*)lds_raw;
    unsigned char* ws = a.ws;
    stat_t* RS = (stat_t*)(ws + WS_RS); stat_t* RSV = RS + 9 * M;
    bf16* XB = (bf16*)(ws + WS_XB); bf16* ACT = (bf16*)(ws + WS_ACT); unsigned char* R = ws + WS_R;
    const int G = gridDim.x;
    if (threadIdx.x < 4) ((LAS unsigned*)(lds + BARST_OFF))[threadIdx.x] = 0u;
    if (a.ph_lo == 0 && blockIdx.x == 0) { unsigned* bw = (unsigned*)(ws + WS_BAR); for (int i = threadIdx.x; i < XCD_BAR_WORDS; i += NW * 64) bw[i] = 0u; }
    __syncthreads();
    XcdBarrier bar; bar.bar = (unsigned*)(ws + WS_BAR); bar.x = 0; bar.st = (volatile LAS unsigned*)(lds + BARST_OFF);
#pragma unroll 1
    for (int ph = a.ph_lo; ph < a.ph_hi; ++ph) {
        int tid_ = threadIdx.x; asm volatile("" : "+v"(tid_));
        const int tid = tid_, lane = tid & 63, wave = __builtin_amdgcn_readfirstlane(tid >> 6);
        int bx_ = blockIdx.x; asm volatile("" : "+s"(bx_)); const int bx = bx_;
        if (ph == 0) prologue_phase(a, lds, tid, wave, lane);
        else if (ph == 1) quant_rows_phase((const bf16*)(ws + WS_FIN), ws + WS_FINQ, (float*)(ws + WS_SW), 4 * NZ, wave, lane);
        else if (ph == N_PHASES - 1) final_phase(XB, a.out, RS + 8 * M, a.in[5], wave, lane);
        else {
            const int li = (ph - 2) / 7, sp7 = (ph - 2) % 7, j = li >> 1; const bool isA = (li & 1) == 0;
            const int sp = sp7 < 3 ? sp7 : sp7 - 1;
            if (sp7 == 3) quant_rows_phase(XB, ws + WS_XQ, (float*)(ws + WS_SX), M, wave, lane); else
            if (sp == 0 && isA) {
                pg8::Gemm g{XB, (const bf16*)(ws + WS_AIN + j * SZ_AIN), M, 4096, 2048}; pg8::StaticOrder S; S.init(M, 4096, G, bx);
                pg8::EpiGeluUV E{RS + (2 * li) * M, a.in[7] + j * 4096, (bf16*)(R + R_U), (bf16*)(R + R_VT2), RSV + j * M};
                pg8::gemm_phase<pg8::EpiGeluUV, pg8::StaticOrder, true, true>(lds, g, S, E);
            } else if (sp == 0) {
                pg8::Gemm g{XB, (const bf16*)(ws + WS_BQKV + j * SZ_QKV), M, NQKV, 2048}; pg8::StaticOrder S; S.init(M, NQKV, G, bx);
                pg8::EpiQKV E{RS + (2 * li) * M, (bf16*)(R + R_Q), (bf16*)(R + R_K), (bf16*)(R + R_VTA), 0.08838834764831845f * LOG2E};
                pg8::gemm_phase<pg8::EpiQKV, pg8::StaticOrder, true, true>(lds, g, S, E);
            } else if (sp == 1 && isA) {
                a2_phase(lds, a.in[9] + (size_t)j * 8 * 128 * 128, a.in[10] + j * 8 * 128, a.in[8] + j * 2048, RSV + j * M, (const bf16*)(R + R_U), (const bf16*)(R + R_VT2), (bf16*)(R + R_Y), tid, wave, lane);
            } else if (sp == 1) {
                attn_phase(lds, (const bf16*)(R + R_Q), (const bf16*)(R + R_K), (const bf16*)(R + R_VTA), (bf16*)(R + R_O), a.in[2], a.in[13] + j * 16, tid, wave, lane);
            } else if (sp == 2 || sp == 5) {
                const bf16* A; const bf16* Bt; int K; stat_t* rsn;
                if (sp == 2) { A = isA ? (const bf16*)(R + R_Y) : (const bf16*)(R + R_O); Bt = isA ? (const bf16*)(ws + WS_AOUT + j * SZ_SQ) : (const bf16*)(ws + WS_BOUT + j * SZ_SQ); K = 2048; rsn = RS + (2 * li + 1) * M; }
                else { A = ACT; Bt = (const bf16*)(ws + WS_FOUT + li * SZ_FOUT); K = DFF; rsn = RS + (2 * li + 2) * M; }
                pg8::Gemm g{A, Bt, M, 2048, K}; pg8::StaticOrder S; S.init(M, 2048, G, bx);
                pg8::EpiResid E{XB, rsn};
                pg8::gemm_phase<pg8::EpiResid, pg8::StaticOrder, true, true>(lds, g, S, E);
            } else if (sp == 3) {
                pg8::Gemm g{(const bf16*)(ws + WS_XQ), (const bf16*)(ws + WS_FINQ + (size_t)li * NZ * 2048), M, NZ, 1024}; pg8::StaticOrder S; S.init(M, NZ, G, bx);
                pg8::EpiConvGate E{RS + (2 * li + 1) * M, a.in[16] + (size_t)li * 3 * NZ, a.in[17] + (size_t)li * NZ, ACT, (float*)(ws + WS_HZ), lds + XCH_OFF, (const float*)(ws + WS_SX), (const float*)(ws + WS_SW) + (size_t)li * NZ};
                pg8::gemm_phase<pg8::EpiConvGate, pg8::StaticOrder, true, true>(lds, g, S, E);
            } else {
                ffn_fix_phase((const float*)(ws + WS_HZ), a.in[16] + (size_t)li * 3 * NZ, a.in[17] + (size_t)li * NZ, ACT, tid);
            }
        }
        if (a.coop && ph + 1 < a.ph_hi) {
            if (ph == 0) { cg::this_grid().sync(); bar = xcd_barrier_post((unsigned*)(ws + WS_BAR), (volatile LAS unsigned*)(lds + BARST_OFF)); }
            else xcd_barrier(bar);
        }
    }
}

extern "C" void kernel_launch(void* const* d_in, const int* in_sizes, int n_in, void* d_out, int out_size, void* d_ws, size_t ws_size, hipStream_t stream) {
    static int grid = 0;
    if (grid == 0) {
        if (n_in != 19 || out_size != M * DM || ws_size < WS_END) { fprintf(stderr, "kernel_launch: unexpected shapes (n_in %d out %d ws %zu need %zu)\n", n_in, out_size, ws_size, (size_t)WS_END); grid = -1; return; }
        int dev = 0, cus = 0, per_cu = 0;
        hipGetDevice(&dev); hipDeviceGetAttribute(&cus, hipDeviceAttributeMultiprocessorCount, dev);
        hipFuncSetAttribute((const void*)fwd_kernel, hipFuncAttributeMaxDynamicSharedMemorySize, LDS_BYTES);
        if (hipOccupancyMaxActiveBlocksPerMultiprocessor(&per_cu, (const void*)fwd_kernel, NW * 64, LDS_BYTES) != hipSuccess || per_cu < 1) { fprintf(stderr, "kernel_launch: occupancy query says %d\n", per_cu); per_cu = 1; }
        (void)hipGetLastError();
        grid = cus > 0 ? cus : 256;
    }
    if (grid < 0) return;
    Args a{};
    for (int i = 0; i < 19; ++i) a.in[i] = (const float*)d_in[i];
    a.out = (float*)d_out; a.ws = (unsigned char*)d_ws; a.pad = 0;
#if MK_COOP
    a.ph_lo = 0; a.ph_hi = N_PHASES; a.coop = 1;
    void* kargs[] = {&a};
    hipError_t e = hipLaunchCooperativeKernel((const void*)fwd_kernel, dim3(grid), dim3(NW * 64), kargs, LDS_BYTES, stream);
    if (e != hipSuccess) fprintf(stderr, "cooperative launch failed: %s (grid %d)\n", hipGetErrorString(e), grid);
#else
    a.coop = 0;
    for (int ph = 0; ph < N_PHASES; ++ph) { a.ph_lo = ph; a.ph_hi = ph + 1; hipLaunchKernelGGL(fwd_kernel, dim3(grid), dim3(NW * 64), LDS_BYTES, stream, a); }
#endif
}
```

```cpp
#include <hip/hip_runtime.h>
#include <hip/hip_cooperative_groups.h>
#include <cstdio>
#include <cstdint>
namespace cg = cooperative_groups;
#ifndef MK_COOP
#define MK_COOP 1
#endif
namespace pg8 {
#define PG8_LAS __attribute__((address_space(3)))
typedef unsigned short bf16_t;
typedef short bf16x8 __attribute__((ext_vector_type(8)));
typedef float f32x4 __attribute__((ext_vector_type(4)));
typedef unsigned u32x4 __attribute__((ext_vector_type(4)));
constexpr int BM = 256, BK = 64, HALF = 128, HTB = HALF * BK * 2  , STAGE_BYTES = 8 * HTB, NXCD = 8, WGM = 4;

__host__ __device__ __forceinline__ int lds_byte(int r, int c) { const int st = (r >> 4) * 2 + (c >> 5), rr = r & 15, cc = c & 31, ob = rr * 64 + cc * 2; return st * 1024 + (ob ^ (((ob >> 9) & 1) << 5)); }
__host__ __device__ __forceinline__ void stage_rc(int b, int& R, int& C) { const int st = b / 1024, sb = b % 1024, swz = sb ^ (((sb >> 9) & 1) << 5); R = (st >> 1) * 16 + swz / 64; C = (st & 1) * 32 + (swz % 64) / 2; }
__host__ __device__ __forceinline__ int perm32(int rho) { const int n = rho >> 4, i = rho & 15; return 8 * (i >> 2) + 4 * n + (i & 3); }

struct Unit { int pm, pn; };
struct Gemm { const bf16_t* A; const bf16_t* Bt; int M, N, K; };

struct StaticOrder {
    int nM, nN, nwg, G, c;
    __host__ __device__ void init(int M, int N, int G_, int c_) { nM = M / BM; nN = N / BM; nwg = nM * nN; G = G_; c = c_; }
    __host__ __device__ bool next(int i, Unit& u) const {
        const long L = (long)i * G + c; if (L >= nwg) return false;
        int wgid = (int)L; { const int q = nwg / NXCD, r = nwg % NXCD, xcd = wgid % NXCD, off = wgid / NXCD; wgid = (xcd < r ? xcd * (q + 1) : r * (q + 1) + (xcd - r) * q) + off; }
        const int nig = WGM * nN, gid = wgid / nig, fm = gid * WGM, gsz = (nM - fm) < WGM ? (nM - fm) : WGM;
        u.pm = fm + ((wgid % nig) % gsz); u.pn = (wgid % nig) / gsz; return true;
    }
    __device__ __forceinline__ void a_ready(const Unit&) const {}
    __device__ __forceinline__ void done(const Unit&) const {}
};

__device__ __forceinline__ unsigned cvt_pk_bf16(float lo, float hi) { unsigned r; asm volatile("v_cvt_pk_bf16_f32 %0, %1, %2" : "=v"(r) : "v"(lo), "v"(hi)); return r; }

constexpr int MROWS = 24576;
constexpr float NORM_EPS = 1e-6f;
typedef unsigned long long stat_t;
constexpr float STAT_SCALE = 16777216.0f, STAT_INV = 1.0f / 16777216.0f;
__device__ __forceinline__ stat_t stat_fix(float ss) { return (stat_t)(ss * STAT_SCALE + 0.5f); }
__device__ __forceinline__ float rstd2048(const stat_t* rs, int row) { return rsqrtf((float)rs[row] * (STAT_INV / 2048.0f) + NORM_EPS); }
__device__ __forceinline__ float gelu_tanh(float x) {
    const float t = x * (1.5957691216057308f + 0.07135481627f * x * x);
    const float e = __builtin_amdgcn_exp2f(-1.4426950408889634f * t);
    return x * __builtin_amdgcn_rcpf(1.0f + e);
}
__device__ __forceinline__ bf16_t f2bf_rne(float f) { return (bf16_t)(cvt_pk_bf16(f, 0.f) & 0xffffu); }

struct EpiGeluUV {
    static constexpr bool PERM = true, AFTER_DRAIN = false, APERM = true, I8 = false;
    const stat_t* rs; const float* bias; bf16_t* U; bf16_t* VT; stat_t* rsv;
    __device__ __forceinline__ void operator()(const f32x4 (&acc)[2][2][4][2], const Unit& u, int wr, int wc, int fr_, int fq_) const {
        int fr = fr_, fq = fq_; asm volatile("" : "+v"(fr), "+v"(fq));
        typedef unsigned u32x2v __attribute__((ext_vector_type(2)));
        const int rowb = u.pm * BM + wr * 64 + 4 * fr, colt = u.pn * BM, cl = wc * 32 + 8 * fq;
        f32x4 bv[2][2];
#pragma unroll
        for (int bj = 0; bj < 2; ++bj)
#pragma unroll
            for (int n = 0; n < 2; ++n) bv[bj][n] = *(const f32x4*)(bias + colt + bj * HALF + cl + 4 * n);
        const bool isV = u.pn >= 8;
        float rr[2][4];
#pragma unroll
        for (int ai = 0; ai < 2; ++ai)
#pragma unroll
            for (int m = 0; m < 4; ++m) rr[ai][m] = rstd2048(rs, rowb + ai * HALF + m);
#pragma unroll
        for (int ai = 0; ai < 2; ++ai) {
            float ss[4] = {0.f, 0.f, 0.f, 0.f};
#pragma unroll
            for (int bj = 0; bj < 2; ++bj) {
                float v[4][8];
#pragma unroll
                for (int m = 0; m < 4; ++m)
#pragma unroll
                    for (int n = 0; n < 2; ++n)
#pragma unroll
                        for (int j = 0; j < 4; ++j) v[m][4 * n + j] = gelu_tanh(acc[ai][bj][m][n][j] * rr[ai][m] + bv[bj][n][j]);
                if (!isV) {
#pragma unroll
                    for (int m = 0; m < 4; ++m) {
                        u32x4 w; w.x = cvt_pk_bf16(v[m][0], v[m][1]); w.y = cvt_pk_bf16(v[m][2], v[m][3]); w.z = cvt_pk_bf16(v[m][4], v[m][5]); w.w = cvt_pk_bf16(v[m][6], v[m][7]);
                        *(u32x4*)(U + (size_t)(rowb + ai * HALF + m) * 2048 + colt + bj * HALF + cl) = w; }
                } else {
                    const int c0 = colt - 2048 + bj * HALF + cl, row = rowb + ai * HALF;
                    bf16_t* vp = VT + ((size_t)(row >> 7) * 2048 + c0) * 128 + (row & 127);
#pragma unroll
                    for (int j = 0; j < 8; ++j) {
                        u32x2v w; w.x = cvt_pk_bf16(v[0][j], v[1][j]); w.y = cvt_pk_bf16(v[2][j], v[3][j]);
                        *(u32x2v*)(vp + (size_t)j * 128) = w;
#pragma unroll
                        for (int m = 0; m < 4; ++m) ss[m] += v[m][j] * v[m][j];
                    }
                }
            }
            if (isV) {
#pragma unroll
                for (int m = 0; m < 4; ++m) { float s = ss[m]; s += __shfl_xor(s, 16); s += __shfl_xor(s, 32); if (fq == 0) atomicAdd(rsv + rowb + ai * HALF + m, stat_fix(s)); }
            }
        }
    }
};
struct EpiResid {
    static constexpr bool PERM = true, AFTER_DRAIN = false, APERM = false, I8 = false;
    bf16_t* XB; stat_t* rs_next;
    __device__ __forceinline__ void operator()(const f32x4 (&acc)[2][2][4][2], const Unit& u, int wr, int wc, int fr, int fq) const {
        const int row0 = u.pm * BM + wr * 64 + fr, col0 = u.pn * BM + wc * 32 + 8 * fq;
        u32x4 xv[2][4][2];
#pragma unroll
        for (int ai = 0; ai < 2; ++ai)
#pragma unroll
            for (int m = 0; m < 4; ++m)
#pragma unroll
                for (int bj = 0; bj < 2; ++bj) xv[ai][m][bj] = *(const u32x4*)(XB + (size_t)(row0 + ai * HALF + m * 16) * 2048 + col0 + bj * HALF);
#pragma unroll
        for (int ai = 0; ai < 2; ++ai)
#pragma unroll
            for (int m = 0; m < 4; ++m) {
                const int row = row0 + ai * HALF + m * 16; bf16_t* p = XB + (size_t)row * 2048 + col0; float ss = 0.f;
#pragma unroll
                for (int bj = 0; bj < 2; ++bj) {
                    u32x4 w;
#pragma unroll
                    for (int k = 0; k < 4; ++k) {
                        const float lo = __uint_as_float(xv[ai][m][bj][k] << 16) + acc[ai][bj][m][k >> 1][(k & 1) * 2], hi = __uint_as_float(xv[ai][m][bj][k] & 0xffff0000u) + acc[ai][bj][m][k >> 1][(k & 1) * 2 + 1];
                        const unsigned pk = cvt_pk_bf16(lo, hi); w[k] = pk;
                        const float rl = __uint_as_float(pk << 16), rh = __uint_as_float(pk & 0xffff0000u);
                        ss += rl * rl + rh * rh;
                    }
                    *(u32x4*)(p + bj * HALF) = w;
                }
                ss += __shfl_xor(ss, 16); ss += __shfl_xor(ss, 32); if (fq == 0) atomicAdd(rs_next + row, stat_fix(ss));
            }
    }
};
struct EpiQKV {
    static constexpr bool PERM = true, AFTER_DRAIN = false, APERM = true, I8 = true;
    const stat_t* rs; bf16_t* Q; bf16_t* Kb; bf16_t* VT; float qscale; const float* sx; const float* sw;
    __device__ __forceinline__ void operator()(const f32x4 (&acc)[2][2][4][2], const Unit& u, int wr, int wc, int fr_, int fq_) const {
        int fr = fr_, fq = fq_; asm volatile("" : "+v"(fr), "+v"(fq));
        typedef unsigned u32x2v __attribute__((ext_vector_type(2)));
        const int rowb = u.pm * BM + wr * 64 + 4 * fr, colt = u.pn * BM, cl = wc * 32 + 8 * fq;
        const bool isq = u.pn < 8;
        const unsigned long long ob = (unsigned long long)(isq ? Q : Kb);
        bf16_t* obase = (bf16_t*)(((unsigned long long)(unsigned)__builtin_amdgcn_readfirstlane((int)(ob >> 32)) << 32) | (unsigned)__builtin_amdgcn_readfirstlane((int)ob));
        const int oldc = isq ? 2048 : 512, ocol = isq ? colt : colt - 2048;
        float rr[2][4];
#pragma unroll
        for (int ai = 0; ai < 2; ++ai)
#pragma unroll
            for (int m = 0; m < 4; ++m) { rr[ai][m] = rstd2048(rs, rowb + ai * HALF + m) * sx[rowb + ai * HALF + m]; if (isq) rr[ai][m] *= qscale; }
        typedef int i32x4 __attribute__((ext_vector_type(4)));
        f32x4 swv[2][2];
#pragma unroll
        for (int bj = 0; bj < 2; ++bj)
#pragma unroll
            for (int n = 0; n < 2; ++n) swv[bj][n] = *(const f32x4*)(sw + colt + bj * HALF + cl + 4 * n);
#define QV(ai_, bj_, m_, n_) (__builtin_convertvector(__builtin_bit_cast(i32x4, acc[ai_][bj_][m_][n_]), f32x4) * swv[bj_][n_])
#pragma unroll
        for (int ai = 0; ai < 2; ++ai)
#pragma unroll
            for (int bj = 0; bj < 2; ++bj) {
                if (u.pn < 10) {
#pragma unroll
                    for (int m = 0; m < 4; ++m) {
                        const f32x4 v0 = QV(ai, bj, m, 0) * rr[ai][m], v1 = QV(ai, bj, m, 1) * rr[ai][m]; const int row = rowb + ai * HALF + m;
                        u32x4 w; w.x = cvt_pk_bf16(v0[0], v0[1]); w.y = cvt_pk_bf16(v0[2], v0[3]); w.z = cvt_pk_bf16(v1[0], v1[1]); w.w = cvt_pk_bf16(v1[2], v1[3]);
                        *(u32x4*)(obase + (size_t)row * oldc + ocol + bj * HALF + cl) = w; }
                } else {
                    bf16_t* vp = VT + (size_t)(colt - 2560 + bj * HALF + cl) * MROWS + rowb + ai * HALF;
#pragma unroll
                    for (int n = 0; n < 2; ++n) {
                        const f32x4 q0 = QV(ai, bj, 0, n) * rr[ai][0], q1 = QV(ai, bj, 1, n) * rr[ai][1], q2 = QV(ai, bj, 2, n) * rr[ai][2], q3 = QV(ai, bj, 3, n) * rr[ai][3];
#pragma unroll
                        for (int j = 0; j < 4; ++j) {
                            u32x2v w; w.x = cvt_pk_bf16(q0[j], q1[j]); w.y = cvt_pk_bf16(q2[j], q3[j]);
                            *(u32x2v*)(vp + (size_t)(4 * n + j) * MROWS) = w; } }
                }
            }
    }
#undef QV
};
__device__ __forceinline__ float dpp_shr1(float old, float v) { return __builtin_bit_cast(float, __builtin_amdgcn_update_dpp(__builtin_bit_cast(int, old), __builtin_bit_cast(int, v), 0x111, 0xf, 0xf, false)); }
__device__ __forceinline__ float dpp_shl1(float old, float v) { return __builtin_bit_cast(float, __builtin_amdgcn_update_dpp(__builtin_bit_cast(int, old), __builtin_bit_cast(int, v), 0x101, 0xf, 0xf, false)); }
__device__ __forceinline__ float fma_s(float a, float b, float c) { float d; asm("v_fma_f32 %0, %1, %2, %3" : "=v"(d) : "v"(a), "v"(b), "v"(c)); return d; }
__device__ __forceinline__ float silu_f(float g) { return g * __builtin_amdgcn_rcpf(1.0f + __builtin_amdgcn_exp2f(-1.4426950408889634f * g)); }
struct EpiConvGate {
    static constexpr bool PERM = true, AFTER_DRAIN = false, APERM = true, I8 = true;
    static constexpr int DFF_ = 5632, NZ_ = 11264;
    const stat_t* rs; const float* cw; const float* cb; bf16_t* ACT; float* HZ; PG8_LAS unsigned char* xch; const float* sx; const float* sw;
    __device__ __forceinline__ void operator()(const f32x4 (&acc)[2][2][4][2], const Unit& u, int wr, int wc, int fr_, int fq_) const {
        typedef unsigned u32x2v __attribute__((ext_vector_type(2)));
        int fr = fr_, fq = fq_; asm volatile("" : "+v"(fr), "+v"(fq));
        f32x4 z[2][2][4][2];
        const int rowb = u.pm * BM + wr * 64 + 4 * fr;
        f32x4 swv[2][2];
#pragma unroll
        for (int bj = 0; bj < 2; ++bj)
#pragma unroll
            for (int n = 0; n < 2; ++n) swv[bj][n] = *(const f32x4*)(sw + u.pn * BM + bj * HALF + wc * 32 + 8 * fq + 4 * n);
#pragma unroll
        for (int ai = 0; ai < 2; ++ai)
#pragma unroll
            for (int m = 0; m < 4; ++m) { const float r = rstd2048(rs, rowb + ai * HALF + m) * sx[rowb + ai * HALF + m];
#pragma unroll
                for (int bj = 0; bj < 2; ++bj)
#pragma unroll
                    for (int n = 0; n < 2; ++n) { typedef int i32x4 __attribute__((ext_vector_type(4)));
                        z[ai][bj][m][n] = __builtin_convertvector(__builtin_bit_cast(i32x4, acc[ai][bj][m][n]), f32x4) * (swv[bj][n] * r); } }
        PG8_LAS f32x4* X4 = (PG8_LAS f32x4*)xch;
#define XIDX(wr_, ai_, fl_) ((((((wr_) * 4 + wc) * 2 + (ai_)) * 2 + (fl_)) * 4 + fq) * 4)
#pragma unroll
        for (int ai = 0; ai < 2; ++ai) {
            if (fr == 0) {
#pragma unroll
                for (int bj = 0; bj < 2; ++bj)
#pragma unroll
                    for (int n = 0; n < 2; ++n) X4[XIDX(wr, ai, 0) + bj * 2 + n] = z[ai][bj][0][n]; }
            if (fr == 15) {
#pragma unroll
                for (int bj = 0; bj < 2; ++bj)
#pragma unroll
                    for (int n = 0; n < 2; ++n) X4[XIDX(wr, ai, 1) + bj * 2 + n] = z[ai][bj][3][n]; }
        }
        {   const int hcol = u.pn * BM + wc * 32 + 8 * fq;
            if (wr == 0 && fr == 0) {
#pragma unroll
                for (int m = 0; m < 2; ++m)
#pragma unroll
                    for (int bj = 0; bj < 2; ++bj)
#pragma unroll
                        for (int n = 0; n < 2; ++n) *(f32x4*)(HZ + (size_t)(u.pm * 4 + m) * NZ_ + hcol + bj * HALF + 4 * n) = z[0][bj][m][n]; }
            if (wr == 1 && fr == 15) {
#pragma unroll
                for (int m = 2; m < 4; ++m)
#pragma unroll
                    for (int bj = 0; bj < 2; ++bj)
#pragma unroll
                        for (int n = 0; n < 2; ++n) *(f32x4*)(HZ + (size_t)(u.pm * 4 + m) * NZ_ + hcol + bj * HALF + 4 * n) = z[1][bj][m][n]; }
        }
        asm volatile("s_waitcnt lgkmcnt(0)" ::: "memory"); __builtin_amdgcn_s_barrier(); asm volatile("" ::: "memory");
        const int ch0 = u.pn * HALF + wc * 32 + 8 * fq;
        const f32x4 zero4 = (f32x4){0.f, 0.f, 0.f, 0.f};
#pragma unroll
        for (int ai = 0; ai < 2; ++ai) {
            unsigned ow[4][4];
#pragma unroll
            for (int n = 0; n < 2; ++n) {
                const int ch = ch0 + 4 * n;
                const f32x4 w0g = *(const f32x4*)(cw + ch), w1g = *(const f32x4*)(cw + NZ_ + ch), w2g = *(const f32x4*)(cw + 2 * NZ_ + ch), bg = *(const f32x4*)(cb + ch);
                const f32x4 w0u = *(const f32x4*)(cw + DFF_ + ch), w1u = *(const f32x4*)(cw + NZ_ + DFF_ + ch), w2u = *(const f32x4*)(cw + 2 * NZ_ + DFF_ + ch), bu = *(const f32x4*)(cb + DFF_ + ch);
                f32x4 pBg = zero4, pBu = zero4, nBg = zero4, nBu = zero4;
                if (wr == 1) { pBg = X4[XIDX(0, ai, 1) + n]; pBu = X4[XIDX(0, ai, 1) + 2 + n]; }
                else if (ai == 1) { pBg = X4[XIDX(1, 0, 1) + n]; pBu = X4[XIDX(1, 0, 1) + 2 + n]; }
                if (wr == 0) { nBg = X4[XIDX(1, ai, 0) + n]; nBu = X4[XIDX(1, ai, 0) + 2 + n]; }
                else if (ai == 0) { nBg = X4[XIDX(0, 1, 0) + n]; nBu = X4[XIDX(0, 1, 0) + 2 + n]; }
                float o[4][4];
#pragma unroll
                for (int h = 0; h < 2; ++h) {
                    typedef float f32x2 __attribute__((ext_vector_type(2)));
#define PAIR(v) (h == 0 ? __builtin_shufflevector(v, v, 0, 1) : __builtin_shufflevector(v, v, 2, 3))
                    const f32x2 g0 = PAIR(z[ai][0][0][n]), g1 = PAIR(z[ai][0][1][n]), g2 = PAIR(z[ai][0][2][n]), g3 = PAIR(z[ai][0][3][n]);
                    const f32x2 u0 = PAIR(z[ai][1][0][n]), u1 = PAIR(z[ai][1][1][n]), u2 = PAIR(z[ai][1][2][n]), u3 = PAIR(z[ai][1][3][n]);
                    const f32x2 pBg2 = PAIR(pBg), nBg2 = PAIR(nBg), pBu2 = PAIR(pBu), nBu2 = PAIR(nBu);
                    f32x2 pg, ng, pu, nu;
                    pg.x = dpp_shr1(pBg2.x, g3.x); pg.y = dpp_shr1(pBg2.y, g3.y); ng.x = dpp_shl1(nBg2.x, g0.x); ng.y = dpp_shl1(nBg2.y, g0.y);
                    pu.x = dpp_shr1(pBu2.x, u3.x); pu.y = dpp_shr1(pBu2.y, u3.y); nu.x = dpp_shl1(nBu2.x, u0.x); nu.y = dpp_shl1(nBu2.y, u0.y);
                    const f32x2 A0 = PAIR(w0g), A1 = PAIR(w1g), A2 = PAIR(w2g), AB = PAIR(bg), C0 = PAIR(w0u), C1 = PAIR(w1u), C2 = PAIR(w2u), CB = PAIR(bu);
                    f32x2 G[4], U[4];
                    G[0] = A0 * pg + (A1 * g0 + (A2 * g1 + AB)); G[1] = A0 * g0 + (A1 * g1 + (A2 * g2 + AB)); G[2] = A0 * g1 + (A1 * g2 + (A2 * g3 + AB)); G[3] = A0 * g2 + (A1 * g3 + (A2 * ng + AB));
                    U[0] = C0 * pu + (C1 * u0 + (C2 * u1 + CB)); U[1] = C0 * u0 + (C1 * u1 + (C2 * u2 + CB)); U[2] = C0 * u1 + (C1 * u2 + (C2 * u3 + CB)); U[3] = C0 * u2 + (C1 * u3 + (C2 * nu + CB));
#pragma unroll
                    for (int m = 0; m < 4; ++m) {
                        const f32x2 t = G[m] * (-1.4426950408889634f);
                        f32x2 e; e.x = __builtin_amdgcn_exp2f(t.x); e.y = __builtin_amdgcn_exp2f(t.y);
                        const f32x2 d = e + 1.0f;
                        f32x2 r; r.x = __builtin_amdgcn_rcpf(d.x); r.y = __builtin_amdgcn_rcpf(d.y);
                        const f32x2 q = (G[m] * U[m]) * r;
                        o[m][2 * h] = q.x; o[m][2 * h + 1] = q.y;
                    }
#undef PAIR
                }
#pragma unroll
                for (int m = 0; m < 4; ++m) { ow[m][2 * n] = cvt_pk_bf16(o[m][0], o[m][1]); ow[m][2 * n + 1] = cvt_pk_bf16(o[m][2], o[m][3]); }
            }
#pragma unroll
            for (int m = 0; m < 4; ++m) { u32x4 w; w.x = ow[m][0]; w.y = ow[m][1]; w.z = ow[m][2]; w.w = ow[m][3];
                *(u32x4*)(ACT + (size_t)(rowb + ai * HALF + m) * DFF_ + ch0) = w; }
            asm volatile("" ::: "memory");
        }
#undef XIDX
    }
};

template <bool I8> __device__ __forceinline__ f32x4 mma16(bf16x8 b, bf16x8 a, f32x4 c) {
    if constexpr (I8) { typedef int i32x4 __attribute__((ext_vector_type(4)));
        return __builtin_bit_cast(f32x4, __builtin_amdgcn_mfma_i32_16x16x64_i8(__builtin_bit_cast(i32x4, b), __builtin_bit_cast(i32x4, a), __builtin_bit_cast(i32x4, c), 0, 0, 0)); }
    else return __builtin_amdgcn_mfma_f32_16x16x32_bf16(b, a, c, 0, 0, 0);
}
template <class Epi, class Sched, bool ALIGN_EPI = false, bool SP2 = false>
__device__ __forceinline__ void gemm_phase(PG8_LAS unsigned char* lds, const Gemm g, const Sched& S, const Epi& E) {
    int tid_ = threadIdx.x; asm volatile("" : "+v"(tid_)); const int tid = tid_, wid = __builtin_amdgcn_readfirstlane(tid >> 6), lane = tid & 63, wr = wid >> 2, wc = wid & 3, fr = lane & 15, fq = lane >> 4;
    const int K = g.K, nt = K / BK;
    unsigned voffA[2], voffB[2];
#pragma unroll
    for (int i = 0; i < 2; ++i) { int R, C; stage_rc(tid * 16 + i * 8192, R, C); const int Rb = Epi::PERM ? ((R & ~31) + perm32(R & 31)) : R;
        const int Ra = Epi::APERM ? ((R & ~63) + ((R & 15) << 2) + ((R >> 4) & 3)) : R;
        voffA[i] = (unsigned)(Ra * K + C) * 2u; voffB[i] = (unsigned)(Rb * K + C) * 2u; }
    const size_t kstep = (size_t)(BK * 2);
    const size_t hstep = (size_t)HALF * K * 2;
    const size_t tstep = 2 * hstep;
    const unsigned ldsw = (unsigned)wid * 1024u;
    const int aoff = lds_byte(wr * 64 + fr, fq * 8), boff = lds_byte(wc * 32 + fr, fq * 8);
#define PG8_SA(b, h) (((b) * 2 + (h)) * HTB)
#define PG8_SB(b, h) ((4 + (b) * 2 + (h)) * HTB)
#define PG8_STAGE(bufoff, gbase, voff) do { _Pragma("unroll") for (int _i = 0; _i < 2; ++_i) \
        __builtin_amdgcn_global_load_lds((const unsigned*)((const char*)(gbase) + (voff)[_i]), (PG8_LAS unsigned*)(lds + (bufoff) + ldsw + _i * 8192), 16, 0, 0); } while (0)
#define PG8_LDA(dst, b, h) do { _Pragma("unroll") for (int m = 0; m < 4; ++m) _Pragma("unroll") for (int k = 0; k < 2; ++k) dst[m][k] = *(const PG8_LAS bf16x8*)(lds + PG8_SA(b, h) + aoff + m * 2048 + k * 1024); } while (0)
#define PG8_LDB(dst, b, h) do { _Pragma("unroll") for (int n = 0; n < 2; ++n) _Pragma("unroll") for (int k = 0; k < 2; ++k) dst[n][k] = *(const PG8_LAS bf16x8*)(lds + PG8_SB(b, h) + boff + n * 2048 + k * 1024); } while (0)
#define PG8_MMA(ai, bj, At, Bt) do { __builtin_amdgcn_s_setprio(1); _Pragma("unroll") for (int m = 0; m < 4; ++m) _Pragma("unroll") for (int n = 0; n < 2; ++n) _Pragma("unroll") for (int k = 0; k < 2; ++k) \
        acc[ai][bj][m][n] = mma16<Epi::I8>(Bt[n][k], At[m][k], acc[ai][bj][m][n]); __builtin_amdgcn_s_setprio(0); } while (0)
#define PG8_WAIT_V(n) asm volatile("s_waitcnt vmcnt(" #n ")" ::: "memory")
#define PG8_WAIT_L(n) asm volatile("s_waitcnt lgkmcnt(" #n ")" ::: "memory")
#define PG8_BAR __builtin_amdgcn_s_barrier()
#define PG8_SCHED __builtin_amdgcn_sched_barrier(0)
    Unit cur, nxt; int ui = 0;
    if (!S.next(0, cur)) return;
    f32x4 acc[2][2][4][2];
#pragma unroll
    for (int a = 0; a < 2; ++a)
#pragma unroll
        for (int b = 0; b < 2; ++b)
#pragma unroll
            for (int m = 0; m < 4; ++m)
#pragma unroll
                for (int n = 0; n < 2; ++n) acc[a][b][m][n] = (f32x4){0.f, 0.f, 0.f, 0.f};
    bf16x8 At[4][2], B0[2][2], B1[2][2];
    const char* cA = (const char*)g.A + (size_t)cur.pm * tstep; const char* cB = (const char*)g.Bt + (size_t)cur.pn * tstep;
    S.a_ready(cur);
    if constexpr (SP2) {
        PG8_STAGE(PG8_SB(0, 0), cB, voffB); PG8_STAGE(PG8_SB(0, 1), cB + hstep, voffB); PG8_STAGE(PG8_SA(0, 0), cA, voffA); PG8_STAGE(PG8_SA(0, 1), cA + hstep, voffA);
        if (wr == 1) PG8_BAR;
        PG8_WAIT_V(2); PG8_BAR;
        PG8_STAGE(PG8_SB(1, 0), cB + kstep, voffB); PG8_STAGE(PG8_SA(1, 0), cA + kstep, voffA); PG8_STAGE(PG8_SB(1, 1), cB + hstep + kstep, voffB);
        PG8_WAIT_V(6); PG8_BAR;
    } else {
        PG8_STAGE(PG8_SB(0, 0), cB, voffB); PG8_STAGE(PG8_SA(0, 0), cA, voffA); PG8_STAGE(PG8_SB(0, 1), cB + hstep, voffB); PG8_STAGE(PG8_SA(0, 1), cA + hstep, voffA);
        if (wr == 1) PG8_BAR;
        PG8_WAIT_V(4); PG8_BAR;
        PG8_STAGE(PG8_SB(1, 0), cB + kstep, voffB); PG8_STAGE(PG8_SA(1, 0), cA + kstep, voffA); PG8_STAGE(PG8_SB(1, 1), cB + hstep + kstep, voffB);
        PG8_WAIT_V(6); PG8_BAR;
    }
    for (;;) {
        const bool has_next = S.next(ui + 1, nxt);
        const char* nA = has_next ? (const char*)g.A + (size_t)nxt.pm * tstep : cA; const char* nB = has_next ? (const char*)g.Bt + (size_t)nxt.pn * tstep : cB;
        for (int t = 0; t < nt; t += 2) {
            const bool last = (t == nt - 2);
            const char* a1 = cA + (size_t)(t + 1) * kstep;
            const char* a2 = last ? nA : cA + (size_t)(t + 2) * kstep; const char* b2 = last ? nB : cB + (size_t)(t + 2) * kstep;
            const char* a3 = a2 + kstep; const char* b3 = b2 + kstep;
            if (last && has_next) S.a_ready(nxt);
            if constexpr (SP2) {
            PG8_LDB(B0, 0, 0); PG8_LDB(B1, 0, 1); PG8_SCHED; PG8_LDA(At, 0, 0); PG8_STAGE(PG8_SA(1, 1), a1 + hstep, voffA);
            PG8_WAIT_V(8); PG8_WAIT_L(0); PG8_BAR; PG8_MMA(0, 0, At, B0); PG8_MMA(0, 1, At, B1); PG8_BAR; PG8_SCHED;
            PG8_LDA(At, 0, 1); PG8_STAGE(PG8_SB(0, 0), b2, voffB); PG8_STAGE(PG8_SB(0, 1), b2 + hstep, voffB); PG8_STAGE(PG8_SA(0, 0), a2, voffA);
            PG8_WAIT_V(8); PG8_WAIT_L(0); PG8_BAR; PG8_MMA(1, 0, At, B0); PG8_MMA(1, 1, At, B1); PG8_BAR; PG8_SCHED;
            PG8_LDB(B0, 1, 0); PG8_LDB(B1, 1, 1); PG8_SCHED; PG8_LDA(At, 1, 0); PG8_STAGE(PG8_SA(0, 1), a2 + hstep, voffA);
            PG8_WAIT_V(8); PG8_WAIT_L(0); PG8_BAR; PG8_MMA(0, 0, At, B0); PG8_MMA(0, 1, At, B1); PG8_BAR; PG8_SCHED;
            PG8_LDA(At, 1, 1); PG8_STAGE(PG8_SB(1, 0), b3, voffB); PG8_STAGE(PG8_SB(1, 1), b3 + hstep, voffB); PG8_STAGE(PG8_SA(1, 0), a3, voffA);
            PG8_WAIT_V(8); PG8_WAIT_L(0); PG8_BAR; PG8_MMA(1, 0, At, B0); PG8_MMA(1, 1, At, B1); PG8_BAR; PG8_SCHED;
            } else {
            PG8_LDB(B0, 0, 0); PG8_SCHED; PG8_LDA(At, 0, 0); PG8_STAGE(PG8_SA(1, 1), a1 + hstep, voffA);
            PG8_WAIT_L(8); PG8_BAR; PG8_WAIT_L(0); PG8_MMA(0, 0, At, B0); PG8_BAR; PG8_SCHED;
            PG8_LDB(B1, 0, 1); PG8_STAGE(PG8_SB(0, 0), b2, voffB);
            PG8_BAR; PG8_WAIT_L(0); PG8_MMA(0, 1, At, B1); PG8_BAR;
            PG8_LDA(At, 0, 1); PG8_STAGE(PG8_SA(0, 0), a2, voffA);
            PG8_BAR; PG8_WAIT_L(0); PG8_MMA(1, 0, At, B0); PG8_BAR; PG8_SCHED;
            PG8_STAGE(PG8_SB(0, 1), b2 + hstep, voffB);
            PG8_WAIT_V(6); PG8_BAR; PG8_MMA(1, 1, At, B1); PG8_BAR;
            PG8_LDB(B0, 1, 0); PG8_SCHED; PG8_LDA(At, 1, 0); PG8_STAGE(PG8_SA(0, 1), a2 + hstep, voffA);
            PG8_WAIT_L(8); PG8_BAR; PG8_WAIT_L(0); PG8_MMA(0, 0, At, B0); PG8_BAR; PG8_SCHED;
            PG8_LDB(B1, 1, 1); PG8_STAGE(PG8_SB(1, 0), b3, voffB);
            PG8_BAR; PG8_WAIT_L(0); PG8_MMA(0, 1, At, B1); PG8_BAR;
            PG8_LDA(At, 1, 1); PG8_STAGE(PG8_SA(1, 0), a3, voffA);
            PG8_BAR; PG8_WAIT_L(0); PG8_MMA(1, 0, At, B0); PG8_BAR; PG8_SCHED;
            PG8_STAGE(PG8_SB(1, 1), b3 + hstep, voffB);
            PG8_WAIT_V(6); PG8_BAR; PG8_MMA(1, 1, At, B1); PG8_BAR;
            }
        }
        if constexpr (ALIGN_EPI) { if (wr == 0) PG8_BAR; }
        if constexpr (!Epi::AFTER_DRAIN) { E(acc, cur, wr, wc, fr, fq); S.done(cur); }
        if (!has_next) break;
#pragma unroll
        for (int a = 0; a < 2; ++a)
#pragma unroll
            for (int b = 0; b < 2; ++b)
#pragma unroll
                for (int m = 0; m < 4; ++m)
#pragma unroll
                    for (int n = 0; n < 2; ++n) acc[a][b][m][n] = (f32x4){0.f, 0.f, 0.f, 0.f};
        cur = nxt; cA = nA; cB = nB; ++ui;
        if constexpr (ALIGN_EPI) { if (wr == 1) PG8_BAR; }
    }
    PG8_WAIT_V(0);
    if constexpr (!ALIGN_EPI) { if (wr == 0) PG8_BAR; }
    PG8_BAR;
    if constexpr (Epi::AFTER_DRAIN) { E.fused(acc, cur, wr, wc, fr, fq, lds, wid, lane); S.done(cur); }
#undef PG8_SA
#undef PG8_SB
#undef PG8_STAGE
#undef PG8_LDA
#undef PG8_LDB
#undef PG8_MMA
#undef PG8_WAIT_V
#undef PG8_WAIT_L
#undef PG8_BAR
#undef PG8_SCHED
}
}

constexpr int NW = 8;
constexpr int M = 24576, DM = 2048, DFF = 5632, NZ = 2 * DFF, NQKV = 3072, AW = 2048;
constexpr int SEQ_P = 8192, SEQ_S = 4096, ROWS_P = 2 * SEQ_P;
constexpr float EPS = 1e-6f, LOG2E = 1.4426950408889634f;
constexpr size_t MiB = 1u << 20;
constexpr size_t WS_RS = 0;
constexpr size_t WS_BAR = 3 * MiB;
constexpr size_t WS_W = 4 * MiB;
constexpr size_t SZ_AIN = (size_t)4096 * 2048 * 2, SZ_SQ = (size_t)2048 * 2048 * 2, SZ_QKV = (size_t)3072 * 2048 * 2, SZ_FIN = (size_t)NZ * 2048 * 2, SZ_FOUT = (size_t)2048 * DFF * 2;
constexpr size_t WS_AIN = WS_W, WS_AOUT = WS_AIN + 2 * SZ_AIN, WS_BQKV = WS_AOUT + 2 * SZ_SQ, WS_BOUT = WS_BQKV + 2 * SZ_QKV, WS_FIN = WS_BOUT + 2 * SZ_SQ, WS_FOUT = WS_FIN + 4 * SZ_FIN;
constexpr size_t WS_XB = WS_FOUT + 4 * SZ_FOUT;
constexpr size_t SZ_ROWS = (size_t)M * 2048 * 2;
constexpr size_t WS_ACT = WS_XB + SZ_ROWS;
constexpr size_t WS_HZ = WS_ACT + (size_t)M * DFF * 2;
constexpr size_t WS_R = WS_HZ + (size_t)96 * 4 * NZ * 4;
constexpr size_t WS_XQ = WS_R + 3 * SZ_ROWS;
constexpr size_t WS_FINQ = WS_XQ + (size_t)M * 2048;
constexpr size_t WS_QKVQ = WS_FINQ + (size_t)4 * NZ * 2048;
constexpr size_t WS_END = WS_QKVQ + (size_t)2 * NQKV * 2048;
constexpr size_t WS_SWQ = 3 * MiB + 524288;
constexpr size_t WS_SX = 3 * MiB + 131072, WS_SW = 3 * MiB + 262144;
constexpr size_t R_U = 0, R_VT2 = SZ_ROWS, R_Y = 2 * SZ_ROWS;
constexpr size_t R_Q = 0, R_K = SZ_ROWS, R_VTA = R_K + (size_t)M * 512 * 2, R_O = R_VTA + (size_t)M * 512 * 2;
constexpr int XCH_OFF = 131072, BARST_OFF = 131072 + 8192, LDS_BYTES = 131072 + 8192 + 16;

#define LAS __attribute__((address_space(3)))
typedef unsigned short bf16;
typedef float f32x4 __attribute__((ext_vector_type(4)));
typedef short bf16x8 __attribute__((ext_vector_type(8)));
typedef unsigned u32x4v __attribute__((ext_vector_type(4)));
typedef unsigned u32x2v __attribute__((ext_vector_type(2)));
using pg8::cvt_pk_bf16; using pg8::stat_t; using pg8::stat_fix; using pg8::STAT_INV;
__device__ __forceinline__ float bf_lo(unsigned w) { return __uint_as_float(w << 16); }
__device__ __forceinline__ float bf_hi(unsigned w) { return __uint_as_float(w & 0xffff0000u); }
__device__ __forceinline__ float wave_sum(float v) {
#pragma unroll
    for (int o = 1; o < 64; o <<= 1) v += __shfl_xor(v, o);
    return v;
}

struct Args { const float* in[19]; float* out; unsigned char* ws; int ph_lo, ph_hi, coop, pad; };

__device__ __forceinline__ void transpose_item(const float* W, int K, int N, bf16* WT, const float* gain, LAS float* scr, int item, int lane, bool ffn_perm) {
    const int nblk = N / 64, kb = item / nblk, nb = item % nblk, k0 = 64 * kb, n0 = 64 * nb;
    int d0 = n0; if (ffn_perm) { const int half = n0 >= DFF, cc = n0 - half * DFF; d0 = (cc >> 7) * 256 + half * 128 + (cc & 127); }
    const int lr = lane >> 4, lc = (lane & 15) * 4;
    const float* src = W + (size_t)(k0 + lr) * N + n0 + lc;
    f32x4 v[16];
#pragma unroll
    for (int i = 0; i < 16; ++i) v[i] = __builtin_nontemporal_load((const f32x4*)(src + (size_t)(4 * i) * N));
#pragma unroll
    for (int i = 0; i < 16; ++i) { LAS float* d = scr + (4 * i + lr) * 65 + lc; d[0] = v[i][0]; d[1] = v[i][1]; d[2] = v[i][2]; d[3] = v[i][3]; }
    asm volatile("s_waitcnt lgkmcnt(0)" ::: "memory");
    const int c = lane & 7;
    f32x4 g0 = (f32x4){1.f, 1.f, 1.f, 1.f}, g1 = g0;
    if (gain) { g0 = *(const f32x4*)(gain + k0 + 8 * c); g1 = *(const f32x4*)(gain + k0 + 8 * c + 4); }
#pragma unroll
    for (int j = 0; j < 8; ++j) { const int n = (lane >> 3) + 8 * j; const LAS float* s = scr + (8 * c) * 65 + n;
        u32x4v o; o.x = cvt_pk_bf16(s[0 * 65] * g0[0], s[1 * 65] * g0[1]); o.y = cvt_pk_bf16(s[2 * 65] * g0[2], s[3 * 65] * g0[3]); o.z = cvt_pk_bf16(s[4 * 65] * g1[0], s[5 * 65] * g1[1]); o.w = cvt_pk_bf16(s[6 * 65] * g1[2], s[7 * 65] * g1[3]);
        *(u32x4v*)(WT + (size_t)(d0 + n) * K + k0 + 8 * c) = o; }
    asm volatile("s_waitcnt lgkmcnt(0)" ::: "memory");
}
__device__ __forceinline__ void transpose_matrix(const float* W, int K, int N, bf16* WT, const float* gain, LAS float* scr, int gw, int ngw, int lane, bool ffn_perm = false) {
    const int items = (K / 64) * (N / 64);
    for (int it = gw; it < items; it += ngw) transpose_item(W, K, N, WT, gain, scr, it, lane, ffn_perm);
}
__device__ __forceinline__ void prologue_phase(const Args& a, LAS unsigned char* lds, int tid, int wave, int lane) {
    unsigned char* ws = a.ws;
    const int G = gridDim.x, gw = blockIdx.x * NW + wave, ngw = G * NW;
    { stat_t* z = (stat_t*)(ws + WS_RS) + M; const int n = 10 * M; for (int i = blockIdx.x * 512 + tid; i < n; i += G * 512) z[i] = 0ull; }
    LAS float* scr = (LAS float*)(lds + wave * 16640);
    const float* mixn = a.in[3]; const float* ffnn = a.in[4];
#pragma unroll 1
    for (int j = 0; j < 2; ++j) {
        transpose_matrix(a.in[6] + (size_t)j * 2048 * 4096, 2048, 4096, (bf16*)(ws + WS_AIN + j * SZ_AIN), mixn + (2 * j) * 2048, scr, gw, ngw, lane);
        transpose_matrix(a.in[11] + (size_t)j * 2048 * 2048, 2048, 2048, (bf16*)(ws + WS_AOUT + j * SZ_SQ), nullptr, scr, gw, ngw, lane);
        transpose_matrix(a.in[12] + (size_t)j * 2048 * 3072, 2048, 3072, (bf16*)(ws + WS_BQKV + j * SZ_QKV), mixn + (2 * j + 1) * 2048, scr, gw, ngw, lane);
        transpose_matrix(a.in[14] + (size_t)j * 2048 * 2048, 2048, 2048, (bf16*)(ws + WS_BOUT + j * SZ_SQ), nullptr, scr, gw, ngw, lane);
    }
#pragma unroll 1
    for (int i = 0; i < 4; ++i) {
        transpose_matrix(a.in[15] + (size_t)i * 2048 * NZ, 2048, NZ, (bf16*)(ws + WS_FIN + i * SZ_FIN), ffnn + i * 2048, scr, gw, ngw, lane, true);
        transpose_matrix(a.in[18] + (size_t)i * DFF * 2048, DFF, 2048, (bf16*)(ws + WS_FOUT + i * SZ_FOUT), nullptr, scr, gw, ngw, lane);
    }
    stat_t* rs0 = (stat_t*)(ws + WS_RS); bf16* XB = (bf16*)(ws + WS_XB);
    for (int row = gw; row < M; row += ngw) {
        const float* src = row < ROWS_P ? a.in[0] + (size_t)row * DM : a.in[1] + (size_t)(row - ROWS_P) * DM;
        float ss = 0.f;
#pragma unroll
        for (int j = 0; j < 8; ++j) {
            const f32x4 v = *(const f32x4*)(src + j * 256 + lane * 4);
            u32x2v w; w.x = cvt_pk_bf16(v[0], v[1]); w.y = cvt_pk_bf16(v[2], v[3]);
            const float r0 = bf_lo(w.x), r1 = bf_hi(w.x), r2 = bf_lo(w.y), r3 = bf_hi(w.y);
            ss += (r0 * r0 + r1 * r1) + (r2 * r2 + r3 * r3);
            *(u32x2v*)(XB + (size_t)row * DM + j * 256 + lane * 4) = w;
        }
        ss = wave_sum(ss);
        if (lane == 0) rs0[row] = stat_fix(ss);
    }
}

__device__ __forceinline__ void a2_phase(LAS unsigned char* lds, const float* Wsp, const float* bs, const float* vn, const stat_t* rsv, const bf16* U, const bf16* VT, bf16* Y,
                                         int tid, int wave, int lane) {
    const int fr = lane & 15, fq = lane >> 4;
    const int q4 = (tid & 31) * 4, p0 = tid >> 5;
    const int crow = 8 * (fr >> 2) + (fr & 3);
    for (int unit = blockIdx.x; unit < 192 * 8; unit += gridDim.x) {
        const int g = unit & 7, chunk = unit >> 3, row0 = chunk * 128;
        f32x4 wv[8];
#pragma unroll
        for (int i = 0; i < 8; ++i) wv[i] = *(const f32x4*)(Wsp + (size_t)(g * 128 + p0 + 16 * i) * 128 + q4);
        stat_t sq[4];
#pragma unroll
        for (int k = 0; k < 4; ++k) sq[k] = rsv[row0 + q4 + k];
        bf16x8 vf[2][4];
#pragma unroll
        for (int cf = 0; cf < 2; ++cf)
#pragma unroll
            for (int ks = 0; ks < 4; ++ks) vf[cf][ks] = *(const bf16x8*)(VT + ((size_t)chunk * 2048 + 256 * g + 32 * wave + crow + 4 * cf) * 128 + 32 * ks + 8 * fq);
        const int c0 = 256 * g + 32 * wave + 8 * fq;
        u32x4v uu[8]; float bsv[8];
#pragma unroll
        for (int pf = 0; pf < 8; ++pf) { uu[pf] = *(const u32x4v*)(U + (size_t)(row0 + 16 * pf + fr) * AW + c0); bsv[pf] = bs[g * 128 + 16 * pf + fr]; }
        const f32x4 vn0 = *(const f32x4*)(vn + c0), vn1 = *(const f32x4*)(vn + c0 + 4);
        __syncthreads();
        float rv[4];
#pragma unroll
        for (int k = 0; k < 4; ++k) rv[k] = rsqrtf((float)sq[k] * (STAT_INV / 2048.f) + EPS);
#pragma unroll
        for (int i = 0; i < 8; ++i) {
            u32x2v o; o.x = cvt_pk_bf16(wv[i][0] * rv[0], wv[i][1] * rv[1]); o.y = cvt_pk_bf16(wv[i][2] * rv[2], wv[i][3] * rv[3]);
            *(LAS u32x2v*)(lds + ((p0 + 16 * i) * 136 + q4) * 2) = o;
        }
        __syncthreads();
        f32x4 acc[8][2];
#pragma unroll
        for (int pf = 0; pf < 8; ++pf)
#pragma unroll
            for (int cf = 0; cf < 2; ++cf) acc[pf][cf] = (f32x4){0.f, 0.f, 0.f, 0.f};
#pragma unroll
        for (int pf = 0; pf < 8; ++pf)
#pragma unroll
            for (int ks = 0; ks < 4; ++ks) {
                const bf16x8 wf = *(const LAS bf16x8*)(lds + ((16 * pf + fr) * 136 + 32 * ks + 8 * fq) * 2);
#pragma unroll
                for (int cf = 0; cf < 2; ++cf) acc[pf][cf] = __builtin_amdgcn_mfma_f32_16x16x32_bf16(vf[cf][ks], wf, acc[pf][cf], 0, 0, 0);
            }
#pragma unroll
        for (int pf = 0; pf < 8; ++pf) {
            const float b = bsv[pf]; const f32x4 s0 = acc[pf][0], s1 = acc[pf][1]; const u32x4v u4 = uu[pf];
            u32x4v o;
            o.x = cvt_pk_bf16(bf_lo(u4.x) * (s0[0] * vn0[0] + b), bf_hi(u4.x) * (s0[1] * vn0[1] + b));
            o.y = cvt_pk_bf16(bf_lo(u4.y) * (s0[2] * vn0[2] + b), bf_hi(u4.y) * (s0[3] * vn0[3] + b));
            o.z = cvt_pk_bf16(bf_lo(u4.z) * (s1[0] * vn1[0] + b), bf_hi(u4.z) * (s1[1] * vn1[1] + b));
            o.w = cvt_pk_bf16(bf_lo(u4.w) * (s1[2] * vn1[2] + b), bf_hi(u4.w) * (s1[3] * vn1[3] + b));
            *(u32x4v*)(Y + (size_t)(row0 + 16 * pf + fr) * AW + c0) = o;
        }
    }
}

__device__ __forceinline__ int t5_bucket(int rel) {
    const int n = rel < 0 ? -rel : rel; int b;
    if (n < 8) b = n; else { b = 8 + (n >= 12) + (n >= 16) + (n >= 23) + (n >= 32) + (n >= 46) + (n >= 64) + (n >= 91) + (n >= 128); if (b > 15) b = 15; }
    return b + (rel > 0 ? 16 : 0);
}
constexpr int AT_KS = 0, AT_VS = 34816, AT_TB = 69632;
__device__ __forceinline__ void attn_seq(int row0, int& s0, int& s1) {
    if (row0 < ROWS_P) { s0 = row0 & ~(SEQ_P - 1); s1 = s0 + SEQ_P; } else { s0 = ROWS_P + ((row0 - ROWS_P) & ~(SEQ_S - 1)); s1 = s0 + SEQ_S; }
}
__device__ __forceinline__ void attn_phase(LAS unsigned char* lds, const bf16* Q, const bf16* Kb, const bf16* VT, bf16* O, const float* rel_bias, const float* sink,
                                           int tid, int wave, int lane) {
    constexpr int NU = 192 * 8;
    const int fr = lane & 15, fq = lane >> 4, hh = wave >> 2, wq = wave & 3;
    const int G = gridDim.x;
    LAS float* tb = (LAS float*)(lds + AT_TB);
    const int sr = tid >> 4, scc = (tid & 15) * 8;
    int unit = blockIdx.x;
    if (unit >= NU) return;
    int s0, s1; attn_seq((unit >> 3) * 128, s0, s1);
    int kb = ((unit >> 3) * 128 - 128 >= s0) ? -1 : 0;
    bool ustart = true;
    bf16x8 Qf[2][4]; float l_run[2]; f32x4 Oacc[2][8];
#pragma unroll 1
    while (unit < NU) {
        const int hp = unit & 1, kvh = (unit >> 1) & 3, row0 = (unit >> 3) * 128, h = kvh * 4 + hp * 2 + hh;
        int nunit = unit, nkb = kb + 1;
        if (nkb > 1 || row0 + nkb * 128 >= s1) { nunit = unit + G; nkb = 0; if (nunit < NU) { int t0, t1; attn_seq((nunit >> 3) * 128, t0, t1); nkb = ((nunit >> 3) * 128 - 128 >= t0) ? -1 : 0; } }
        u32x4v kreg[4], vreg[4];
        {   const int kr0 = row0 + kb * 128;
#pragma unroll
            for (int i = 0; i < 4; ++i) { kreg[i] = *(const u32x4v*)(Kb + (size_t)(kr0 + sr + 32 * i) * 512 + kvh * 128 + scc); vreg[i] = *(const u32x4v*)(VT + (size_t)(kvh * 128 + sr + 32 * i) * M + kr0 + scc); } }
        if (ustart) {
#pragma unroll
            for (int qf = 0; qf < 2; ++qf)
#pragma unroll
                for (int ks = 0; ks < 4; ++ks) Qf[qf][ks] = *(const bf16x8*)(Q + (size_t)(row0 + wq * 32 + qf * 16 + fr) * DM + h * 128 + 32 * ks + 8 * fq);
#pragma unroll
            for (int qf = 0; qf < 2; ++qf) { l_run[qf] = (fq == 0) ? 1.0f : 0.0f;
#pragma unroll
                for (int a = 0; a < 8; ++a) Oacc[qf][a] = (f32x4){0.f, 0.f, 0.f, 0.f}; }
        }
        __syncthreads();
#pragma unroll
        for (int i = 0; i < 4; ++i) { *(LAS u32x4v*)(lds + AT_KS + ((sr + 32 * i) * 136 + scc) * 2) = kreg[i]; *(LAS u32x4v*)(lds + AT_VS + ((sr + 32 * i) * 136 + scc) * 2) = vreg[i]; }
        if (ustart) {
#pragma unroll
            for (int i = 0; i < 2; ++i) { const int e = tid + 512 * i, th = e >> 9, rel = (e & 511) - 256, hd = kvh * 4 + hp * 2 + th; const bool in = rel >= -128 && rel <= 128;
                tb[e] = in ? (rel_bias[t5_bucket(rel) * 16 + hd] - sink[hd]) * LOG2E : -INFINITY; }
        }
        __syncthreads();
        {
        const int kt_lo = (kb == -1) ? wq : 0, kt_hi = (kb == 1) ? wq : 3;
        bf16x8 kf[2][4];
#pragma unroll
        for (int t = 0; t < 2; ++t)
#pragma unroll
            for (int ks = 0; ks < 4; ++ks) kf[t][ks] = *(const LAS bf16x8*)(lds + AT_KS + ((32 * kt_lo + 16 * t + fr) * 136 + 32 * ks + 8 * fq) * 2);
#pragma unroll 1
        for (int kt = kt_lo; kt <= kt_hi; ++kt) {
            f32x4 S[2][2];
#pragma unroll
            for (int qf = 0; qf < 2; ++qf)
#pragma unroll
                for (int t = 0; t < 2; ++t) S[qf][t] = (f32x4){0.f, 0.f, 0.f, 0.f};
#pragma unroll
            for (int t = 0; t < 2; ++t)
#pragma unroll
                for (int ks = 0; ks < 4; ++ks)
#pragma unroll
                    for (int qf = 0; qf < 2; ++qf) S[qf][t] = __builtin_amdgcn_mfma_f32_16x16x32_bf16(kf[t][ks], Qf[qf][ks], S[qf][t], 0, 0, 0);
            __builtin_amdgcn_sched_barrier(0);
            const LAS float* tp0 = tb + hh * 512 + (kb * 128 + 32 * kt + 4 * fq - (wq * 32 + fr) + 256);
            float bias[2][8];
#pragma unroll
            for (int qf = 0; qf < 2; ++qf)
#pragma unroll
                for (int t = 0; t < 2; ++t)
#pragma unroll
                    for (int i = 0; i < 4; ++i) bias[qf][4 * t + i] = tp0[16 * t + i - 16 * qf];
            u32x2v vr[4][2], vr2[4][2];
#pragma unroll
            for (int a = 0; a < 4; ++a) {
                vr[a][0] = *(const LAS u32x2v*)(lds + AT_VS + ((16 * a + fr) * 136 + 32 * kt + 4 * fq) * 2);
                vr[a][1] = *(const LAS u32x2v*)(lds + AT_VS + ((16 * a + fr) * 136 + 32 * kt + 16 + 4 * fq) * 2);
            }
            bf16x8 pf[2];
#pragma unroll
            for (int qf = 0; qf < 2; ++qf) {
                float p[8]; float ps = 0.f;
#pragma unroll
                for (int t = 0; t < 2; ++t)
#pragma unroll
                    for (int i = 0; i < 4; ++i) { p[4 * t + i] = __builtin_amdgcn_exp2f(S[qf][t][i] + bias[qf][4 * t + i]); ps += p[4 * t + i]; }
                l_run[qf] += ps;
                u32x4v pw; pw.x = cvt_pk_bf16(p[0], p[1]); pw.y = cvt_pk_bf16(p[2], p[3]); pw.z = cvt_pk_bf16(p[4], p[5]); pw.w = cvt_pk_bf16(p[6], p[7]);
                pf[qf] = __builtin_bit_cast(bf16x8, pw);
            }
            __builtin_amdgcn_sched_barrier(0);
#pragma unroll
            for (int a = 0; a < 4; ++a) {
                vr2[a][0] = *(const LAS u32x2v*)(lds + AT_VS + ((16 * (a + 4) + fr) * 136 + 32 * kt + 4 * fq) * 2);
                vr2[a][1] = *(const LAS u32x2v*)(lds + AT_VS + ((16 * (a + 4) + fr) * 136 + 32 * kt + 16 + 4 * fq) * 2);
            }
#pragma unroll
            for (int a = 0; a < 4; ++a) {
                u32x4v vw; vw.x = vr[a][0].x; vw.y = vr[a][0].y; vw.z = vr[a][1].x; vw.w = vr[a][1].y;
                const bf16x8 vf = __builtin_bit_cast(bf16x8, vw);
#pragma unroll
                for (int qf = 0; qf < 2; ++qf) Oacc[qf][a] = __builtin_amdgcn_mfma_f32_16x16x32_bf16(vf, pf[qf], Oacc[qf][a], 0, 0, 0);
            }
            __builtin_amdgcn_sched_barrier(0);
            if (kt < kt_hi) {
#pragma unroll
                for (int t = 0; t < 2; ++t)
#pragma unroll
                    for (int ks = 0; ks < 4; ++ks) kf[t][ks] = *(const LAS bf16x8*)(lds + AT_KS + ((32 * (kt + 1) + 16 * t + fr) * 136 + 32 * ks + 8 * fq) * 2);
            }
#pragma unroll
            for (int a = 0; a < 4; ++a) {
                u32x4v vw; vw.x = vr2[a][0].x; vw.y = vr2[a][0].y; vw.z = vr2[a][1].x; vw.w = vr2[a][1].y;
                const bf16x8 vf = __builtin_bit_cast(bf16x8, vw);
#pragma unroll
                for (int qf = 0; qf < 2; ++qf) Oacc[qf][a + 4] = __builtin_amdgcn_mfma_f32_16x16x32_bf16(vf, pf[qf], Oacc[qf][a + 4], 0, 0, 0);
            }
        }
        }
        if (nunit != unit) {
#pragma unroll
            for (int qf = 0; qf < 2; ++qf) {
                float lt = l_run[qf]; lt += __shfl_xor(lt, 16); lt += __shfl_xor(lt, 32);
                const float inv = 1.0f / lt;
                bf16* orow = O + (size_t)(row0 + wq * 32 + qf * 16 + fr) * DM + h * 128 + 4 * fq;
#pragma unroll
                for (int a = 0; a < 8; ++a) { const f32x4 o = Oacc[qf][a] * inv; u32x2v w; w.x = cvt_pk_bf16(o[0], o[1]); w.y = cvt_pk_bf16(o[2], o[3]); *(u32x2v*)(orow + 16 * a) = w; }
            }
            if (nunit < NU) attn_seq((nunit >> 3) * 128, s0, s1);
        }
        ustart = (nunit != unit); unit = nunit; kb = nkb;
    }
}

__device__ __forceinline__ bool seq_start(int t) { return t == 0 || t == SEQ_P || t == ROWS_P || t == ROWS_P + SEQ_S || t >= M; }
__device__ __forceinline__ void ffn_fix_phase(const float* HZ, const float* cw, const float* cb, bf16* ACT, int tid) {
    constexpr int NC4 = DFF / 4;
    const int total = 192 * NC4;
    const f32x4 zero4 = (f32x4){0.f, 0.f, 0.f, 0.f};
    for (int it = blockIdx.x * 512 + tid; it < total; it += gridDim.x * 512) {
        const int ri = it / NC4, c4 = it - ri * NC4, pm = ri >> 1, last = ri & 1, t = pm * 256 + last * 255, ch = 4 * c4;
        const int gi = (ch >> 7) * 256 + (ch & 127), ui = gi + 128;
        const float* hp = last ? HZ + (size_t)(pm * 4 + 2) * NZ : (seq_start(t) ? nullptr : HZ + (size_t)(pm * 4 - 1) * NZ);
        const float* hc = HZ + (size_t)(pm * 4 + (last ? 3 : 0)) * NZ;
        const float* hn = last ? (seq_start(t + 1) ? nullptr : HZ + (size_t)(pm * 4 + 4) * NZ) : HZ + (size_t)(pm * 4 + 1) * NZ;
        const f32x4 pg = hp ? *(const f32x4*)(hp + gi) : zero4, pu = hp ? *(const f32x4*)(hp + ui) : zero4;
        const f32x4 cg_ = *(const f32x4*)(hc + gi), cu = *(const f32x4*)(hc + ui);
        const f32x4 ng = hn ? *(const f32x4*)(hn + gi) : zero4, nu = hn ? *(const f32x4*)(hn + ui) : zero4;
        const f32x4 w0g = *(const f32x4*)(cw + ch), w1g = *(const f32x4*)(cw + NZ + ch), w2g = *(const f32x4*)(cw + 2 * NZ + ch), bg = *(const f32x4*)(cb + ch);
        const f32x4 w0u = *(const f32x4*)(cw + DFF + ch), w1u = *(const f32x4*)(cw + NZ + DFF + ch), w2u = *(const f32x4*)(cw + 2 * NZ + DFF + ch), bu = *(const f32x4*)(cb + DFF + ch);
        float o[4];
#pragma unroll
        for (int j = 0; j < 4; ++j) {
            const float g = w0g[j] * pg[j] + w1g[j] * cg_[j] + w2g[j] * ng[j] + bg[j];
            const float u = w0u[j] * pu[j] + w1u[j] * cu[j] + w2u[j] * nu[j] + bu[j];
            o[j] = pg8::silu_f(g) * u;
        }
        u32x2v w; w.x = cvt_pk_bf16(o[0], o[1]); w.y = cvt_pk_bf16(o[2], o[3]);
        *(u32x2v*)(ACT + (size_t)t * DFF + ch) = w;
    }
}

__device__ __forceinline__ void quant_rows_phase(const bf16* src, unsigned char* dst, float* scale, int R, int wave, int lane) {
    const int gw = blockIdx.x * NW + wave, ngw = gridDim.x * NW;
    for (int row = gw; row < R; row += ngw) {
        const u32x4v* p = (const u32x4v*)(src + (size_t)row * 2048 + lane * 32);
        u32x4v v[4];
#pragma unroll
        for (int i = 0; i < 4; ++i) v[i] = p[i];
        float f[32]; float mx = 0.f;
#pragma unroll
        for (int i = 0; i < 4; ++i)
#pragma unroll
            for (int k = 0; k < 4; ++k) { f[8 * i + 2 * k] = bf_lo(v[i][k]); f[8 * i + 2 * k + 1] = bf_hi(v[i][k]); mx = fmaxf(mx, fmaxf(fabsf(f[8 * i + 2 * k]), fabsf(f[8 * i + 2 * k + 1]))); }
#pragma unroll
        for (int o = 1; o < 64; o <<= 1) mx = fmaxf(mx, __shfl_xor(mx, o));
        const float inv = mx > 0.f ? 127.0f / mx : 0.f;
        if (lane == 0) scale[row] = mx * (1.0f / 127.0f);
        u32x4v o[2];
#pragma unroll
        for (int d = 0; d < 8; ++d) {
            const int q0 = (int)__builtin_rintf(f[4 * d] * inv), q1 = (int)__builtin_rintf(f[4 * d + 1] * inv), q2 = (int)__builtin_rintf(f[4 * d + 2] * inv), q3 = (int)__builtin_rintf(f[4 * d + 3] * inv);
            o[d >> 2][d & 3] = (unsigned)(q0 & 255) | ((unsigned)(q1 & 255) << 8) | ((unsigned)(q2 & 255) << 16) | ((unsigned)q3 << 24);
        }
        u32x4v* q = (u32x4v*)(dst + (size_t)row * 2048 + lane * 32);
        q[0] = o[0]; q[1] = o[1];
    }
}

__device__ __forceinline__ void final_phase(const bf16* XB, float* out, const stat_t* rs, const float* gain, int wave, int lane) {
    const int gw = blockIdx.x * NW + wave, ngw = gridDim.x * NW;
    for (int row = gw; row < M; row += ngw) {
        const float r = rsqrtf((float)rs[row] * (STAT_INV / 2048.f) + EPS);
#pragma unroll
        for (int j = 0; j < 8; ++j) {
            const u32x2v w = *(const u32x2v*)(XB + (size_t)row * DM + j * 256 + lane * 4);
            const f32x4 g = *(const f32x4*)(gain + j * 256 + lane * 4);
            f32x4 v; v[0] = bf_lo(w.x) * r * g[0]; v[1] = bf_hi(w.x) * r * g[1]; v[2] = bf_lo(w.y) * r * g[2]; v[3] = bf_hi(w.y) * r * g[3];
            *(f32x4*)(out + (size_t)row * DM + j * 256 + lane * 4) = v;
        }
    }
}

#define XB_TMO      128
#define XB_XCNT(j)  (256  + 64 * (j))
#define XB_XSUB(j)  (1280 + 64 * (j))
#define XB_XGEN(j)  (2304 + 64 * (j))
#define XB_TOP      3328
#define XB_TOPGEN   3392
#define XCD_BAR_WORDS 3456
#define XB_SPIN_CAP (1u << 18)

__device__ __forceinline__ unsigned xb_ld(unsigned* p)              { return __hip_atomic_load(p, __ATOMIC_RELAXED, __HIP_MEMORY_SCOPE_AGENT); }
__device__ __forceinline__ unsigned xb_add(unsigned* p, unsigned v) { return __hip_atomic_fetch_add(p, v, __ATOMIC_RELAXED, __HIP_MEMORY_SCOPE_AGENT); }
__device__ __forceinline__ unsigned xb_xcc_id() { return (unsigned)__builtin_amdgcn_s_getreg((3 << 11) | 20) & 0xFu; }
#define XB_SPIN(cond, bar) do { unsigned _sp = 0; while (cond) { __builtin_amdgcn_s_sleep(1); \
    if ((++_sp & 255u) == 0u) { if (xb_ld(&(bar)[XB_TMO])) break; if (_sp > XB_SPIN_CAP) { atomicAdd(&(bar)[XB_TMO], 1u); break; } } } } while (0)

struct XcdBarrier {
    unsigned* bar; unsigned x;
    volatile LAS unsigned* st;
};

__device__ __forceinline__ XcdBarrier xcd_barrier_post(unsigned* bar, volatile LAS unsigned* st) {
    XcdBarrier b; b.bar = bar; b.x = xb_xcc_id(); b.st = st;
    if (threadIdx.x == 0) (void)xb_add(&bar[XB_XCNT(b.x)], 1u);
    return b;
}
__device__ __forceinline__ void xcd_barrier_complete(unsigned* bar, unsigned x, unsigned& nloc, unsigned& nx) {
    const unsigned G = gridDim.x * gridDim.y * gridDim.z;
    unsigned sum, cnt, mine, sp = 0u;
    for (;;) {
        sum = 0u; cnt = 0u; mine = 0u;
#pragma unroll
        for (unsigned j = 0; j < 16; ++j) { const unsigned c = xb_ld(&bar[XB_XCNT(j)]); sum += c; cnt += (c > 0u) ? 1u : 0u; mine = (j == x) ? c : mine; }
        if (sum == G) break;
        __builtin_amdgcn_s_sleep(1);
        if ((++sp & 255u) == 0u) { if (xb_ld(&bar[XB_TMO])) break; if (sp > XB_SPIN_CAP) { atomicAdd(&bar[XB_TMO], 1u); break; } }
    }
    nloc = mine > 0u ? mine : 1u; nx = cnt > 0u ? cnt : 1u;
}

__device__ __forceinline__ void xcd_barrier(const XcdBarrier& b) {
    asm volatile("s_waitcnt vmcnt(0)" ::: "memory");
    __syncthreads();
    if (threadIdx.x == 0) {
        unsigned* bar = b.bar;
        __builtin_amdgcn_s_waitcnt(0);
        unsigned nloc = b.st[0], nx = b.st[1];
        if (nloc == 0u) { xcd_barrier_complete(bar, b.x, nloc, nx); b.st[0] = nloc; b.st[1] = nx; }
        const unsigned old = xb_add(&bar[XB_XSUB(b.x)], 1u);
        const unsigned gen = old / nloc;
        if (old + 1u == (gen + 1u) * nloc) {
            __builtin_amdgcn_fence(__ATOMIC_RELEASE, "agent");
            asm volatile("s_waitcnt vmcnt(0)" ::: "memory");
            const unsigned og = xb_add(&bar[XB_TOP], 1u);
            const unsigned tg = og / nx;
            if (og + 1u == (tg + 1u) * nx) xb_add(&bar[XB_TOPGEN], 1u);
            else XB_SPIN(xb_ld(&bar[XB_TOPGEN]) == tg, bar);
            __builtin_amdgcn_fence(__ATOMIC_ACQUIRE, "agent");
            xb_add(&bar[XB_XGEN(b.x)], 1u);
            asm volatile("s_waitcnt vmcnt(0)" ::: "memory");
        } else {
            XB_SPIN(xb_ld(&bar[XB_XGEN(b.x)]) == gen, bar);
            __builtin_amdgcn_fence(__ATOMIC_ACQUIRE, "agent");
            asm volatile("s_waitcnt vmcnt(0)" ::: "memory");
        }
    }
    __syncthreads();
}

constexpr int N_PHASES = 35;
__global__ void __launch_bounds__(NW * 64, 2) fwd_kernel(Args a) {
    extern __shared__ __attribute__((aligned(16))) unsigned char lds_raw[];
    LAS unsigned char* lds = (LAS unsigned char*)lds_raw;
    unsigned char* ws = a.ws;
    stat_t* RS = (stat_t*)(ws + WS_RS); stat_t* RSV = RS + 9 * M;
    bf16* XB = (bf16*)(ws + WS_XB); bf16* ACT = (bf16*)(ws + WS_ACT); unsigned char* R = ws + WS_R;
    const int G = gridDim.x;
    if (threadIdx.x < 4) ((LAS unsigned*)(lds + BARST_OFF))[threadIdx.x] = 0u;
    if (a.ph_lo == 0 && blockIdx.x == 0) { unsigned* bw = (unsigned*)(ws + WS_BAR); for (int i = threadIdx.x; i < XCD_BAR_WORDS; i += NW * 64) bw[i] = 0u; }
    __syncthreads();
    XcdBarrier bar; bar.bar = (unsigned*)(ws + WS_BAR); bar.x = 0; bar.st = (volatile LAS unsigned*)(lds + BARST_OFF);
#pragma unroll 1
    for (int ph = a.ph_lo; ph < a.ph_hi; ++ph) {
        int tid_ = threadIdx.x; asm volatile("" : "+v"(tid_));
        const int tid = tid_, lane = tid & 63, wave = __builtin_amdgcn_readfirstlane(tid >> 6);
        int bx_ = blockIdx.x; asm volatile("" : "+s"(bx_)); const int bx = bx_;
        if (ph == 0) prologue_phase(a, lds, tid, wave, lane);
        else if (ph == 1) { quant_rows_phase((const bf16*)(ws + WS_FIN), ws + WS_FINQ, (float*)(ws + WS_SW), 4 * NZ, wave, lane);
                            quant_rows_phase((const bf16*)(ws + WS_BQKV), ws + WS_QKVQ, (float*)(ws + WS_SWQ), 2 * NQKV, wave, lane); }
        else if (ph == N_PHASES - 1) final_phase(XB, a.out, RS + 8 * M, a.in[5], wave, lane);
        else {
            const int li = (ph - 2) / 8, sp8 = (ph - 2) % 8, j = li >> 1; const bool isA = (li & 1) == 0;
            if (sp8 == 0 && isA) continue;
            const int sp = sp8 == 0 ? -1 : (sp8 < 4 ? sp8 - 1 : sp8 - 2);
            if (sp8 == 0 || sp8 == 4) quant_rows_phase(XB, ws + WS_XQ, (float*)(ws + WS_SX), M, wave, lane); else
            if (sp == 0 && isA) {
                pg8::Gemm g{XB, (const bf16*)(ws + WS_AIN + j * SZ_AIN), M, 4096, 2048}; pg8::StaticOrder S; S.init(M, 4096, G, bx);
                pg8::EpiGeluUV E{RS + (2 * li) * M, a.in[7] + j * 4096, (bf16*)(R + R_U), (bf16*)(R + R_VT2), RSV + j * M};
                pg8::gemm_phase<pg8::EpiGeluUV, pg8::StaticOrder, true, true>(lds, g, S, E);
            } else if (sp == 0) {
                pg8::Gemm g{(const bf16*)(ws + WS_XQ), (const bf16*)(ws + WS_QKVQ + (size_t)j * NQKV * 2048), M, NQKV, 1024}; pg8::StaticOrder S; S.init(M, NQKV, G, bx);
                pg8::EpiQKV E{RS + (2 * li) * M, (bf16*)(R + R_Q), (bf16*)(R + R_K), (bf16*)(R + R_VTA), 0.08838834764831845f * LOG2E, (const float*)(ws + WS_SX), (const float*)(ws + WS_SWQ) + (size_t)j * NQKV};
                pg8::gemm_phase<pg8::EpiQKV, pg8::StaticOrder, true, true>(lds, g, S, E);
            } else if (sp == 1 && isA) {
                a2_phase(lds, a.in[9] + (size_t)j * 8 * 128 * 128, a.in[10] + j * 8 * 128, a.in[8] + j * 2048, RSV + j * M, (const bf16*)(R + R_U), (const bf16*)(R + R_VT2), (bf16*)(R + R_Y), tid, wave, lane);
            } else if (sp == 1) {
                attn_phase(lds, (const bf16*)(R + R_Q), (const bf16*)(R + R_K), (const bf16*)(R + R_VTA), (bf16*)(R + R_O), a.in[2], a.in[13] + j * 16, tid, wave, lane);
            } else if (sp == 2 || sp == 5) {
                const bf16* A; const bf16* Bt; int K; stat_t* rsn;
                if (sp == 2) { A = isA ? (const bf16*)(R + R_Y) : (const bf16*)(R + R_O); Bt = isA ? (const bf16*)(ws + WS_AOUT + j * SZ_SQ) : (const bf16*)(ws + WS_BOUT + j * SZ_SQ); K = 2048; rsn = RS + (2 * li + 1) * M; }
                else { A = ACT; Bt = (const bf16*)(ws + WS_FOUT + li * SZ_FOUT); K = DFF; rsn = RS + (2 * li + 2) * M; }
                pg8::Gemm g{A, Bt, M, 2048, K}; pg8::StaticOrder S; S.init(M, 2048, G, bx);
                pg8::EpiResid E{XB, rsn};
                pg8::gemm_phase<pg8::EpiResid, pg8::StaticOrder, true, true>(lds, g, S, E);
            } else if (sp == 3) {
                pg8::Gemm g{(const bf16*)(ws + WS_XQ), (const bf16*)(ws + WS_FINQ + (size_t)li * NZ * 2048), M, NZ, 1024}; pg8::StaticOrder S; S.init(M, NZ, G, bx);
                pg8::EpiConvGate E{RS + (2 * li + 1) * M, a.in[16] + (size_t)li * 3 * NZ, a.in[17] + (size_t)li * NZ, ACT, (float*)(ws + WS_HZ), lds + XCH_OFF, (const float*)(ws + WS_SX), (const float*)(ws + WS_SW) + (size_t)li * NZ};
                pg8::gemm_phase<pg8::EpiConvGate, pg8::StaticOrder, true, true>(lds, g, S, E);
            } else {
                ffn_fix_phase((const float*)(ws + WS_HZ), a.in[16] + (size_t)li * 3 * NZ, a.in[17] + (size_t)li * NZ, ACT, tid);
            }
        }
        if (a.coop && ph + 1 < a.ph_hi) {
            if (ph == 0) { cg::this_grid().sync(); bar = xcd_barrier_post((unsigned*)(ws + WS_BAR), (volatile LAS unsigned*)(lds + BARST_OFF)); }
            else xcd_barrier(bar);
        }
    }
}

extern "C" void kernel_launch(void* const* d_in, const int* in_sizes, int n_in, void* d_out, int out_size, void* d_ws, size_t ws_size, hipStream_t stream) {
    static int grid = 0;
    if (grid == 0) {
        if (n_in != 19 || out_size != M * DM || ws_size < WS_END) { fprintf(stderr, "kernel_launch: unexpected shapes (n_in %d out %d ws %zu need %zu)\n", n_in, out_size, ws_size, (size_t)WS_END); grid = -1; return; }
        int dev = 0, cus = 0, per_cu = 0;
        hipGetDevice(&dev); hipDeviceGetAttribute(&cus, hipDeviceAttributeMultiprocessorCount, dev);
        hipFuncSetAttribute((const void*)fwd_kernel, hipFuncAttributeMaxDynamicSharedMemorySize, LDS_BYTES);
        if (hipOccupancyMaxActiveBlocksPerMultiprocessor(&per_cu, (const void*)fwd_kernel, NW * 64, LDS_BYTES) != hipSuccess || per_cu < 1) { fprintf(stderr, "kernel_launch: occupancy query says %d\n", per_cu); per_cu = 1; }
        (void)hipGetLastError();
        grid = cus > 0 ? cus : 256;
    }
    if (grid < 0) return;
    Args a{};
    for (int i = 0; i < 19; ++i) a.in[i] = (const float*)d_in[i];
    a.out = (float*)d_out; a.ws = (unsigned char*)d_ws; a.pad = 0;
#if MK_COOP
    a.ph_lo = 0; a.ph_hi = N_PHASES; a.coop = 1;
    void* kargs[] = {&a};
    hipError_t e = hipLaunchCooperativeKernel((const void*)fwd_kernel, dim3(grid), dim3(NW * 64), kargs, LDS_BYTES, stream);
    if (e != hipSuccess) fprintf(stderr, "cooperative launch failed: %s (grid %d)\n", hipGetErrorString(e), grid);
#else
    a.coop = 0;
    for (int ph = 0; ph < N_PHASES; ++ph) { a.ph_lo = ph; a.ph_hi = ph + 1; hipLaunchKernelGGL(fwd_kernel, dim3(grid), dim3(NW * 64), LDS_BYTES, stream, a); }
#endif
}
```

```cpp
#include <hip/hip_runtime.h>
#include <hip/hip_cooperative_groups.h>
#include <cstdio>
#include <cstdint>
namespace cg = cooperative_groups;
#ifndef MK_COOP
#define MK_COOP 1
#endif
namespace pg8 {
#define PG8_LAS __attribute__((address_space(3)))
typedef unsigned short bf16_t;
typedef short bf16x8 __attribute__((ext_vector_type(8)));
typedef float f32x4 __attribute__((ext_vector_type(4)));
typedef unsigned u32x4 __attribute__((ext_vector_type(4)));
constexpr int BM = 256, BK = 64, HALF = 128, HTB = HALF * BK * 2  , STAGE_BYTES = 8 * HTB, NXCD = 8, WGM = 4;

__host__ __device__ __forceinline__ int lds_byte(int r, int c) { const int st = (r >> 4) * 2 + (c >> 5), rr = r & 15, cc = c & 31, ob = rr * 64 + cc * 2; return st * 1024 + (ob ^ (((ob >> 9) & 1) << 5)); }
__host__ __device__ __forceinline__ void stage_rc(int b, int& R, int& C) { const int st = b / 1024, sb = b % 1024, swz = sb ^ (((sb >> 9) & 1) << 5); R = (st >> 1) * 16 + swz / 64; C = (st & 1) * 32 + (swz % 64) / 2; }
__host__ __device__ __forceinline__ int perm32(int rho) { const int n = rho >> 4, i = rho & 15; return 8 * (i >> 2) + 4 * n + (i & 3); }

struct Unit { int pm, pn; };
struct Gemm { const bf16_t* A; const bf16_t* Bt; int M, N, K; };

struct StaticOrder {
    int nM, nN, nwg, G, c;
    __host__ __device__ void init(int M, int N, int G_, int c_) { nM = M / BM; nN = N / BM; nwg = nM * nN; G = G_; c = c_; }
    __host__ __device__ bool next(int i, Unit& u) const {
        const long L = (long)i * G + c; if (L >= nwg) return false;
        int wgid = (int)L; { const int q = nwg / NXCD, r = nwg % NXCD, xcd = wgid % NXCD, off = wgid / NXCD; wgid = (xcd < r ? xcd * (q + 1) : r * (q + 1) + (xcd - r) * q) + off; }
        const int nig = WGM * nN, gid = wgid / nig, fm = gid * WGM, gsz = (nM - fm) < WGM ? (nM - fm) : WGM;
        u.pm = fm + ((wgid % nig) % gsz); u.pn = (wgid % nig) / gsz; return true;
    }
    __device__ __forceinline__ void a_ready(const Unit&) const {}
    __device__ __forceinline__ void done(const Unit&) const {}
};

__device__ __forceinline__ unsigned cvt_pk_bf16(float lo, float hi) { unsigned r; asm volatile("v_cvt_pk_bf16_f32 %0, %1, %2" : "=v"(r) : "v"(lo), "v"(hi)); return r; }

constexpr int MROWS = 24576;
constexpr float NORM_EPS = 1e-6f;
typedef unsigned long long stat_t;
constexpr float STAT_SCALE = 16777216.0f, STAT_INV = 1.0f / 16777216.0f;
__device__ __forceinline__ stat_t stat_fix(float ss) { return (stat_t)(ss * STAT_SCALE + 0.5f); }
__device__ __forceinline__ float rstd2048(const stat_t* rs, int row) { return rsqrtf((float)rs[row] * (STAT_INV / 2048.0f) + NORM_EPS); }
__device__ __forceinline__ float gelu_tanh(float x) {
    const float t = x * (1.5957691216057308f + 0.07135481627f * x * x);
    const float e = __builtin_amdgcn_exp2f(-1.4426950408889634f * t);
    return x * __builtin_amdgcn_rcpf(1.0f + e);
}
__device__ __forceinline__ bf16_t f2bf_rne(float f) { return (bf16_t)(cvt_pk_bf16(f, 0.f) & 0xffffu); }

struct EpiGeluUV {
    static constexpr bool PERM = true, AFTER_DRAIN = false, APERM = true, I8 = false;
    const stat_t* rs; const float* bias; bf16_t* U; bf16_t* VT; stat_t* rsv;
    __device__ __forceinline__ void operator()(const f32x4 (&acc)[2][2][4][2], const Unit& u, int wr, int wc, int fr_, int fq_) const {
        int fr = fr_, fq = fq_; asm volatile("" : "+v"(fr), "+v"(fq));
        typedef unsigned u32x2v __attribute__((ext_vector_type(2)));
        const int rowb = u.pm * BM + wr * 64 + 4 * fr, colt = u.pn * BM, cl = wc * 32 + 8 * fq;
        f32x4 bv[2][2];
#pragma unroll
        for (int bj = 0; bj < 2; ++bj)
#pragma unroll
            for (int n = 0; n < 2; ++n) bv[bj][n] = *(const f32x4*)(bias + colt + bj * HALF + cl + 4 * n);
        const bool isV = u.pn >= 8;
        float rr[2][4];
#pragma unroll
        for (int ai = 0; ai < 2; ++ai)
#pragma unroll
            for (int m = 0; m < 4; ++m) rr[ai][m] = rstd2048(rs, rowb + ai * HALF + m);
#pragma unroll
        for (int ai = 0; ai < 2; ++ai) {
            float ss[4] = {0.f, 0.f, 0.f, 0.f};
#pragma unroll
            for (int bj = 0; bj < 2; ++bj) {
                float v[4][8];
#pragma unroll
                for (int m = 0; m < 4; ++m)
#pragma unroll
                    for (int n = 0; n < 2; ++n)
#pragma unroll
                        for (int j = 0; j < 4; ++j) v[m][4 * n + j] = gelu_tanh(acc[ai][bj][m][n][j] * rr[ai][m] + bv[bj][n][j]);
                if (!isV) {
#pragma unroll
                    for (int m = 0; m < 4; ++m) {
                        u32x4 w; w.x = cvt_pk_bf16(v[m][0], v[m][1]); w.y = cvt_pk_bf16(v[m][2], v[m][3]); w.z = cvt_pk_bf16(v[m][4], v[m][5]); w.w = cvt_pk_bf16(v[m][6], v[m][7]);
                        *(u32x4*)(U + (size_t)(rowb + ai * HALF + m) * 2048 + colt + bj * HALF + cl) = w; }
                } else {
                    const int c0 = colt - 2048 + bj * HALF + cl, row = rowb + ai * HALF;
                    bf16_t* vp = VT + ((size_t)(row >> 7) * 2048 + c0) * 128 + (row & 127);
#pragma unroll
                    for (int j = 0; j < 8; ++j) {
                        u32x2v w; w.x = cvt_pk_bf16(v[0][j], v[1][j]); w.y = cvt_pk_bf16(v[2][j], v[3][j]);
                        *(u32x2v*)(vp + (size_t)j * 128) = w;
#pragma unroll
                        for (int m = 0; m < 4; ++m) ss[m] += v[m][j] * v[m][j];
                    }
                }
            }
            if (isV) {
#pragma unroll
                for (int m = 0; m < 4; ++m) { float s = ss[m]; s += __shfl_xor(s, 16); s += __shfl_xor(s, 32); if (fq == 0) atomicAdd(rsv + rowb + ai * HALF + m, stat_fix(s)); }
            }
        }
    }
};
template <size_t OFF_XQ, size_t OFF_SX, size_t OFF_Q> struct EpiResid {
    static constexpr bool PERM = true, AFTER_DRAIN = false, APERM = false, I8 = false;
    bf16_t* XB; stat_t* rs_next; unsigned char* wsb; int quse;
    __device__ __forceinline__ void operator()(const f32x4 (&acc)[2][2][4][2], const Unit& u, int wr, int wc, int fr_, int fq_) const {
        int tl_ = threadIdx.x; asm volatile("" : "+v"(tl_)); const int fr = tl_ & 15, fq = (tl_ & 63) >> 4; (void)fr_; (void)fq_;
        typedef unsigned u32x2v __attribute__((ext_vector_type(2)));
        const int row0 = u.pm * BM + wr * 64 + fr, col0 = u.pn * BM + wc * 32 + 8 * fq;
        const bool do_q = quse >= 0; unsigned* qbase = (unsigned*)(wsb + OFF_Q); unsigned char* XQ = wsb + OFF_XQ; float* sx = (float*)(wsb + OFF_SX);
        unsigned* rowmax = qbase + (size_t)(do_q ? quse : 0) * MROWS; unsigned* pcnt = qbase + (size_t)6 * MROWS + (size_t)(do_q ? quse : 0) * 6144;
        u32x4 xv[2][4][2];
#pragma unroll
        for (int ai = 0; ai < 2; ++ai)
#pragma unroll
            for (int m = 0; m < 4; ++m)
#pragma unroll
                for (int bj = 0; bj < 2; ++bj) xv[ai][m][bj] = *(const u32x4*)(XB + (size_t)(row0 + ai * HALF + m * 16) * 2048 + col0 + bj * HALF);
#pragma unroll
        for (int ai = 0; ai < 2; ++ai)
#pragma unroll
            for (int m = 0; m < 4; ++m) {
                const int row = row0 + ai * HALF + m * 16; bf16_t* p = XB + (size_t)row * 2048 + col0; float ss = 0.f, mxl = 0.f;
#pragma unroll
                for (int bj = 0; bj < 2; ++bj) {
#pragma unroll
                    for (int k = 0; k < 4; ++k) {
                        const float lo = __uint_as_float(xv[ai][m][bj][k] << 16) + acc[ai][bj][m][k >> 1][(k & 1) * 2], hi = __uint_as_float(xv[ai][m][bj][k] & 0xffff0000u) + acc[ai][bj][m][k >> 1][(k & 1) * 2 + 1];
                        const unsigned pk = cvt_pk_bf16(lo, hi); xv[ai][m][bj][k] = pk;
                        const float rl = __uint_as_float(pk << 16), rh = __uint_as_float(pk & 0xffff0000u);
                        ss += rl * rl + rh * rh; mxl = fmaxf(mxl, fmaxf(fabsf(rl), fabsf(rh)));
                    }
                    *(u32x4*)(p + bj * HALF) = xv[ai][m][bj];
                }
                ss += __shfl_xor(ss, 16); ss += __shfl_xor(ss, 32); if (fq == 0) atomicAdd(rs_next + row, stat_fix(ss));
                if (do_q) { mxl = fmaxf(mxl, __shfl_xor(mxl, 16)); mxl = fmaxf(mxl, __shfl_xor(mxl, 32)); if (fq == 0) atomicMax(rowmax + row, __float_as_uint(mxl)); }
            }
        if (do_q) {
            asm volatile("s_waitcnt vmcnt(0)" ::: "memory");
            unsigned* pc = pcnt + 64 * u.pm;
            if ((fr | fq) == 0) __hip_atomic_fetch_add(pc, 1u, __ATOMIC_RELAXED, __HIP_MEMORY_SCOPE_AGENT);
            { unsigned sp = 0; while ((unsigned)__builtin_amdgcn_readfirstlane((int)__hip_atomic_load(pc, __ATOMIC_RELAXED, __HIP_MEMORY_SCOPE_AGENT)) < 64u && ++sp < (1u << 20)) __builtin_amdgcn_s_sleep(2); }
#pragma unroll
            for (int ai = 0; ai < 2; ++ai)
#pragma unroll
                for (int m = 0; m < 4; ++m) {
                    const int row = row0 + ai * HALF + m * 16;
                    const float mx = __uint_as_float(__hip_atomic_load(rowmax + row, __ATOMIC_RELAXED, __HIP_MEMORY_SCOPE_AGENT)), inv = mx > 0.f ? 127.0f / mx : 0.f;
                    if (u.pn == 0 && wc == 0 && fq == 0) sx[row] = mx * (1.0f / 127.0f);
#pragma unroll
                    for (int bj = 0; bj < 2; ++bj) {
                        u32x2v o;
#pragma unroll
                        for (int h = 0; h < 2; ++h) {
                            const unsigned w0 = xv[ai][m][bj][2 * h], w1 = xv[ai][m][bj][2 * h + 1];
                            const int q0 = (int)__builtin_rintf(__uint_as_float(w0 << 16) * inv), q1 = (int)__builtin_rintf(__uint_as_float(w0 & 0xffff0000u) * inv);
                            const int q2 = (int)__builtin_rintf(__uint_as_float(w1 << 16) * inv), q3 = (int)__builtin_rintf(__uint_as_float(w1 & 0xffff0000u) * inv);
                            o[h] = (unsigned)(q0 & 255) | ((unsigned)(q1 & 255) << 8) | ((unsigned)(q2 & 255) << 16) | ((unsigned)q3 << 24);
                        }
                        *(u32x2v*)(XQ + (size_t)row * 2048 + col0 + bj * HALF) = o;
                    }
                }
        }
    }
};
struct EpiQKV {
    static constexpr bool PERM = true, AFTER_DRAIN = false, APERM = true, I8 = true;
    const stat_t* rs; bf16_t* Q; bf16_t* Kb; bf16_t* VT; float qscale; const float* sx; const float* sw;
    __device__ __forceinline__ void operator()(const f32x4 (&acc)[2][2][4][2], const Unit& u, int wr, int wc, int fr_, int fq_) const {
        int fr = fr_, fq = fq_; asm volatile("" : "+v"(fr), "+v"(fq));
        typedef unsigned u32x2v __attribute__((ext_vector_type(2)));
        const int rowb = u.pm * BM + wr * 64 + 4 * fr, colt = u.pn * BM, cl = wc * 32 + 8 * fq;
        const bool isq = u.pn < 8;
        const unsigned long long ob = (unsigned long long)(isq ? Q : Kb);
        bf16_t* obase = (bf16_t*)(((unsigned long long)(unsigned)__builtin_amdgcn_readfirstlane((int)(ob >> 32)) << 32) | (unsigned)__builtin_amdgcn_readfirstlane((int)ob));
        const int oldc = isq ? 2048 : 512, ocol = isq ? colt : colt - 2048;
        float rr[2][4];
#pragma unroll
        for (int ai = 0; ai < 2; ++ai)
#pragma unroll
            for (int m = 0; m < 4; ++m) { rr[ai][m] = rstd2048(rs, rowb + ai * HALF + m) * sx[rowb + ai * HALF + m]; if (isq) rr[ai][m] *= qscale; }
        typedef int i32x4 __attribute__((ext_vector_type(4)));
        f32x4 swv[2][2];
#pragma unroll
        for (int bj = 0; bj < 2; ++bj)
#pragma unroll
            for (int n = 0; n < 2; ++n) swv[bj][n] = *(const f32x4*)(sw + colt + bj * HALF + cl + 4 * n);
#define QV(ai_, bj_, m_, n_) (__builtin_convertvector(__builtin_bit_cast(i32x4, acc[ai_][bj_][m_][n_]), f32x4) * swv[bj_][n_])
#pragma unroll
        for (int ai = 0; ai < 2; ++ai)
#pragma unroll
            for (int bj = 0; bj < 2; ++bj) {
                if (u.pn < 10) {
#pragma unroll
                    for (int m = 0; m < 4; ++m) {
                        const f32x4 v0 = QV(ai, bj, m, 0) * rr[ai][m], v1 = QV(ai, bj, m, 1) * rr[ai][m]; const int row = rowb + ai * HALF + m;
                        u32x4 w; w.x = cvt_pk_bf16(v0[0], v0[1]); w.y = cvt_pk_bf16(v0[2], v0[3]); w.z = cvt_pk_bf16(v1[0], v1[1]); w.w = cvt_pk_bf16(v1[2], v1[3]);
                        *(u32x4*)(obase + (size_t)row * oldc + ocol + bj * HALF + cl) = w; }
                } else {
                    bf16_t* vp = VT + (size_t)(colt - 2560 + bj * HALF + cl) * MROWS + rowb + ai * HALF;
#pragma unroll
                    for (int n = 0; n < 2; ++n) {
                        const f32x4 q0 = QV(ai, bj, 0, n) * rr[ai][0], q1 = QV(ai, bj, 1, n) * rr[ai][1], q2 = QV(ai, bj, 2, n) * rr[ai][2], q3 = QV(ai, bj, 3, n) * rr[ai][3];
#pragma unroll
                        for (int j = 0; j < 4; ++j) {
                            u32x2v w; w.x = cvt_pk_bf16(q0[j], q1[j]); w.y = cvt_pk_bf16(q2[j], q3[j]);
                            *(u32x2v*)(vp + (size_t)(4 * n + j) * MROWS) = w; } }
                }
            }
    }
#undef QV
};
__device__ __forceinline__ float dpp_shr1(float old, float v) { return __builtin_bit_cast(float, __builtin_amdgcn_update_dpp(__builtin_bit_cast(int, old), __builtin_bit_cast(int, v), 0x111, 0xf, 0xf, false)); }
__device__ __forceinline__ float dpp_shl1(float old, float v) { return __builtin_bit_cast(float, __builtin_amdgcn_update_dpp(__builtin_bit_cast(int, old), __builtin_bit_cast(int, v), 0x101, 0xf, 0xf, false)); }
__device__ __forceinline__ float fma_s(float a, float b, float c) { float d; asm("v_fma_f32 %0, %1, %2, %3" : "=v"(d) : "v"(a), "v"(b), "v"(c)); return d; }
__device__ __forceinline__ float silu_f(float g) { return g * __builtin_amdgcn_rcpf(1.0f + __builtin_amdgcn_exp2f(-1.4426950408889634f * g)); }
struct EpiConvGate {
    static constexpr bool PERM = true, AFTER_DRAIN = false, APERM = true, I8 = true;
    static constexpr int DFF_ = 5632, NZ_ = 11264;
    const stat_t* rs; const float* cw; const float* cb; bf16_t* ACT; float* HZ; PG8_LAS unsigned char* xch; const float* sx; const float* sw;
    __device__ __forceinline__ void operator()(const f32x4 (&acc)[2][2][4][2], const Unit& u, int wr, int wc, int fr_, int fq_) const {
        typedef unsigned u32x2v __attribute__((ext_vector_type(2)));
        int fr = fr_, fq = fq_; asm volatile("" : "+v"(fr), "+v"(fq));
        f32x4 z[2][2][4][2];
        const int rowb = u.pm * BM + wr * 64 + 4 * fr;
        f32x4 swv[2][2];
#pragma unroll
        for (int bj = 0; bj < 2; ++bj)
#pragma unroll
            for (int n = 0; n < 2; ++n) swv[bj][n] = *(const f32x4*)(sw + u.pn * BM + bj * HALF + wc * 32 + 8 * fq + 4 * n);
#pragma unroll
        for (int ai = 0; ai < 2; ++ai)
#pragma unroll
            for (int m = 0; m < 4; ++m) { const float r = rstd2048(rs, rowb + ai * HALF + m) * sx[rowb + ai * HALF + m];
#pragma unroll
                for (int bj = 0; bj < 2; ++bj)
#pragma unroll
                    for (int n = 0; n < 2; ++n) { typedef int i32x4 __attribute__((ext_vector_type(4)));
                        z[ai][bj][m][n] = __builtin_convertvector(__builtin_bit_cast(i32x4, acc[ai][bj][m][n]), f32x4) * (swv[bj][n] * r); } }
        PG8_LAS f32x4* X4 = (PG8_LAS f32x4*)xch;
#define XIDX(wr_, ai_, fl_) ((((((wr_) * 4 + wc) * 2 + (ai_)) * 2 + (fl_)) * 4 + fq) * 4)
#pragma unroll
        for (int ai = 0; ai < 2; ++ai) {
            if (fr == 0) {
#pragma unroll
                for (int bj = 0; bj < 2; ++bj)
#pragma unroll
                    for (int n = 0; n < 2; ++n) X4[XIDX(wr, ai, 0) + bj * 2 + n] = z[ai][bj][0][n]; }
            if (fr == 15) {
#pragma unroll
                for (int bj = 0; bj < 2; ++bj)
#pragma unroll
                    for (int n = 0; n < 2; ++n) X4[XIDX(wr, ai, 1) + bj * 2 + n] = z[ai][bj][3][n]; }
        }
        {   const int hcol = u.pn * BM + wc * 32 + 8 * fq;
            if (wr == 0 && fr == 0) {
#pragma unroll
                for (int m = 0; m < 2; ++m)
#pragma unroll
                    for (int bj = 0; bj < 2; ++bj)
#pragma unroll
                        for (int n = 0; n < 2; ++n) *(f32x4*)(HZ + (size_t)(u.pm * 4 + m) * NZ_ + hcol + bj * HALF + 4 * n) = z[0][bj][m][n]; }
            if (wr == 1 && fr == 15) {
#pragma unroll
                for (int m = 2; m < 4; ++m)
#pragma unroll
                    for (int bj = 0; bj < 2; ++bj)
#pragma unroll
                        for (int n = 0; n < 2; ++n) *(f32x4*)(HZ + (size_t)(u.pm * 4 + m) * NZ_ + hcol + bj * HALF + 4 * n) = z[1][bj][m][n]; }
        }
        asm volatile("s_waitcnt lgkmcnt(0)" ::: "memory"); __builtin_amdgcn_s_barrier(); asm volatile("" ::: "memory");
        const int ch0 = u.pn * HALF + wc * 32 + 8 * fq;
        const f32x4 zero4 = (f32x4){0.f, 0.f, 0.f, 0.f};
#pragma unroll
        for (int ai = 0; ai < 2; ++ai) {
            unsigned ow[4][4];
#pragma unroll
            for (int n = 0; n < 2; ++n) {
                const int ch = ch0 + 4 * n;
                const f32x4 w0g = *(const f32x4*)(cw + ch), w1g = *(const f32x4*)(cw + NZ_ + ch), w2g = *(const f32x4*)(cw + 2 * NZ_ + ch), bg = *(const f32x4*)(cb + ch);
                const f32x4 w0u = *(const f32x4*)(cw + DFF_ + ch), w1u = *(const f32x4*)(cw + NZ_ + DFF_ + ch), w2u = *(const f32x4*)(cw + 2 * NZ_ + DFF_ + ch), bu = *(const f32x4*)(cb + DFF_ + ch);
                f32x4 pBg = zero4, pBu = zero4, nBg = zero4, nBu = zero4;
                if (wr == 1) { pBg = X4[XIDX(0, ai, 1) + n]; pBu = X4[XIDX(0, ai, 1) + 2 + n]; }
                else if (ai == 1) { pBg = X4[XIDX(1, 0, 1) + n]; pBu = X4[XIDX(1, 0, 1) + 2 + n]; }
                if (wr == 0) { nBg = X4[XIDX(1, ai, 0) + n]; nBu = X4[XIDX(1, ai, 0) + 2 + n]; }
                else if (ai == 0) { nBg = X4[XIDX(0, 1, 0) + n]; nBu = X4[XIDX(0, 1, 0) + 2 + n]; }
                float o[4][4];
#pragma unroll
                for (int h = 0; h < 2; ++h) {
                    typedef float f32x2 __attribute__((ext_vector_type(2)));
#define PAIR(v) (h == 0 ? __builtin_shufflevector(v, v, 0, 1) : __builtin_shufflevector(v, v, 2, 3))
                    const f32x2 g0 = PAIR(z[ai][0][0][n]), g1 = PAIR(z[ai][0][1][n]), g2 = PAIR(z[ai][0][2][n]), g3 = PAIR(z[ai][0][3][n]);
                    const f32x2 u0 = PAIR(z[ai][1][0][n]), u1 = PAIR(z[ai][1][1][n]), u2 = PAIR(z[ai][1][2][n]), u3 = PAIR(z[ai][1][3][n]);
                    const f32x2 pBg2 = PAIR(pBg), nBg2 = PAIR(nBg), pBu2 = PAIR(pBu), nBu2 = PAIR(nBu);
                    f32x2 pg, ng, pu, nu;
                    pg.x = dpp_shr1(pBg2.x, g3.x); pg.y = dpp_shr1(pBg2.y, g3.y); ng.x = dpp_shl1(nBg2.x, g0.x); ng.y = dpp_shl1(nBg2.y, g0.y);
                    pu.x = dpp_shr1(pBu2.x, u3.x); pu.y = dpp_shr1(pBu2.y, u3.y); nu.x = dpp_shl1(nBu2.x, u0.x); nu.y = dpp_shl1(nBu2.y, u0.y);
                    const f32x2 A0 = PAIR(w0g), A1 = PAIR(w1g), A2 = PAIR(w2g), AB = PAIR(bg), C0 = PAIR(w0u), C1 = PAIR(w1u), C2 = PAIR(w2u), CB = PAIR(bu);
                    f32x2 G[4], U[4];
                    G[0] = A0 * pg + (A1 * g0 + (A2 * g1 + AB)); G[1] = A0 * g0 + (A1 * g1 + (A2 * g2 + AB)); G[2] = A0 * g1 + (A1 * g2 + (A2 * g3 + AB)); G[3] = A0 * g2 + (A1 * g3 + (A2 * ng + AB));
                    U[0] = C0 * pu + (C1 * u0 + (C2 * u1 + CB)); U[1] = C0 * u0 + (C1 * u1 + (C2 * u2 + CB)); U[2] = C0 * u1 + (C1 * u2 + (C2 * u3 + CB)); U[3] = C0 * u2 + (C1 * u3 + (C2 * nu + CB));
#pragma unroll
                    for (int m = 0; m < 4; ++m) {
                        const f32x2 t = G[m] * (-1.4426950408889634f);
                        f32x2 e; e.x = __builtin_amdgcn_exp2f(t.x); e.y = __builtin_amdgcn_exp2f(t.y);
                        const f32x2 d = e + 1.0f;
                        f32x2 r; r.x = __builtin_amdgcn_rcpf(d.x); r.y = __builtin_amdgcn_rcpf(d.y);
                        const f32x2 q = (G[m] * U[m]) * r;
                        o[m][2 * h] = q.x; o[m][2 * h + 1] = q.y;
                    }
#undef PAIR
                }
#pragma unroll
                for (int m = 0; m < 4; ++m) { ow[m][2 * n] = cvt_pk_bf16(o[m][0], o[m][1]); ow[m][2 * n + 1] = cvt_pk_bf16(o[m][2], o[m][3]); }
            }
#pragma unroll
            for (int m = 0; m < 4; ++m) { u32x4 w; w.x = ow[m][0]; w.y = ow[m][1]; w.z = ow[m][2]; w.w = ow[m][3];
                *(u32x4*)(ACT + (size_t)(rowb + ai * HALF + m) * DFF_ + ch0) = w; }
            asm volatile("" ::: "memory");
        }
#undef XIDX
    }
};

template <bool I8> __device__ __forceinline__ f32x4 mma16(bf16x8 b, bf16x8 a, f32x4 c) {
    if constexpr (I8) { typedef int i32x4 __attribute__((ext_vector_type(4)));
        return __builtin_bit_cast(f32x4, __builtin_amdgcn_mfma_i32_16x16x64_i8(__builtin_bit_cast(i32x4, b), __builtin_bit_cast(i32x4, a), __builtin_bit_cast(i32x4, c), 0, 0, 0)); }
    else return __builtin_amdgcn_mfma_f32_16x16x32_bf16(b, a, c, 0, 0, 0);
}
template <class Epi, class Sched, bool ALIGN_EPI = false, bool SP2 = false>
__device__ __forceinline__ void gemm_phase(PG8_LAS unsigned char* lds, const Gemm g, const Sched& S, const Epi& E) {
    int tid_ = threadIdx.x; asm volatile("" : "+v"(tid_)); const int tid = tid_, wid = __builtin_amdgcn_readfirstlane(tid >> 6), lane = tid & 63, wr = wid >> 2, wc = wid & 3, fr = lane & 15, fq = lane >> 4;
    const int K = g.K, nt = K / BK;
    unsigned voffA[2], voffB[2];
#pragma unroll
    for (int i = 0; i < 2; ++i) { int R, C; stage_rc(tid * 16 + i * 8192, R, C); const int Rb = Epi::PERM ? ((R & ~31) + perm32(R & 31)) : R;
        const int Ra = Epi::APERM ? ((R & ~63) + ((R & 15) << 2) + ((R >> 4) & 3)) : R;
        voffA[i] = (unsigned)(Ra * K + C) * 2u; voffB[i] = (unsigned)(Rb * K + C) * 2u; }
    const size_t kstep = (size_t)(BK * 2);
    const size_t hstep = (size_t)HALF * K * 2;
    const size_t tstep = 2 * hstep;
    const unsigned ldsw = (unsigned)wid * 1024u;
    const int aoff = lds_byte(wr * 64 + fr, fq * 8), boff = lds_byte(wc * 32 + fr, fq * 8);
#define PG8_SA(b, h) (((b) * 2 + (h)) * HTB)
#define PG8_SB(b, h) ((4 + (b) * 2 + (h)) * HTB)
#define PG8_STAGE(bufoff, gbase, voff) do { _Pragma("unroll") for (int _i = 0; _i < 2; ++_i) \
        __builtin_amdgcn_global_load_lds((const unsigned*)((const char*)(gbase) + (voff)[_i]), (PG8_LAS unsigned*)(lds + (bufoff) + ldsw + _i * 8192), 16, 0, 0); } while (0)
#define PG8_LDA(dst, b, h) do { _Pragma("unroll") for (int m = 0; m < 4; ++m) _Pragma("unroll") for (int k = 0; k < 2; ++k) dst[m][k] = *(const PG8_LAS bf16x8*)(lds + PG8_SA(b, h) + aoff + m * 2048 + k * 1024); } while (0)
#define PG8_LDB(dst, b, h) do { _Pragma("unroll") for (int n = 0; n < 2; ++n) _Pragma("unroll") for (int k = 0; k < 2; ++k) dst[n][k] = *(const PG8_LAS bf16x8*)(lds + PG8_SB(b, h) + boff + n * 2048 + k * 1024); } while (0)
#define PG8_MMA(ai, bj, At, Bt) do { __builtin_amdgcn_s_setprio(1); _Pragma("unroll") for (int m = 0; m < 4; ++m) _Pragma("unroll") for (int n = 0; n < 2; ++n) _Pragma("unroll") for (int k = 0; k < 2; ++k) \
        acc[ai][bj][m][n] = mma16<Epi::I8>(Bt[n][k], At[m][k], acc[ai][bj][m][n]); __builtin_amdgcn_s_setprio(0); } while (0)
#define PG8_WAIT_V(n) asm volatile("s_waitcnt vmcnt(" #n ")" ::: "memory")
#define PG8_WAIT_L(n) asm volatile("s_waitcnt lgkmcnt(" #n ")" ::: "memory")
#define PG8_BAR __builtin_amdgcn_s_barrier()
#define PG8_SCHED __builtin_amdgcn_sched_barrier(0)
    Unit cur, nxt; int ui = 0;
    if (!S.next(0, cur)) return;
    f32x4 acc[2][2][4][2];
#pragma unroll
    for (int a = 0; a < 2; ++a)
#pragma unroll
        for (int b = 0; b < 2; ++b)
#pragma unroll
            for (int m = 0; m < 4; ++m)
#pragma unroll
                for (int n = 0; n < 2; ++n) acc[a][b][m][n] = (f32x4){0.f, 0.f, 0.f, 0.f};
    bf16x8 At[4][2], B0[2][2], B1[2][2];
    const char* cA = (const char*)g.A + (size_t)cur.pm * tstep; const char* cB = (const char*)g.Bt + (size_t)cur.pn * tstep;
    S.a_ready(cur);
    if constexpr (SP2) {
        PG8_STAGE(PG8_SB(0, 0), cB, voffB); PG8_STAGE(PG8_SB(0, 1), cB + hstep, voffB); PG8_STAGE(PG8_SA(0, 0), cA, voffA); PG8_STAGE(PG8_SA(0, 1), cA + hstep, voffA);
        if (wr == 1) PG8_BAR;
        PG8_WAIT_V(2); PG8_BAR;
        PG8_STAGE(PG8_SB(1, 0), cB + kstep, voffB); PG8_STAGE(PG8_SA(1, 0), cA + kstep, voffA); PG8_STAGE(PG8_SB(1, 1), cB + hstep + kstep, voffB);
        PG8_WAIT_V(6); PG8_BAR;
    } else {
        PG8_STAGE(PG8_SB(0, 0), cB, voffB); PG8_STAGE(PG8_SA(0, 0), cA, voffA); PG8_STAGE(PG8_SB(0, 1), cB + hstep, voffB); PG8_STAGE(PG8_SA(0, 1), cA + hstep, voffA);
        if (wr == 1) PG8_BAR;
        PG8_WAIT_V(4); PG8_BAR;
        PG8_STAGE(PG8_SB(1, 0), cB + kstep, voffB); PG8_STAGE(PG8_SA(1, 0), cA + kstep, voffA); PG8_STAGE(PG8_SB(1, 1), cB + hstep + kstep, voffB);
        PG8_WAIT_V(6); PG8_BAR;
    }
    for (;;) {
        const bool has_next = S.next(ui + 1, nxt);
        const char* nA = has_next ? (const char*)g.A + (size_t)nxt.pm * tstep : cA; const char* nB = has_next ? (const char*)g.Bt + (size_t)nxt.pn * tstep : cB;
        for (int t = 0; t < nt; t += 2) {
            const bool last = (t == nt - 2);
            const char* a1 = cA + (size_t)(t + 1) * kstep;
            const char* a2 = last ? nA : cA + (size_t)(t + 2) * kstep; const char* b2 = last ? nB : cB + (size_t)(t + 2) * kstep;
            const char* a3 = a2 + kstep; const char* b3 = b2 + kstep;
            if (last && has_next) S.a_ready(nxt);
            if constexpr (SP2) {
            PG8_LDB(B0, 0, 0); PG8_LDB(B1, 0, 1); PG8_SCHED; PG8_LDA(At, 0, 0); PG8_STAGE(PG8_SA(1, 1), a1 + hstep, voffA);
            PG8_WAIT_V(8); PG8_WAIT_L(0); PG8_BAR; PG8_MMA(0, 0, At, B0); PG8_MMA(0, 1, At, B1); PG8_BAR; PG8_SCHED;
            PG8_LDA(At, 0, 1); PG8_STAGE(PG8_SB(0, 0), b2, voffB); PG8_STAGE(PG8_SB(0, 1), b2 + hstep, voffB); PG8_STAGE(PG8_SA(0, 0), a2, voffA);
            PG8_WAIT_V(8); PG8_WAIT_L(0); PG8_BAR; PG8_MMA(1, 0, At, B0); PG8_MMA(1, 1, At, B1); PG8_BAR; PG8_SCHED;
            PG8_LDB(B0, 1, 0); PG8_LDB(B1, 1, 1); PG8_SCHED; PG8_LDA(At, 1, 0); PG8_STAGE(PG8_SA(0, 1), a2 + hstep, voffA);
            PG8_WAIT_V(8); PG8_WAIT_L(0); PG8_BAR; PG8_MMA(0, 0, At, B0); PG8_MMA(0, 1, At, B1); PG8_BAR; PG8_SCHED;
            PG8_LDA(At, 1, 1); PG8_STAGE(PG8_SB(1, 0), b3, voffB); PG8_STAGE(PG8_SB(1, 1), b3 + hstep, voffB); PG8_STAGE(PG8_SA(1, 0), a3, voffA);
            PG8_WAIT_V(8); PG8_WAIT_L(0); PG8_BAR; PG8_MMA(1, 0, At, B0); PG8_MMA(1, 1, At, B1); PG8_BAR; PG8_SCHED;
            } else {
            PG8_LDB(B0, 0, 0); PG8_SCHED; PG8_LDA(At, 0, 0); PG8_STAGE(PG8_SA(1, 1), a1 + hstep, voffA);
            PG8_WAIT_L(8); PG8_BAR; PG8_WAIT_L(0); PG8_MMA(0, 0, At, B0); PG8_BAR; PG8_SCHED;
            PG8_LDB(B1, 0, 1); PG8_STAGE(PG8_SB(0, 0), b2, voffB);
            PG8_BAR; PG8_WAIT_L(0); PG8_MMA(0, 1, At, B1); PG8_BAR;
            PG8_LDA(At, 0, 1); PG8_STAGE(PG8_SA(0, 0), a2, voffA);
            PG8_BAR; PG8_WAIT_L(0); PG8_MMA(1, 0, At, B0); PG8_BAR; PG8_SCHED;
            PG8_STAGE(PG8_SB(0, 1), b2 + hstep, voffB);
            PG8_WAIT_V(6); PG8_BAR; PG8_MMA(1, 1, At, B1); PG8_BAR;
            PG8_LDB(B0, 1, 0); PG8_SCHED; PG8_LDA(At, 1, 0); PG8_STAGE(PG8_SA(0, 1), a2 + hstep, voffA);
            PG8_WAIT_L(8); PG8_BAR; PG8_WAIT_L(0); PG8_MMA(0, 0, At, B0); PG8_BAR; PG8_SCHED;
            PG8_LDB(B1, 1, 1); PG8_STAGE(PG8_SB(1, 0), b3, voffB);
            PG8_BAR; PG8_WAIT_L(0); PG8_MMA(0, 1, At, B1); PG8_BAR;
            PG8_LDA(At, 1, 1); PG8_STAGE(PG8_SA(1, 0), a3, voffA);
            PG8_BAR; PG8_WAIT_L(0); PG8_MMA(1, 0, At, B0); PG8_BAR; PG8_SCHED;
            PG8_STAGE(PG8_SB(1, 1), b3 + hstep, voffB);
            PG8_WAIT_V(6); PG8_BAR; PG8_MMA(1, 1, At, B1); PG8_BAR;
            }
        }
        if constexpr (ALIGN_EPI) { if (wr == 0) PG8_BAR; }
        if constexpr (!Epi::AFTER_DRAIN) { E(acc, cur, wr, wc, fr, fq); S.done(cur); }
        if (!has_next) break;
#pragma unroll
        for (int a = 0; a < 2; ++a)
#pragma unroll
            for (int b = 0; b < 2; ++b)
#pragma unroll
                for (int m = 0; m < 4; ++m)
#pragma unroll
                    for (int n = 0; n < 2; ++n) acc[a][b][m][n] = (f32x4){0.f, 0.f, 0.f, 0.f};
        cur = nxt; cA = nA; cB = nB; ++ui;
        if constexpr (ALIGN_EPI) { if (wr == 1) PG8_BAR; }
    }
    PG8_WAIT_V(0);
    if constexpr (!ALIGN_EPI) { if (wr == 0) PG8_BAR; }
    PG8_BAR;
    if constexpr (Epi::AFTER_DRAIN) { E.fused(acc, cur, wr, wc, fr, fq, lds, wid, lane); S.done(cur); }
#undef PG8_SA
#undef PG8_SB
#undef PG8_STAGE
#undef PG8_LDA
#undef PG8_LDB
#undef PG8_MMA
#undef PG8_WAIT_V
#undef PG8_WAIT_L
#undef PG8_BAR
#undef PG8_SCHED
}
}

constexpr int NW = 8;
constexpr int M = 24576, DM = 2048, DFF = 5632, NZ = 2 * DFF, NQKV = 3072, AW = 2048;
constexpr int SEQ_P = 8192, SEQ_S = 4096, ROWS_P = 2 * SEQ_P;
constexpr float EPS = 1e-6f, LOG2E = 1.4426950408889634f;
constexpr size_t MiB = 1u << 20;
constexpr size_t WS_RS = 0;
constexpr size_t WS_BAR = 3 * MiB;
constexpr size_t WS_W = 4 * MiB;
constexpr size_t SZ_AIN = (size_t)4096 * 2048 * 2, SZ_SQ = (size_t)2048 * 2048 * 2, SZ_QKV = (size_t)3072 * 2048 * 2, SZ_FIN = (size_t)NZ * 2048 * 2, SZ_FOUT = (size_t)2048 * DFF * 2;
constexpr size_t WS_AIN = WS_W, WS_AOUT = WS_AIN + 2 * SZ_AIN, WS_BQKV = WS_AOUT + 2 * SZ_SQ, WS_BOUT = WS_BQKV + 2 * SZ_QKV, WS_FIN = WS_BOUT + 2 * SZ_SQ, WS_FOUT = WS_FIN + 4 * SZ_FIN;
constexpr size_t WS_XB = WS_FOUT + 4 * SZ_FOUT;
constexpr size_t SZ_ROWS = (size_t)M * 2048 * 2;
constexpr size_t WS_ACT = WS_XB + SZ_ROWS;
constexpr size_t WS_HZ = WS_ACT + (size_t)M * DFF * 2;
constexpr size_t WS_R = WS_HZ + (size_t)96 * 4 * NZ * 4;
constexpr size_t WS_XQ = WS_R + 3 * SZ_ROWS;
constexpr size_t WS_FINQ = WS_XQ + (size_t)M * 2048;
constexpr size_t WS_QKVQ = WS_FINQ + (size_t)4 * NZ * 2048;
constexpr size_t WS_RMAX = WS_QKVQ + (size_t)2 * NQKV * 2048;
constexpr size_t WS_PCNT = WS_RMAX + (size_t)6 * M * 4;
constexpr size_t WS_END = WS_PCNT + (size_t)6 * 96 * 256;
constexpr size_t WS_SWQ = 3 * MiB + 524288;
constexpr size_t WS_SX = 3 * MiB + 131072, WS_SW = 3 * MiB + 262144;
constexpr size_t R_U = 0, R_VT2 = SZ_ROWS, R_Y = 2 * SZ_ROWS;
constexpr size_t R_Q = 0, R_K = SZ_ROWS, R_VTA = R_K + (size_t)M * 512 * 2, R_O = R_VTA + (size_t)M * 512 * 2;
constexpr int XCH_OFF = 131072, BARST_OFF = 131072 + 8192, LDS_BYTES = 131072 + 8192 + 16;

#define LAS __attribute__((address_space(3)))
typedef unsigned short bf16;
typedef float f32x4 __attribute__((ext_vector_type(4)));
typedef short bf16x8 __attribute__((ext_vector_type(8)));
typedef unsigned u32x4v __attribute__((ext_vector_type(4)));
typedef unsigned u32x2v __attribute__((ext_vector_type(2)));
using pg8::cvt_pk_bf16; using pg8::stat_t; using pg8::stat_fix; using pg8::STAT_INV;
__device__ __forceinline__ float bf_lo(unsigned w) { return __uint_as_float(w << 16); }
__device__ __forceinline__ float bf_hi(unsigned w) { return __uint_as_float(w & 0xffff0000u); }
__device__ __forceinline__ float wave_sum(float v) {
#pragma unroll
    for (int o = 1; o < 64; o <<= 1) v += __shfl_xor(v, o);
    return v;
}

struct Args { const float* in[19]; float* out; unsigned char* ws; int ph_lo, ph_hi, coop, pad; };

__device__ __forceinline__ void transpose_item(const float* W, int K, int N, bf16* WT, const float* gain, LAS float* scr, int item, int lane, bool ffn_perm) {
    const int nblk = N / 64, kb = item / nblk, nb = item % nblk, k0 = 64 * kb, n0 = 64 * nb;
    int d0 = n0; if (ffn_perm) { const int half = n0 >= DFF, cc = n0 - half * DFF; d0 = (cc >> 7) * 256 + half * 128 + (cc & 127); }
    const int lr = lane >> 4, lc = (lane & 15) * 4;
    const float* src = W + (size_t)(k0 + lr) * N + n0 + lc;
    f32x4 v[16];
#pragma unroll
    for (int i = 0; i < 16; ++i) v[i] = __builtin_nontemporal_load((const f32x4*)(src + (size_t)(4 * i) * N));
#pragma unroll
    for (int i = 0; i < 16; ++i) { LAS float* d = scr + (4 * i + lr) * 65 + lc; d[0] = v[i][0]; d[1] = v[i][1]; d[2] = v[i][2]; d[3] = v[i][3]; }
    asm volatile("s_waitcnt lgkmcnt(0)" ::: "memory");
    const int c = lane & 7;
    f32x4 g0 = (f32x4){1.f, 1.f, 1.f, 1.f}, g1 = g0;
    if (gain) { g0 = *(const f32x4*)(gain + k0 + 8 * c); g1 = *(const f32x4*)(gain + k0 + 8 * c + 4); }
#pragma unroll
    for (int j = 0; j < 8; ++j) { const int n = (lane >> 3) + 8 * j; const LAS float* s = scr + (8 * c) * 65 + n;
        u32x4v o; o.x = cvt_pk_bf16(s[0 * 65] * g0[0], s[1 * 65] * g0[1]); o.y = cvt_pk_bf16(s[2 * 65] * g0[2], s[3 * 65] * g0[3]); o.z = cvt_pk_bf16(s[4 * 65] * g1[0], s[5 * 65] * g1[1]); o.w = cvt_pk_bf16(s[6 * 65] * g1[2], s[7 * 65] * g1[3]);
        *(u32x4v*)(WT + (size_t)(d0 + n) * K + k0 + 8 * c) = o; }
    asm volatile("s_waitcnt lgkmcnt(0)" ::: "memory");
}
__device__ __forceinline__ void transpose_matrix(const float* W, int K, int N, bf16* WT, const float* gain, LAS float* scr, int gw, int ngw, int lane, bool ffn_perm = false) {
    const int items = (K / 64) * (N / 64);
    for (int it = gw; it < items; it += ngw) transpose_item(W, K, N, WT, gain, scr, it, lane, ffn_perm);
}
__device__ __forceinline__ void prologue_phase(const Args& a, LAS unsigned char* lds, int tid, int wave, int lane) {
    unsigned char* ws = a.ws;
    const int G = gridDim.x, gw = blockIdx.x * NW + wave, ngw = G * NW;
    { stat_t* z = (stat_t*)(ws + WS_RS) + M; const int n = 10 * M; int i = blockIdx.x * 512 + tid; while (i < n) { z[i] = 0ull; i += G * 512; asm volatile("" : "+v"(i)); } }
    { unsigned* z = (unsigned*)(ws + WS_RMAX); const int n = (int)((WS_END - WS_RMAX) / 4); int i = blockIdx.x * 512 + tid; while (i < n) { z[i] = 0u; i += G * 512; asm volatile("" : "+v"(i)); } }
    LAS float* scr = (LAS float*)(lds + wave * 16640);
    const float* mixn = a.in[3]; const float* ffnn = a.in[4];
#pragma unroll 1
    for (int j = 0; j < 2; ++j) {
        transpose_matrix(a.in[6] + (size_t)j * 2048 * 4096, 2048, 4096, (bf16*)(ws + WS_AIN + j * SZ_AIN), mixn + (2 * j) * 2048, scr, gw, ngw, lane);
        transpose_matrix(a.in[11] + (size_t)j * 2048 * 2048, 2048, 2048, (bf16*)(ws + WS_AOUT + j * SZ_SQ), nullptr, scr, gw, ngw, lane);
        transpose_matrix(a.in[12] + (size_t)j * 2048 * 3072, 2048, 3072, (bf16*)(ws + WS_BQKV + j * SZ_QKV), mixn + (2 * j + 1) * 2048, scr, gw, ngw, lane);
        transpose_matrix(a.in[14] + (size_t)j * 2048 * 2048, 2048, 2048, (bf16*)(ws + WS_BOUT + j * SZ_SQ), nullptr, scr, gw, ngw, lane);
    }
#pragma unroll 1
    for (int i = 0; i < 4; ++i) {
        transpose_matrix(a.in[15] + (size_t)i * 2048 * NZ, 2048, NZ, (bf16*)(ws + WS_FIN + i * SZ_FIN), ffnn + i * 2048, scr, gw, ngw, lane, true);
        transpose_matrix(a.in[18] + (size_t)i * DFF * 2048, DFF, 2048, (bf16*)(ws + WS_FOUT + i * SZ_FOUT), nullptr, scr, gw, ngw, lane);
    }
    stat_t* rs0 = (stat_t*)(ws + WS_RS); bf16* XB = (bf16*)(ws + WS_XB);
    for (int row = gw; row < M; row += ngw) {
        const float* src = row < ROWS_P ? a.in[0] + (size_t)row * DM : a.in[1] + (size_t)(row - ROWS_P) * DM;
        float ss = 0.f;
#pragma unroll
        for (int j = 0; j < 8; ++j) {
            const f32x4 v = *(const f32x4*)(src + j * 256 + lane * 4);
            u32x2v w; w.x = cvt_pk_bf16(v[0], v[1]); w.y = cvt_pk_bf16(v[2], v[3]);
            const float r0 = bf_lo(w.x), r1 = bf_hi(w.x), r2 = bf_lo(w.y), r3 = bf_hi(w.y);
            ss += (r0 * r0 + r1 * r1) + (r2 * r2 + r3 * r3);
            *(u32x2v*)(XB + (size_t)row * DM + j * 256 + lane * 4) = w;
        }
        ss = wave_sum(ss);
        if (lane == 0) rs0[row] = stat_fix(ss);
    }
}

__device__ __forceinline__ void a2_phase(LAS unsigned char* lds, const float* Wsp, const float* bs, const float* vn, const stat_t* rsv, const bf16* U, const bf16* VT, bf16* Y,
                                         int tid, int wave, int lane) {
    const int fr = lane & 15, fq = lane >> 4;
    const int q4 = (tid & 31) * 4, p0 = tid >> 5;
    const int crow = 8 * (fr >> 2) + (fr & 3);
    for (int unit = blockIdx.x; unit < 192 * 8; unit += gridDim.x) {
        const int g = unit & 7, chunk = unit >> 3, row0 = chunk * 128;
        f32x4 wv[8];
#pragma unroll
        for (int i = 0; i < 8; ++i) wv[i] = *(const f32x4*)(Wsp + (size_t)(g * 128 + p0 + 16 * i) * 128 + q4);
        stat_t sq[4];
#pragma unroll
        for (int k = 0; k < 4; ++k) sq[k] = rsv[row0 + q4 + k];
        bf16x8 vf[2][4];
#pragma unroll
        for (int cf = 0; cf < 2; ++cf)
#pragma unroll
            for (int ks = 0; ks < 4; ++ks) vf[cf][ks] = *(const bf16x8*)(VT + ((size_t)chunk * 2048 + 256 * g + 32 * wave + crow + 4 * cf) * 128 + 32 * ks + 8 * fq);
        const int c0 = 256 * g + 32 * wave + 8 * fq;
        u32x4v uu[8]; float bsv[8];
#pragma unroll
        for (int pf = 0; pf < 8; ++pf) { uu[pf] = *(const u32x4v*)(U + (size_t)(row0 + 16 * pf + fr) * AW + c0); bsv[pf] = bs[g * 128 + 16 * pf + fr]; }
        const f32x4 vn0 = *(const f32x4*)(vn + c0), vn1 = *(const f32x4*)(vn + c0 + 4);
        __syncthreads();
        float rv[4];
#pragma unroll
        for (int k = 0; k < 4; ++k) rv[k] = rsqrtf((float)sq[k] * (STAT_INV / 2048.f) + EPS);
#pragma unroll
        for (int i = 0; i < 8; ++i) {
            u32x2v o; o.x = cvt_pk_bf16(wv[i][0] * rv[0], wv[i][1] * rv[1]); o.y = cvt_pk_bf16(wv[i][2] * rv[2], wv[i][3] * rv[3]);
            *(LAS u32x2v*)(lds + ((p0 + 16 * i) * 136 + q4) * 2) = o;
        }
        __syncthreads();
        f32x4 acc[8][2];
#pragma unroll
        for (int pf = 0; pf < 8; ++pf)
#pragma unroll
            for (int cf = 0; cf < 2; ++cf) acc[pf][cf] = (f32x4){0.f, 0.f, 0.f, 0.f};
#pragma unroll
        for (int pf = 0; pf < 8; ++pf)
#pragma unroll
            for (int ks = 0; ks < 4; ++ks) {
                const bf16x8 wf = *(const LAS bf16x8*)(lds + ((16 * pf + fr) * 136 + 32 * ks + 8 * fq) * 2);
#pragma unroll
                for (int cf = 0; cf < 2; ++cf) acc[pf][cf] = __builtin_amdgcn_mfma_f32_16x16x32_bf16(vf[cf][ks], wf, acc[pf][cf], 0, 0, 0);
            }
#pragma unroll
        for (int pf = 0; pf < 8; ++pf) {
            const float b = bsv[pf]; const f32x4 s0 = acc[pf][0], s1 = acc[pf][1]; const u32x4v u4 = uu[pf];
            u32x4v o;
            o.x = cvt_pk_bf16(bf_lo(u4.x) * (s0[0] * vn0[0] + b), bf_hi(u4.x) * (s0[1] * vn0[1] + b));
            o.y = cvt_pk_bf16(bf_lo(u4.y) * (s0[2] * vn0[2] + b), bf_hi(u4.y) * (s0[3] * vn0[3] + b));
            o.z = cvt_pk_bf16(bf_lo(u4.z) * (s1[0] * vn1[0] + b), bf_hi(u4.z) * (s1[1] * vn1[1] + b));
            o.w = cvt_pk_bf16(bf_lo(u4.w) * (s1[2] * vn1[2] + b), bf_hi(u4.w) * (s1[3] * vn1[3] + b));
            *(u32x4v*)(Y + (size_t)(row0 + 16 * pf + fr) * AW + c0) = o;
        }
    }
}

__device__ __forceinline__ int t5_bucket(int rel) {
    const int n = rel < 0 ? -rel : rel; int b;
    if (n < 8) b = n; else { b = 8 + (n >= 12) + (n >= 16) + (n >= 23) + (n >= 32) + (n >= 46) + (n >= 64) + (n >= 91) + (n >= 128); if (b > 15) b = 15; }
    return b + (rel > 0 ? 16 : 0);
}
constexpr int AT_KS = 0, AT_VS = 34816, AT_TB = 69632;
__device__ __forceinline__ void attn_seq(int row0, int& s0, int& s1) {
    if (row0 < ROWS_P) { s0 = row0 & ~(SEQ_P - 1); s1 = s0 + SEQ_P; } else { s0 = ROWS_P + ((row0 - ROWS_P) & ~(SEQ_S - 1)); s1 = s0 + SEQ_S; }
}
__device__ __forceinline__ void attn_phase(LAS unsigned char* lds, const bf16* Q, const bf16* Kb, const bf16* VT, bf16* O, const float* rel_bias, const float* sink,
                                           int tid, int wave, int lane) {
    constexpr int NU = 192 * 8;
    const int fr = lane & 15, fq = lane >> 4, hh = wave >> 2, wq = wave & 3;
    const int G = gridDim.x;
    LAS float* tb = (LAS float*)(lds + AT_TB);
    const int sr = tid >> 4, scc = (tid & 15) * 8;
    int unit = blockIdx.x;
    if (unit >= NU) return;
    int s0, s1; attn_seq((unit >> 3) * 128, s0, s1);
    int kb = ((unit >> 3) * 128 - 128 >= s0) ? -1 : 0;
    bool ustart = true;
    bf16x8 Qf[2][4]; float l_run[2]; f32x4 Oacc[2][8];
#pragma unroll 1
    while (unit < NU) {
        const int hp = unit & 1, kvh = (unit >> 1) & 3, row0 = (unit >> 3) * 128, h = kvh * 4 + hp * 2 + hh;
        int nunit = unit, nkb = kb + 1;
        if (nkb > 1 || row0 + nkb * 128 >= s1) { nunit = unit + G; nkb = 0; if (nunit < NU) { int t0, t1; attn_seq((nunit >> 3) * 128, t0, t1); nkb = ((nunit >> 3) * 128 - 128 >= t0) ? -1 : 0; } }
        u32x4v kreg[4], vreg[4];
        {   const int kr0 = row0 + kb * 128;
#pragma unroll
            for (int i = 0; i < 4; ++i) { kreg[i] = *(const u32x4v*)(Kb + (size_t)(kr0 + sr + 32 * i) * 512 + kvh * 128 + scc); vreg[i] = *(const u32x4v*)(VT + (size_t)(kvh * 128 + sr + 32 * i) * M + kr0 + scc); } }
        if (ustart) {
#pragma unroll
            for (int qf = 0; qf < 2; ++qf)
#pragma unroll
                for (int ks = 0; ks < 4; ++ks) Qf[qf][ks] = *(const bf16x8*)(Q + (size_t)(row0 + wq * 32 + qf * 16 + fr) * DM + h * 128 + 32 * ks + 8 * fq);
#pragma unroll
            for (int qf = 0; qf < 2; ++qf) { l_run[qf] = (fq == 0) ? 1.0f : 0.0f;
#pragma unroll
                for (int a = 0; a < 8; ++a) Oacc[qf][a] = (f32x4){0.f, 0.f, 0.f, 0.f}; }
        }
        __syncthreads();
#pragma unroll
        for (int i = 0; i < 4; ++i) { *(LAS u32x4v*)(lds + AT_KS + ((sr + 32 * i) * 136 + scc) * 2) = kreg[i]; *(LAS u32x4v*)(lds + AT_VS + ((sr + 32 * i) * 136 + scc) * 2) = vreg[i]; }
        if (ustart) {
#pragma unroll
            for (int i = 0; i < 2; ++i) { const int e = tid + 512 * i, th = e >> 9, rel = (e & 511) - 256, hd = kvh * 4 + hp * 2 + th; const bool in = rel >= -128 && rel <= 128;
                tb[e] = in ? (rel_bias[t5_bucket(rel) * 16 + hd] - sink[hd]) * LOG2E : -INFINITY; }
        }
        __syncthreads();
        {
        const int kt_lo = (kb == -1) ? wq : 0, kt_hi = (kb == 1) ? wq : 3;
        bf16x8 kf[2][4];
#pragma unroll
        for (int t = 0; t < 2; ++t)
#pragma unroll
            for (int ks = 0; ks < 4; ++ks) kf[t][ks] = *(const LAS bf16x8*)(lds + AT_KS + ((32 * kt_lo + 16 * t + fr) * 136 + 32 * ks + 8 * fq) * 2);
#pragma unroll 1
        for (int kt = kt_lo; kt <= kt_hi; ++kt) {
            f32x4 S[2][2];
#pragma unroll
            for (int qf = 0; qf < 2; ++qf)
#pragma unroll
                for (int t = 0; t < 2; ++t) S[qf][t] = (f32x4){0.f, 0.f, 0.f, 0.f};
#pragma unroll
            for (int t = 0; t < 2; ++t)
#pragma unroll
                for (int ks = 0; ks < 4; ++ks)
#pragma unroll
                    for (int qf = 0; qf < 2; ++qf) S[qf][t] = __builtin_amdgcn_mfma_f32_16x16x32_bf16(kf[t][ks], Qf[qf][ks], S[qf][t], 0, 0, 0);
            __builtin_amdgcn_sched_barrier(0);
            const LAS float* tp0 = tb + hh * 512 + (kb * 128 + 32 * kt + 4 * fq - (wq * 32 + fr) + 256);
            float bias[2][8];
#pragma unroll
            for (int qf = 0; qf < 2; ++qf)
#pragma unroll
                for (int t = 0; t < 2; ++t)
#pragma unroll
                    for (int i = 0; i < 4; ++i) bias[qf][4 * t + i] = tp0[16 * t + i - 16 * qf];
            u32x2v vr[4][2], vr2[4][2];
#pragma unroll
            for (int a = 0; a < 4; ++a) {
                vr[a][0] = *(const LAS u32x2v*)(lds + AT_VS + ((16 * a + fr) * 136 + 32 * kt + 4 * fq) * 2);
                vr[a][1] = *(const LAS u32x2v*)(lds + AT_VS + ((16 * a + fr) * 136 + 32 * kt + 16 + 4 * fq) * 2);
            }
            bf16x8 pf[2];
#pragma unroll
            for (int qf = 0; qf < 2; ++qf) {
                float p[8]; float ps = 0.f;
#pragma unroll
                for (int t = 0; t < 2; ++t)
#pragma unroll
                    for (int i = 0; i < 4; ++i) { p[4 * t + i] = __builtin_amdgcn_exp2f(S[qf][t][i] + bias[qf][4 * t + i]); ps += p[4 * t + i]; }
                l_run[qf] += ps;
                u32x4v pw; pw.x = cvt_pk_bf16(p[0], p[1]); pw.y = cvt_pk_bf16(p[2], p[3]); pw.z = cvt_pk_bf16(p[4], p[5]); pw.w = cvt_pk_bf16(p[6], p[7]);
                pf[qf] = __builtin_bit_cast(bf16x8, pw);
            }
            __builtin_amdgcn_sched_barrier(0);
#pragma unroll
            for (int a = 0; a < 4; ++a) {
                vr2[a][0] = *(const LAS u32x2v*)(lds + AT_VS + ((16 * (a + 4) + fr) * 136 + 32 * kt + 4 * fq) * 2);
                vr2[a][1] = *(const LAS u32x2v*)(lds + AT_VS + ((16 * (a + 4) + fr) * 136 + 32 * kt + 16 + 4 * fq) * 2);
            }
#pragma unroll
            for (int a = 0; a < 4; ++a) {
                u32x4v vw; vw.x = vr[a][0].x; vw.y = vr[a][0].y; vw.z = vr[a][1].x; vw.w = vr[a][1].y;
                const bf16x8 vf = __builtin_bit_cast(bf16x8, vw);
#pragma unroll
                for (int qf = 0; qf < 2; ++qf) Oacc[qf][a] = __builtin_amdgcn_mfma_f32_16x16x32_bf16(vf, pf[qf], Oacc[qf][a], 0, 0, 0);
            }
            __builtin_amdgcn_sched_barrier(0);
            if (kt < kt_hi) {
#pragma unroll
                for (int t = 0; t < 2; ++t)
#pragma unroll
                    for (int ks = 0; ks < 4; ++ks) kf[t][ks] = *(const LAS bf16x8*)(lds + AT_KS + ((32 * (kt + 1) + 16 * t + fr) * 136 + 32 * ks + 8 * fq) * 2);
            }
#pragma unroll
            for (int a = 0; a < 4; ++a) {
                u32x4v vw; vw.x = vr2[a][0].x; vw.y = vr2[a][0].y; vw.z = vr2[a][1].x; vw.w = vr2[a][1].y;
                const bf16x8 vf = __builtin_bit_cast(bf16x8, vw);
#pragma unroll
                for (int qf = 0; qf < 2; ++qf) Oacc[qf][a + 4] = __builtin_amdgcn_mfma_f32_16x16x32_bf16(vf, pf[qf], Oacc[qf][a + 4], 0, 0, 0);
            }
        }
        }
        if (nunit != unit) {
#pragma unroll
            for (int qf = 0; qf < 2; ++qf) {
                float lt = l_run[qf]; lt += __shfl_xor(lt, 16); lt += __shfl_xor(lt, 32);
                const float inv = 1.0f / lt;
                bf16* orow = O + (size_t)(row0 + wq * 32 + qf * 16 + fr) * DM + h * 128 + 4 * fq;
#pragma unroll
                for (int a = 0; a < 8; ++a) { const f32x4 o = Oacc[qf][a] * inv; u32x2v w; w.x = cvt_pk_bf16(o[0], o[1]); w.y = cvt_pk_bf16(o[2], o[3]); *(u32x2v*)(orow + 16 * a) = w; }
            }
            if (nunit < NU) attn_seq((nunit >> 3) * 128, s0, s1);
        }
        ustart = (nunit != unit); unit = nunit; kb = nkb;
    }
}

__device__ __forceinline__ bool seq_start(int t) { return t == 0 || t == SEQ_P || t == ROWS_P || t == ROWS_P + SEQ_S || t >= M; }
__device__ __forceinline__ void ffn_fix_phase(const float* HZ, const float* cw, const float* cb, bf16* ACT, int tid) {
    constexpr int NC4 = DFF / 4;
    const int total = 192 * NC4;
    const f32x4 zero4 = (f32x4){0.f, 0.f, 0.f, 0.f};
    for (int it = blockIdx.x * 512 + tid; it < total; it += gridDim.x * 512) {
        const int ri = it / NC4, c4 = it - ri * NC4, pm = ri >> 1, last = ri & 1, t = pm * 256 + last * 255, ch = 4 * c4;
        const int gi = (ch >> 7) * 256 + (ch & 127), ui = gi + 128;
        const float* hp = last ? HZ + (size_t)(pm * 4 + 2) * NZ : (seq_start(t) ? nullptr : HZ + (size_t)(pm * 4 - 1) * NZ);
        const float* hc = HZ + (size_t)(pm * 4 + (last ? 3 : 0)) * NZ;
        const float* hn = last ? (seq_start(t + 1) ? nullptr : HZ + (size_t)(pm * 4 + 4) * NZ) : HZ + (size_t)(pm * 4 + 1) * NZ;
        const f32x4 pg = hp ? *(const f32x4*)(hp + gi) : zero4, pu = hp ? *(const f32x4*)(hp + ui) : zero4;
        const f32x4 cg_ = *(const f32x4*)(hc + gi), cu = *(const f32x4*)(hc + ui);
        const f32x4 ng = hn ? *(const f32x4*)(hn + gi) : zero4, nu = hn ? *(const f32x4*)(hn + ui) : zero4;
        const f32x4 w0g = *(const f32x4*)(cw + ch), w1g = *(const f32x4*)(cw + NZ + ch), w2g = *(const f32x4*)(cw + 2 * NZ + ch), bg = *(const f32x4*)(cb + ch);
        const f32x4 w0u = *(const f32x4*)(cw + DFF + ch), w1u = *(const f32x4*)(cw + NZ + DFF + ch), w2u = *(const f32x4*)(cw + 2 * NZ + DFF + ch), bu = *(const f32x4*)(cb + DFF + ch);
        float o[4];
#pragma unroll
        for (int j = 0; j < 4; ++j) {
            const float g = w0g[j] * pg[j] + w1g[j] * cg_[j] + w2g[j] * ng[j] + bg[j];
            const float u = w0u[j] * pu[j] + w1u[j] * cu[j] + w2u[j] * nu[j] + bu[j];
            o[j] = pg8::silu_f(g) * u;
        }
        u32x2v w; w.x = cvt_pk_bf16(o[0], o[1]); w.y = cvt_pk_bf16(o[2], o[3]);
        *(u32x2v*)(ACT + (size_t)t * DFF + ch) = w;
    }
}

__device__ __forceinline__ void quant_rows_phase(const bf16* src, unsigned char* dst, float* scale, int R, int wave, int lane) {
    const int gw = blockIdx.x * NW + wave, ngw = gridDim.x * NW;
    for (int row = gw; row < R; row += ngw) {
        const u32x4v* p = (const u32x4v*)(src + (size_t)row * 2048 + lane * 32);
        u32x4v v[4];
#pragma unroll
        for (int i = 0; i < 4; ++i) v[i] = p[i];
        float f[32]; float mx = 0.f;
#pragma unroll
        for (int i = 0; i < 4; ++i)
#pragma unroll
            for (int k = 0; k < 4; ++k) { f[8 * i + 2 * k] = bf_lo(v[i][k]); f[8 * i + 2 * k + 1] = bf_hi(v[i][k]); mx = fmaxf(mx, fmaxf(fabsf(f[8 * i + 2 * k]), fabsf(f[8 * i + 2 * k + 1]))); }
#pragma unroll
        for (int o = 1; o < 64; o <<= 1) mx = fmaxf(mx, __shfl_xor(mx, o));
        const float inv = mx > 0.f ? 127.0f / mx : 0.f;
        if (lane == 0) scale[row] = mx * (1.0f / 127.0f);
        u32x4v o[2];
#pragma unroll
        for (int d = 0; d < 8; ++d) {
            const int q0 = (int)__builtin_rintf(f[4 * d] * inv), q1 = (int)__builtin_rintf(f[4 * d + 1] * inv), q2 = (int)__builtin_rintf(f[4 * d + 2] * inv), q3 = (int)__builtin_rintf(f[4 * d + 3] * inv);
            o[d >> 2][d & 3] = (unsigned)(q0 & 255) | ((unsigned)(q1 & 255) << 8) | ((unsigned)(q2 & 255) << 16) | ((unsigned)q3 << 24);
        }
        u32x4v* q = (u32x4v*)(dst + (size_t)row * 2048 + lane * 32);
        q[0] = o[0]; q[1] = o[1];
    }
}

__device__ __forceinline__ void final_phase(const bf16* XB, float* out, const stat_t* rs, const float* gain, int wave, int lane) {
    const int gw = blockIdx.x * NW + wave, ngw = gridDim.x * NW;
    for (int row = gw; row < M; row += ngw) {
        const float r = rsqrtf((float)rs[row] * (STAT_INV / 2048.f) + EPS);
#pragma unroll
        for (int j = 0; j < 8; ++j) {
            const u32x2v w = *(const u32x2v*)(XB + (size_t)row * DM + j * 256 + lane * 4);
            const f32x4 g = *(const f32x4*)(gain + j * 256 + lane * 4);
            f32x4 v; v[0] = bf_lo(w.x) * r * g[0]; v[1] = bf_hi(w.x) * r * g[1]; v[2] = bf_lo(w.y) * r * g[2]; v[3] = bf_hi(w.y) * r * g[3];
            *(f32x4*)(out + (size_t)row * DM + j * 256 + lane * 4) = v;
        }
    }
}

#define XB_TMO      128
#define XB_XCNT(j)  (256  + 64 * (j))
#define XB_XSUB(j)  (1280 + 64 * (j))
#define XB_XGEN(j)  (2304 + 64 * (j))
#define XB_TOP      3328
#define XB_TOPGEN   3392
#define XCD_BAR_WORDS 3456
#define XB_SPIN_CAP (1u << 18)

__device__ __forceinline__ unsigned xb_ld(unsigned* p)              { return __hip_atomic_load(p, __ATOMIC_RELAXED, __HIP_MEMORY_SCOPE_AGENT); }
__device__ __forceinline__ unsigned xb_add(unsigned* p, unsigned v) { return __hip_atomic_fetch_add(p, v, __ATOMIC_RELAXED, __HIP_MEMORY_SCOPE_AGENT); }
__device__ __forceinline__ unsigned xb_xcc_id() { return (unsigned)__builtin_amdgcn_s_getreg((3 << 11) | 20) & 0xFu; }
#define XB_SPIN(cond, bar) do { unsigned _sp = 0; while (cond) { __builtin_amdgcn_s_sleep(1); \
    if ((++_sp & 255u) == 0u) { if (xb_ld(&(bar)[XB_TMO])) break; if (_sp > XB_SPIN_CAP) { atomicAdd(&(bar)[XB_TMO], 1u); break; } } } } while (0)

struct XcdBarrier {
    unsigned* bar; unsigned x;
    volatile LAS unsigned* st;
};

__device__ __forceinline__ XcdBarrier xcd_barrier_post(unsigned* bar, volatile LAS unsigned* st) {
    XcdBarrier b; b.bar = bar; b.x = xb_xcc_id(); b.st = st;
    if (threadIdx.x == 0) (void)xb_add(&bar[XB_XCNT(b.x)], 1u);
    return b;
}
__device__ __forceinline__ void xcd_barrier_complete(unsigned* bar, unsigned x, unsigned& nloc, unsigned& nx) {
    const unsigned G = gridDim.x * gridDim.y * gridDim.z;
    unsigned sum, cnt, mine, sp = 0u;
    for (;;) {
        sum = 0u; cnt = 0u; mine = 0u;
#pragma unroll
        for (unsigned j = 0; j < 16; ++j) { const unsigned c = xb_ld(&bar[XB_XCNT(j)]); sum += c; cnt += (c > 0u) ? 1u : 0u; mine = (j == x) ? c : mine; }
        if (sum == G) break;
        __builtin_amdgcn_s_sleep(1);
        if ((++sp & 255u) == 0u) { if (xb_ld(&bar[XB_TMO])) break; if (sp > XB_SPIN_CAP) { atomicAdd(&bar[XB_TMO], 1u); break; } }
    }
    nloc = mine > 0u ? mine : 1u; nx = cnt > 0u ? cnt : 1u;
}

__device__ __forceinline__ void xcd_barrier(const XcdBarrier& b) {
    asm volatile("s_waitcnt vmcnt(0)" ::: "memory");
    __syncthreads();
    if (threadIdx.x == 0) {
        unsigned* bar = b.bar;
        __builtin_amdgcn_s_waitcnt(0);
        unsigned nloc = b.st[0], nx = b.st[1];
        if (nloc == 0u) { xcd_barrier_complete(bar, b.x, nloc, nx); b.st[0] = nloc; b.st[1] = nx; }
        const unsigned old = xb_add(&bar[XB_XSUB(b.x)], 1u);
        const unsigned gen = old / nloc;
        if (old + 1u == (gen + 1u) * nloc) {
            __builtin_amdgcn_fence(__ATOMIC_RELEASE, "agent");
            asm volatile("s_waitcnt vmcnt(0)" ::: "memory");
            const unsigned og = xb_add(&bar[XB_TOP], 1u);
            const unsigned tg = og / nx;
            if (og + 1u == (tg + 1u) * nx) xb_add(&bar[XB_TOPGEN], 1u);
            else XB_SPIN(xb_ld(&bar[XB_TOPGEN]) == tg, bar);
            __builtin_amdgcn_fence(__ATOMIC_ACQUIRE, "agent");
            xb_add(&bar[XB_XGEN(b.x)], 1u);
            asm volatile("s_waitcnt vmcnt(0)" ::: "memory");
        } else {
            XB_SPIN(xb_ld(&bar[XB_XGEN(b.x)]) == gen, bar);
            __builtin_amdgcn_fence(__ATOMIC_ACQUIRE, "agent");
            asm volatile("s_waitcnt vmcnt(0)" ::: "memory");
        }
    }
    __syncthreads();
}

constexpr int N_PHASES = 35;
__global__ void __launch_bounds__(NW * 64, 2) fwd_kernel(Args a) {
    extern __shared__ __attribute__((aligned(16))) unsigned char lds_raw[];
    LAS unsigned char* lds = (LAS unsigned char*)lds_raw;
    unsigned char* ws = a.ws;
    stat_t* RS = (stat_t*)(ws + WS_RS); stat_t* RSV = RS + 9 * M;
    bf16* XB = (bf16*)(ws + WS_XB); bf16* ACT = (bf16*)(ws + WS_ACT); unsigned char* R = ws + WS_R;
    const int G = gridDim.x;
    if (threadIdx.x < 4) ((LAS unsigned*)(lds + BARST_OFF))[threadIdx.x] = 0u;
    if (a.ph_lo == 0 && blockIdx.x == 0) { unsigned* bw = (unsigned*)(ws + WS_BAR); for (int i = threadIdx.x; i < XCD_BAR_WORDS; i += NW * 64) bw[i] = 0u; }
    __syncthreads();
    XcdBarrier bar; bar.bar = (unsigned*)(ws + WS_BAR); bar.x = 0; bar.st = (volatile LAS unsigned*)(lds + BARST_OFF);
#pragma unroll 1
    for (int ph = a.ph_lo; ph < a.ph_hi; ++ph) {
        int tid_ = threadIdx.x; asm volatile("" : "+v"(tid_));
        const int tid = tid_, lane = tid & 63, wave = __builtin_amdgcn_readfirstlane(tid >> 6);
        int bx_ = blockIdx.x; asm volatile("" : "+s"(bx_)); const int bx = bx_;
        if (ph == 0) prologue_phase(a, lds, tid, wave, lane);
        else if (ph == 1) { quant_rows_phase((const bf16*)(ws + WS_FIN), ws + WS_FINQ, (float*)(ws + WS_SW), 4 * NZ, wave, lane);
                            quant_rows_phase((const bf16*)(ws + WS_BQKV), ws + WS_QKVQ, (float*)(ws + WS_SWQ), 2 * NQKV, wave, lane); }
        else if (ph == N_PHASES - 1) final_phase(XB, a.out, RS + 8 * M, a.in[5], wave, lane);
        else {
            const int li = (ph - 2) / 8, sp8 = (ph - 2) % 8, j = li >> 1; const bool isA = (li & 1) == 0;
            const bool fusedq = (G == 256);
            if ((sp8 == 0 && isA) || (fusedq && (sp8 == 0 || sp8 == 4))) continue;
            const int sp = sp8 == 0 ? -1 : (sp8 < 4 ? sp8 - 1 : sp8 - 2);
            if (sp8 == 0 || sp8 == 4) quant_rows_phase(XB, ws + WS_XQ, (float*)(ws + WS_SX), M, wave, lane); else
            if (sp == 0 && isA) {
                pg8::Gemm g{XB, (const bf16*)(ws + WS_AIN + j * SZ_AIN), M, 4096, 2048}; pg8::StaticOrder S; S.init(M, 4096, G, bx);
                pg8::EpiGeluUV E{RS + (2 * li) * M, a.in[7] + j * 4096, (bf16*)(R + R_U), (bf16*)(R + R_VT2), RSV + j * M};
                pg8::gemm_phase<pg8::EpiGeluUV, pg8::StaticOrder, true, true>(lds, g, S, E);
            } else if (sp == 0) {
                pg8::Gemm g{(const bf16*)(ws + WS_XQ), (const bf16*)(ws + WS_QKVQ + (size_t)j * NQKV * 2048), M, NQKV, 1024}; pg8::StaticOrder S; S.init(M, NQKV, G, bx);
                pg8::EpiQKV E{RS + (2 * li) * M, (bf16*)(R + R_Q), (bf16*)(R + R_K), (bf16*)(R + R_VTA), 0.08838834764831845f * LOG2E, (const float*)(ws + WS_SX), (const float*)(ws + WS_SWQ) + (size_t)j * NQKV};
                pg8::gemm_phase<pg8::EpiQKV, pg8::StaticOrder, true, true>(lds, g, S, E);
            } else if (sp == 1 && isA) {
                a2_phase(lds, a.in[9] + (size_t)j * 8 * 128 * 128, a.in[10] + j * 8 * 128, a.in[8] + j * 2048, RSV + j * M, (const bf16*)(R + R_U), (const bf16*)(R + R_VT2), (bf16*)(R + R_Y), tid, wave, lane);
            } else if (sp == 1) {
                attn_phase(lds, (const bf16*)(R + R_Q), (const bf16*)(R + R_K), (const bf16*)(R + R_VTA), (bf16*)(R + R_O), a.in[2], a.in[13] + j * 16, tid, wave, lane);
            } else if (sp == 2 || sp == 5) {
                const bf16* A; const bf16* Bt; int K; stat_t* rsn;
                if (sp == 2) { A = isA ? (const bf16*)(R + R_Y) : (const bf16*)(R + R_O); Bt = isA ? (const bf16*)(ws + WS_AOUT + j * SZ_SQ) : (const bf16*)(ws + WS_BOUT + j * SZ_SQ); K = 2048; rsn = RS + (2 * li + 1) * M; }
                else { A = ACT; Bt = (const bf16*)(ws + WS_FOUT + li * SZ_FOUT); K = DFF; rsn = RS + (2 * li + 2) * M; }
                pg8::Gemm g{A, Bt, M, 2048, K}; pg8::StaticOrder S; S.init(M, 2048, G, bx);
                const int quse = (sp == 2) ? li : (li == 0 ? 4 : 5);
                const int doq = fusedq && (sp == 2 || li == 0 || li == 2);
                typedef pg8::EpiResid<WS_XQ, WS_SX, WS_RMAX> EpiR;
                EpiR E{XB, rsn, ws, doq ? quse : -1};
                pg8::gemm_phase<EpiR, pg8::StaticOrder, true, true>(lds, g, S, E);
            } else if (sp == 3) {
                pg8::Gemm g{(const bf16*)(ws + WS_XQ), (const bf16*)(ws + WS_FINQ + (size_t)li * NZ * 2048), M, NZ, 1024}; pg8::StaticOrder S; S.init(M, NZ, G, bx);
                pg8::EpiConvGate E{RS + (2 * li + 1) * M, a.in[16] + (size_t)li * 3 * NZ, a.in[17] + (size_t)li * NZ, ACT, (float*)(ws + WS_HZ), lds + XCH_OFF, (const float*)(ws + WS_SX), (const float*)(ws + WS_SW) + (size_t)li * NZ};
                pg8::gemm_phase<pg8::EpiConvGate, pg8::StaticOrder, true, true>(lds, g, S, E);
            } else {
                ffn_fix_phase((const float*)(ws + WS_HZ), a.in[16] + (size_t)li * 3 * NZ, a.in[17] + (size_t)li * NZ, ACT, tid);
            }
        }
        if (a.coop && ph + 1 < a.ph_hi) {
            if (ph == 0) { cg::this_grid().sync(); bar = xcd_barrier_post((unsigned*)(ws + WS_BAR), (volatile LAS unsigned*)(lds + BARST_OFF)); }
            else xcd_barrier(bar);
        }
    }
}

extern "C" void kernel_launch(void* const* d_in, const int* in_sizes, int n_in, void* d_out, int out_size, void* d_ws, size_t ws_size, hipStream_t stream) {
    static int grid = 0;
    if (grid == 0) {
        if (n_in != 19 || out_size != M * DM || ws_size < WS_END) { fprintf(stderr, "kernel_launch: unexpected shapes (n_in %d out %d ws %zu need %zu)\n", n_in, out_size, ws_size, (size_t)WS_END); grid = -1; return; }
        int dev = 0, cus = 0, per_cu = 0;
        hipGetDevice(&dev); hipDeviceGetAttribute(&cus, hipDeviceAttributeMultiprocessorCount, dev);
        hipFuncSetAttribute((const void*)fwd_kernel, hipFuncAttributeMaxDynamicSharedMemorySize, LDS_BYTES);
        if (hipOccupancyMaxActiveBlocksPerMultiprocessor(&per_cu, (const void*)fwd_kernel, NW * 64, LDS_BYTES) != hipSuccess || per_cu < 1) { fprintf(stderr, "kernel_launch: occupancy query says %d\n", per_cu); per_cu = 1; }
        (void)hipGetLastError();
        grid = cus > 0 ? cus : 256;
    }
    if (grid < 0) return;
    Args a{};
    for (int i = 0; i < 19; ++i) a.in[i] = (const float*)d_in[i];
    a.out = (float*)d_out; a.ws = (unsigned char*)d_ws; a.pad = 0;
#if MK_COOP
    a.ph_lo = 0; a.ph_hi = N_PHASES; a.coop = 1;
    void* kargs[] = {&a};
    hipError_t e = hipLaunchCooperativeKernel((const void*)fwd_kernel, dim3(grid), dim3(NW * 64), kargs, LDS_BYTES, stream);
    if (e != hipSuccess) fprintf(stderr, "cooperative launch failed: %s (grid %d)\n", hipGetErrorString(e), grid);
#else
    a.coop = 0;
    for (int ph = 0; ph < N_PHASES; ++ph) { a.ph_lo = ph; a.ph_hi = ph + 1; hipLaunchKernelGGL(fwd_kernel, dim3(grid), dim3(NW * 64), LDS_BYTES, stream, a); }
#endif
}
```

```cpp
#include <hip/hip_runtime.h>
#include <hip/hip_cooperative_groups.h>
#include <cstdio>
#include <cstdint>
namespace cg = cooperative_groups;
#ifndef MK_COOP
#define MK_COOP 1
#endif
namespace pg8 {
#define PG8_LAS __attribute__((address_space(3)))
typedef unsigned short bf16_t;
typedef short bf16x8 __attribute__((ext_vector_type(8)));
typedef float f32x4 __attribute__((ext_vector_type(4)));
typedef unsigned u32x4 __attribute__((ext_vector_type(4)));
constexpr int BM = 256, BK = 64, HALF = 128, HTB = HALF * BK * 2  , STAGE_BYTES = 8 * HTB, NXCD = 8, WGM = 4;

__host__ __device__ __forceinline__ int lds_byte(int r, int c) { const int st = (r >> 4) * 2 + (c >> 5), rr = r & 15, cc = c & 31, ob = rr * 64 + cc * 2; return st * 1024 + (ob ^ (((ob >> 9) & 1) << 5)); }
__host__ __device__ __forceinline__ void stage_rc(int b, int& R, int& C) { const int st = b / 1024, sb = b % 1024, swz = sb ^ (((sb >> 9) & 1) << 5); R = (st >> 1) * 16 + swz / 64; C = (st & 1) * 32 + (swz % 64) / 2; }
__host__ __device__ __forceinline__ int perm32(int rho) { const int n = rho >> 4, i = rho & 15; return 8 * (i >> 2) + 4 * n + (i & 3); }

struct Unit { int pm, pn; };
struct Gemm { const bf16_t* A; const bf16_t* Bt; int M, N, K; };

struct StaticOrder {
    int nM, nN, nwg, G, c;
    __host__ __device__ void init(int M, int N, int G_, int c_) { nM = M / BM; nN = N / BM; nwg = nM * nN; G = G_; c = c_; }
    __host__ __device__ bool next(int i, Unit& u) const {
        const long L = (long)i * G + c; if (L >= nwg) return false;
        int wgid = (int)L; { const int q = nwg / NXCD, r = nwg % NXCD, xcd = wgid % NXCD, off = wgid / NXCD; wgid = (xcd < r ? xcd * (q + 1) : r * (q + 1) + (xcd - r) * q) + off; }
        const int nig = WGM * nN, gid = wgid / nig, fm = gid * WGM, gsz = (nM - fm) < WGM ? (nM - fm) : WGM;
        u.pm = fm + ((wgid % nig) % gsz); u.pn = (wgid % nig) / gsz; return true;
    }
    __device__ __forceinline__ void a_ready(const Unit&) const {}
    __device__ __forceinline__ void done(const Unit&) const {}
};

__device__ __forceinline__ unsigned cvt_pk_bf16(float lo, float hi) { unsigned r; asm volatile("v_cvt_pk_bf16_f32 %0, %1, %2" : "=v"(r) : "v"(lo), "v"(hi)); return r; }

constexpr int MROWS = 24576;
constexpr float NORM_EPS = 1e-6f;
typedef unsigned long long stat_t;
constexpr float STAT_SCALE = 16777216.0f, STAT_INV = 1.0f / 16777216.0f;
__device__ __forceinline__ stat_t stat_fix(float ss) { return (stat_t)(ss * STAT_SCALE + 0.5f); }
__device__ __forceinline__ float rstd2048(const stat_t* rs, int row) { return rsqrtf((float)rs[row] * (STAT_INV / 2048.0f) + NORM_EPS); }
__device__ __forceinline__ float gelu_tanh(float x) {
    const float t = x * (1.5957691216057308f + 0.07135481627f * x * x);
    const float e = __builtin_amdgcn_exp2f(-1.4426950408889634f * t);
    return x * __builtin_amdgcn_rcpf(1.0f + e);
}
__device__ __forceinline__ bf16_t f2bf_rne(float f) { return (bf16_t)(cvt_pk_bf16(f, 0.f) & 0xffffu); }

template <bool I8_> struct EpiGeluUV {
    static constexpr bool PERM = true, AFTER_DRAIN = false, APERM = true, I8 = I8_;
    const stat_t* rs; const float* bias; bf16_t* U; bf16_t* VT; stat_t* rsv; const float* sx; const float* sw;
    __device__ __forceinline__ void operator()(const f32x4 (&acc)[2][2][4][2], const Unit& u, int wr, int wc, int fr_, int fq_) const {
        int fr = fr_, fq = fq_; asm volatile("" : "+v"(fr), "+v"(fq));
        typedef unsigned u32x2v __attribute__((ext_vector_type(2)));
        const int rowb = u.pm * BM + wr * 64 + 4 * fr, colt = u.pn * BM, cl = wc * 32 + 8 * fq;
        f32x4 bv[2][2];
#pragma unroll
        for (int bj = 0; bj < 2; ++bj)
#pragma unroll
            for (int n = 0; n < 2; ++n) bv[bj][n] = *(const f32x4*)(bias + colt + bj * HALF + cl + 4 * n);
        const bool isV = u.pn >= 8;
        float rr[2][4];
#pragma unroll
        for (int ai = 0; ai < 2; ++ai)
#pragma unroll
            for (int m = 0; m < 4; ++m) { rr[ai][m] = rstd2048(rs, rowb + ai * HALF + m); if (I8_) rr[ai][m] *= sx[rowb + ai * HALF + m]; }
        f32x4 swv[2][2];
#pragma unroll
        for (int bj = 0; bj < 2; ++bj)
#pragma unroll
            for (int n = 0; n < 2; ++n) swv[bj][n] = I8_ ? *(const f32x4*)(sw + colt + bj * HALF + cl + 4 * n) : (f32x4){1.f, 1.f, 1.f, 1.f};
#pragma unroll
        for (int ai = 0; ai < 2; ++ai) {
            float ss[4] = {0.f, 0.f, 0.f, 0.f};
#pragma unroll
            for (int bj = 0; bj < 2; ++bj) {
                float v[4][8];
#pragma unroll
                for (int m = 0; m < 4; ++m)
#pragma unroll
                    for (int n = 0; n < 2; ++n) {
                        typedef int i32x4 __attribute__((ext_vector_type(4)));
                        f32x4 cv = acc[ai][bj][m][n];
                        if (I8_) cv = __builtin_convertvector(__builtin_bit_cast(i32x4, acc[ai][bj][m][n]), f32x4) * swv[bj][n];
#pragma unroll
                        for (int j = 0; j < 4; ++j) v[m][4 * n + j] = gelu_tanh(cv[j] * rr[ai][m] + bv[bj][n][j]);
                    }
                if (!isV) {
#pragma unroll
                    for (int m = 0; m < 4; ++m) {
                        u32x4 w; w.x = cvt_pk_bf16(v[m][0], v[m][1]); w.y = cvt_pk_bf16(v[m][2], v[m][3]); w.z = cvt_pk_bf16(v[m][4], v[m][5]); w.w = cvt_pk_bf16(v[m][6], v[m][7]);
                        *(u32x4*)(U + (size_t)(rowb + ai * HALF + m) * 2048 + colt + bj * HALF + cl) = w; }
                } else {
                    const int c0 = colt - 2048 + bj * HALF + cl, row = rowb + ai * HALF;
                    bf16_t* vp = VT + ((size_t)(row >> 7) * 2048 + c0) * 128 + (row & 127);
#pragma unroll
                    for (int j = 0; j < 8; ++j) {
                        u32x2v w; w.x = cvt_pk_bf16(v[0][j], v[1][j]); w.y = cvt_pk_bf16(v[2][j], v[3][j]);
                        *(u32x2v*)(vp + (size_t)j * 128) = w;
#pragma unroll
                        for (int m = 0; m < 4; ++m) ss[m] += v[m][j] * v[m][j];
                    }
                }
            }
            if (isV) {
#pragma unroll
                for (int m = 0; m < 4; ++m) { float s = ss[m]; s += __shfl_xor(s, 16); s += __shfl_xor(s, 32); if (fq == 0) atomicAdd(rsv + rowb + ai * HALF + m, stat_fix(s)); }
            }
        }
    }
};
template <size_t OFF_XQ, size_t OFF_SX, size_t OFF_Q> struct EpiResid {
    static constexpr bool PERM = true, AFTER_DRAIN = false, APERM = false, I8 = false;
    bf16_t* XB; stat_t* rs_next; unsigned char* wsb; int quse;
    __device__ __forceinline__ void operator()(const f32x4 (&acc)[2][2][4][2], const Unit& u, int wr, int wc, int fr_, int fq_) const {
        int tl_ = threadIdx.x; asm volatile("" : "+v"(tl_)); const int fr = tl_ & 15, fq = (tl_ & 63) >> 4; (void)fr_; (void)fq_;
        typedef unsigned u32x2v __attribute__((ext_vector_type(2)));
        const int row0 = u.pm * BM + wr * 64 + fr, col0 = u.pn * BM + wc * 32 + 8 * fq;
        const bool do_q = quse >= 0; unsigned* qbase = (unsigned*)(wsb + OFF_Q); unsigned char* XQ = wsb + OFF_XQ; float* sx = (float*)(wsb + OFF_SX);
        unsigned* rowmax = qbase + (size_t)(do_q ? quse : 0) * MROWS; unsigned* pcnt = qbase + (size_t)8 * MROWS + (size_t)(do_q ? quse : 0) * 6144;
        u32x4 xv[2][4][2];
#pragma unroll
        for (int ai = 0; ai < 2; ++ai)
#pragma unroll
            for (int m = 0; m < 4; ++m)
#pragma unroll
                for (int bj = 0; bj < 2; ++bj) xv[ai][m][bj] = *(const u32x4*)(XB + (size_t)(row0 + ai * HALF + m * 16) * 2048 + col0 + bj * HALF);
#pragma unroll
        for (int ai = 0; ai < 2; ++ai)
#pragma unroll
            for (int m = 0; m < 4; ++m) {
                const int row = row0 + ai * HALF + m * 16; bf16_t* p = XB + (size_t)row * 2048 + col0; float ss = 0.f, mxl = 0.f;
#pragma unroll
                for (int bj = 0; bj < 2; ++bj) {
#pragma unroll
                    for (int k = 0; k < 4; ++k) {
                        const float lo = __uint_as_float(xv[ai][m][bj][k] << 16) + acc[ai][bj][m][k >> 1][(k & 1) * 2], hi = __uint_as_float(xv[ai][m][bj][k] & 0xffff0000u) + acc[ai][bj][m][k >> 1][(k & 1) * 2 + 1];
                        const unsigned pk = cvt_pk_bf16(lo, hi); xv[ai][m][bj][k] = pk;
                        const float rl = __uint_as_float(pk << 16), rh = __uint_as_float(pk & 0xffff0000u);
                        ss += rl * rl + rh * rh; mxl = fmaxf(mxl, fmaxf(fabsf(rl), fabsf(rh)));
                    }
                    *(u32x4*)(p + bj * HALF) = xv[ai][m][bj];
                }
                ss += __shfl_xor(ss, 16); ss += __shfl_xor(ss, 32); if (fq == 0) atomicAdd(rs_next + row, stat_fix(ss));
                if (do_q) { mxl = fmaxf(mxl, __shfl_xor(mxl, 16)); mxl = fmaxf(mxl, __shfl_xor(mxl, 32)); if (fq == 0) atomicMax(rowmax + row, __float_as_uint(mxl)); }
            }
        if (do_q) {
            asm volatile("s_waitcnt vmcnt(0)" ::: "memory");
            unsigned* pc = pcnt + 64 * u.pm;
            if ((fr | fq) == 0) __hip_atomic_fetch_add(pc, 1u, __ATOMIC_RELAXED, __HIP_MEMORY_SCOPE_AGENT);
            { unsigned sp = 0; while ((unsigned)__builtin_amdgcn_readfirstlane((int)__hip_atomic_load(pc, __ATOMIC_RELAXED, __HIP_MEMORY_SCOPE_AGENT)) < 64u && ++sp < (1u << 20)) __builtin_amdgcn_s_sleep(2); }
#pragma unroll
            for (int ai = 0; ai < 2; ++ai)
#pragma unroll
                for (int m = 0; m < 4; ++m) {
                    const int row = row0 + ai * HALF + m * 16;
                    const float mx = __uint_as_float(__hip_atomic_load(rowmax + row, __ATOMIC_RELAXED, __HIP_MEMORY_SCOPE_AGENT)), inv = mx > 0.f ? 127.0f / mx : 0.f;
                    if (u.pn == 0 && wc == 0 && fq == 0) sx[row] = mx * (1.0f / 127.0f);
#pragma unroll
                    for (int bj = 0; bj < 2; ++bj) {
                        u32x2v o;
#pragma unroll
                        for (int h = 0; h < 2; ++h) {
                            const unsigned w0 = xv[ai][m][bj][2 * h], w1 = xv[ai][m][bj][2 * h + 1];
                            const int q0 = (int)__builtin_rintf(__uint_as_float(w0 << 16) * inv), q1 = (int)__builtin_rintf(__uint_as_float(w0 & 0xffff0000u) * inv);
                            const int q2 = (int)__builtin_rintf(__uint_as_float(w1 << 16) * inv), q3 = (int)__builtin_rintf(__uint_as_float(w1 & 0xffff0000u) * inv);
                            o[h] = (unsigned)(q0 & 255) | ((unsigned)(q1 & 255) << 8) | ((unsigned)(q2 & 255) << 16) | ((unsigned)q3 << 24);
                        }
                        *(u32x2v*)(XQ + (size_t)row * 2048 + col0 + bj * HALF) = o;
                    }
                }
        }
    }
};
struct EpiQKV {
    static constexpr bool PERM = true, AFTER_DRAIN = false, APERM = true, I8 = true;
    const stat_t* rs; bf16_t* Q; bf16_t* Kb; bf16_t* VT; float qscale; const float* sx; const float* sw;
    __device__ __forceinline__ void operator()(const f32x4 (&acc)[2][2][4][2], const Unit& u, int wr, int wc, int fr_, int fq_) const {
        int fr = fr_, fq = fq_; asm volatile("" : "+v"(fr), "+v"(fq));
        typedef unsigned u32x2v __attribute__((ext_vector_type(2)));
        const int rowb = u.pm * BM + wr * 64 + 4 * fr, colt = u.pn * BM, cl = wc * 32 + 8 * fq;
        const bool isq = u.pn < 8;
        const unsigned long long ob = (unsigned long long)(isq ? Q : Kb);
        bf16_t* obase = (bf16_t*)(((unsigned long long)(unsigned)__builtin_amdgcn_readfirstlane((int)(ob >> 32)) << 32) | (unsigned)__builtin_amdgcn_readfirstlane((int)ob));
        const int oldc = isq ? 2048 : 512, ocol = isq ? colt : colt - 2048;
        float rr[2][4];
#pragma unroll
        for (int ai = 0; ai < 2; ++ai)
#pragma unroll
            for (int m = 0; m < 4; ++m) { rr[ai][m] = rstd2048(rs, rowb + ai * HALF + m) * sx[rowb + ai * HALF + m]; if (isq) rr[ai][m] *= qscale; }
        typedef int i32x4 __attribute__((ext_vector_type(4)));
        f32x4 swv[2][2];
#pragma unroll
        for (int bj = 0; bj < 2; ++bj)
#pragma unroll
            for (int n = 0; n < 2; ++n) swv[bj][n] = *(const f32x4*)(sw + colt + bj * HALF + cl + 4 * n);
#define QV(ai_, bj_, m_, n_) (__builtin_convertvector(__builtin_bit_cast(i32x4, acc[ai_][bj_][m_][n_]), f32x4) * swv[bj_][n_])
#pragma unroll
        for (int ai = 0; ai < 2; ++ai)
#pragma unroll
            for (int bj = 0; bj < 2; ++bj) {
                if (u.pn < 10) {
#pragma unroll
                    for (int m = 0; m < 4; ++m) {
                        const f32x4 v0 = QV(ai, bj, m, 0) * rr[ai][m], v1 = QV(ai, bj, m, 1) * rr[ai][m]; const int row = rowb + ai * HALF + m;
                        u32x4 w; w.x = cvt_pk_bf16(v0[0], v0[1]); w.y = cvt_pk_bf16(v0[2], v0[3]); w.z = cvt_pk_bf16(v1[0], v1[1]); w.w = cvt_pk_bf16(v1[2], v1[3]);
                        *(u32x4*)(obase + (size_t)row * oldc + ocol + bj * HALF + cl) = w; }
                } else {
                    bf16_t* vp = VT + (size_t)(colt - 2560 + bj * HALF + cl) * MROWS + rowb + ai * HALF;
#pragma unroll
                    for (int n = 0; n < 2; ++n) {
                        const f32x4 q0 = QV(ai, bj, 0, n) * rr[ai][0], q1 = QV(ai, bj, 1, n) * rr[ai][1], q2 = QV(ai, bj, 2, n) * rr[ai][2], q3 = QV(ai, bj, 3, n) * rr[ai][3];
#pragma unroll
                        for (int j = 0; j < 4; ++j) {
                            u32x2v w; w.x = cvt_pk_bf16(q0[j], q1[j]); w.y = cvt_pk_bf16(q2[j], q3[j]);
                            *(u32x2v*)(vp + (size_t)(4 * n + j) * MROWS) = w; } }
                }
            }
    }
#undef QV
};
__device__ __forceinline__ float dpp_shr1(float old, float v) { return __builtin_bit_cast(float, __builtin_amdgcn_update_dpp(__builtin_bit_cast(int, old), __builtin_bit_cast(int, v), 0x111, 0xf, 0xf, false)); }
__device__ __forceinline__ float dpp_shl1(float old, float v) { return __builtin_bit_cast(float, __builtin_amdgcn_update_dpp(__builtin_bit_cast(int, old), __builtin_bit_cast(int, v), 0x101, 0xf, 0xf, false)); }
__device__ __forceinline__ float fma_s(float a, float b, float c) { float d; asm("v_fma_f32 %0, %1, %2, %3" : "=v"(d) : "v"(a), "v"(b), "v"(c)); return d; }
__device__ __forceinline__ float silu_f(float g) { return g * __builtin_amdgcn_rcpf(1.0f + __builtin_amdgcn_exp2f(-1.4426950408889634f * g)); }
struct EpiConvGate {
    static constexpr bool PERM = true, AFTER_DRAIN = false, APERM = true, I8 = true;
    static constexpr int DFF_ = 5632, NZ_ = 11264;
    const stat_t* rs; const float* cw; const float* cb; bf16_t* ACT; float* HZ; PG8_LAS unsigned char* xch; const float* sx; const float* sw;
    __device__ __forceinline__ void operator()(const f32x4 (&acc)[2][2][4][2], const Unit& u, int wr, int wc, int fr_, int fq_) const {
        typedef unsigned u32x2v __attribute__((ext_vector_type(2)));
        int fr = fr_, fq = fq_; asm volatile("" : "+v"(fr), "+v"(fq));
        f32x4 z[2][2][4][2];
        const int rowb = u.pm * BM + wr * 64 + 4 * fr;
        f32x4 swv[2][2];
#pragma unroll
        for (int bj = 0; bj < 2; ++bj)
#pragma unroll
            for (int n = 0; n < 2; ++n) swv[bj][n] = *(const f32x4*)(sw + u.pn * BM + bj * HALF + wc * 32 + 8 * fq + 4 * n);
#pragma unroll
        for (int ai = 0; ai < 2; ++ai)
#pragma unroll
            for (int m = 0; m < 4; ++m) { const float r = rstd2048(rs, rowb + ai * HALF + m) * sx[rowb + ai * HALF + m];
#pragma unroll
                for (int bj = 0; bj < 2; ++bj)
#pragma unroll
                    for (int n = 0; n < 2; ++n) { typedef int i32x4 __attribute__((ext_vector_type(4)));
                        z[ai][bj][m][n] = __builtin_convertvector(__builtin_bit_cast(i32x4, acc[ai][bj][m][n]), f32x4) * (swv[bj][n] * r); } }
        PG8_LAS f32x4* X4 = (PG8_LAS f32x4*)xch;
#define XIDX(wr_, ai_, fl_) ((((((wr_) * 4 + wc) * 2 + (ai_)) * 2 + (fl_)) * 4 + fq) * 4)
#pragma unroll
        for (int ai = 0; ai < 2; ++ai) {
            if (fr == 0) {
#pragma unroll
                for (int bj = 0; bj < 2; ++bj)
#pragma unroll
                    for (int n = 0; n < 2; ++n) X4[XIDX(wr, ai, 0) + bj * 2 + n] = z[ai][bj][0][n]; }
            if (fr == 15) {
#pragma unroll
                for (int bj = 0; bj < 2; ++bj)
#pragma unroll
                    for (int n = 0; n < 2; ++n) X4[XIDX(wr, ai, 1) + bj * 2 + n] = z[ai][bj][3][n]; }
        }
        {   const int hcol = u.pn * BM + wc * 32 + 8 * fq;
            if (wr == 0 && fr == 0) {
#pragma unroll
                for (int m = 0; m < 2; ++m)
#pragma unroll
                    for (int bj = 0; bj < 2; ++bj)
#pragma unroll
                        for (int n = 0; n < 2; ++n) *(f32x4*)(HZ + (size_t)(u.pm * 4 + m) * NZ_ + hcol + bj * HALF + 4 * n) = z[0][bj][m][n]; }
            if (wr == 1 && fr == 15) {
#pragma unroll
                for (int m = 2; m < 4; ++m)
#pragma unroll
                    for (int bj = 0; bj < 2; ++bj)
#pragma unroll
                        for (int n = 0; n < 2; ++n) *(f32x4*)(HZ + (size_t)(u.pm * 4 + m) * NZ_ + hcol + bj * HALF + 4 * n) = z[1][bj][m][n]; }
        }
        asm volatile("s_waitcnt lgkmcnt(0)" ::: "memory"); __builtin_amdgcn_s_barrier(); asm volatile("" ::: "memory");
        const int ch0 = u.pn * HALF + wc * 32 + 8 * fq;
        const f32x4 zero4 = (f32x4){0.f, 0.f, 0.f, 0.f};
#pragma unroll
        for (int ai = 0; ai < 2; ++ai) {
            unsigned ow[4][4];
#pragma unroll
            for (int n = 0; n < 2; ++n) {
                const int ch = ch0 + 4 * n;
                const f32x4 w0g = *(const f32x4*)(cw + ch), w1g = *(const f32x4*)(cw + NZ_ + ch), w2g = *(const f32x4*)(cw + 2 * NZ_ + ch), bg = *(const f32x4*)(cb + ch);
                const f32x4 w0u = *(const f32x4*)(cw + DFF_ + ch), w1u = *(const f32x4*)(cw + NZ_ + DFF_ + ch), w2u = *(const f32x4*)(cw + 2 * NZ_ + DFF_ + ch), bu = *(const f32x4*)(cb + DFF_ + ch);
                f32x4 pBg = zero4, pBu = zero4, nBg = zero4, nBu = zero4;
                if (wr == 1) { pBg = X4[XIDX(0, ai, 1) + n]; pBu = X4[XIDX(0, ai, 1) + 2 + n]; }
                else if (ai == 1) { pBg = X4[XIDX(1, 0, 1) + n]; pBu = X4[XIDX(1, 0, 1) + 2 + n]; }
                if (wr == 0) { nBg = X4[XIDX(1, ai, 0) + n]; nBu = X4[XIDX(1, ai, 0) + 2 + n]; }
                else if (ai == 0) { nBg = X4[XIDX(0, 1, 0) + n]; nBu = X4[XIDX(0, 1, 0) + 2 + n]; }
                float o[4][4];
#pragma unroll
                for (int h = 0; h < 2; ++h) {
                    typedef float f32x2 __attribute__((ext_vector_type(2)));
#define PAIR(v) (h == 0 ? __builtin_shufflevector(v, v, 0, 1) : __builtin_shufflevector(v, v, 2, 3))
                    const f32x2 g0 = PAIR(z[ai][0][0][n]), g1 = PAIR(z[ai][0][1][n]), g2 = PAIR(z[ai][0][2][n]), g3 = PAIR(z[ai][0][3][n]);
                    const f32x2 u0 = PAIR(z[ai][1][0][n]), u1 = PAIR(z[ai][1][1][n]), u2 = PAIR(z[ai][1][2][n]), u3 = PAIR(z[ai][1][3][n]);
                    const f32x2 pBg2 = PAIR(pBg), nBg2 = PAIR(nBg), pBu2 = PAIR(pBu), nBu2 = PAIR(nBu);
                    f32x2 pg, ng, pu, nu;
                    pg.x = dpp_shr1(pBg2.x, g3.x); pg.y = dpp_shr1(pBg2.y, g3.y); ng.x = dpp_shl1(nBg2.x, g0.x); ng.y = dpp_shl1(nBg2.y, g0.y);
                    pu.x = dpp_shr1(pBu2.x, u3.x); pu.y = dpp_shr1(pBu2.y, u3.y); nu.x = dpp_shl1(nBu2.x, u0.x); nu.y = dpp_shl1(nBu2.y, u0.y);
                    const f32x2 A0 = PAIR(w0g), A1 = PAIR(w1g), A2 = PAIR(w2g), AB = PAIR(bg), C0 = PAIR(w0u), C1 = PAIR(w1u), C2 = PAIR(w2u), CB = PAIR(bu);
                    f32x2 G[4], U[4];
                    G[0] = A0 * pg + (A1 * g0 + (A2 * g1 + AB)); G[1] = A0 * g0 + (A1 * g1 + (A2 * g2 + AB)); G[2] = A0 * g1 + (A1 * g2 + (A2 * g3 + AB)); G[3] = A0 * g2 + (A1 * g3 + (A2 * ng + AB));
                    U[0] = C0 * pu + (C1 * u0 + (C2 * u1 + CB)); U[1] = C0 * u0 + (C1 * u1 + (C2 * u2 + CB)); U[2] = C0 * u1 + (C1 * u2 + (C2 * u3 + CB)); U[3] = C0 * u2 + (C1 * u3 + (C2 * nu + CB));
#pragma unroll
                    for (int m = 0; m < 4; ++m) {
                        const f32x2 t = G[m] * (-1.4426950408889634f);
                        f32x2 e; e.x = __builtin_amdgcn_exp2f(t.x); e.y = __builtin_amdgcn_exp2f(t.y);
                        const f32x2 d = e + 1.0f;
                        f32x2 r; r.x = __builtin_amdgcn_rcpf(d.x); r.y = __builtin_amdgcn_rcpf(d.y);
                        const f32x2 q = (G[m] * U[m]) * r;
                        o[m][2 * h] = q.x; o[m][2 * h + 1] = q.y;
                    }
#undef PAIR
                }
#pragma unroll
                for (int m = 0; m < 4; ++m) { ow[m][2 * n] = cvt_pk_bf16(o[m][0], o[m][1]); ow[m][2 * n + 1] = cvt_pk_bf16(o[m][2], o[m][3]); }
            }
#pragma unroll
            for (int m = 0; m < 4; ++m) { u32x4 w; w.x = ow[m][0]; w.y = ow[m][1]; w.z = ow[m][2]; w.w = ow[m][3];
                *(u32x4*)(ACT + (size_t)(rowb + ai * HALF + m) * DFF_ + ch0) = w; }
            asm volatile("" ::: "memory");
        }
#undef XIDX
    }
};

template <bool I8> __device__ __forceinline__ f32x4 mma16(bf16x8 b, bf16x8 a, f32x4 c) {
    if constexpr (I8) { typedef int i32x4 __attribute__((ext_vector_type(4)));
        return __builtin_bit_cast(f32x4, __builtin_amdgcn_mfma_i32_16x16x64_i8(__builtin_bit_cast(i32x4, b), __builtin_bit_cast(i32x4, a), __builtin_bit_cast(i32x4, c), 0, 0, 0)); }
    else return __builtin_amdgcn_mfma_f32_16x16x32_bf16(b, a, c, 0, 0, 0);
}
template <class Epi, class Sched, bool ALIGN_EPI = false, bool SP2 = false>
__device__ __forceinline__ void gemm_phase(PG8_LAS unsigned char* lds, const Gemm g, const Sched& S, const Epi& E) {
    int tid_ = threadIdx.x; asm volatile("" : "+v"(tid_)); const int tid = tid_, wid = __builtin_amdgcn_readfirstlane(tid >> 6), lane = tid & 63, wr = wid >> 2, wc = wid & 3, fr = lane & 15, fq = lane >> 4;
    const int K = g.K, nt = K / BK;
    unsigned voffA[2], voffB[2];
#pragma unroll
    for (int i = 0; i < 2; ++i) { int R, C; stage_rc(tid * 16 + i * 8192, R, C); const int Rb = Epi::PERM ? ((R & ~31) + perm32(R & 31)) : R;
        const int Ra = Epi::APERM ? ((R & ~63) + ((R & 15) << 2) + ((R >> 4) & 3)) : R;
        voffA[i] = (unsigned)(Ra * K + C) * 2u; voffB[i] = (unsigned)(Rb * K + C) * 2u; }
    const size_t kstep = (size_t)(BK * 2);
    const size_t hstep = (size_t)HALF * K * 2;
    const size_t tstep = 2 * hstep;
    const unsigned ldsw = (unsigned)wid * 1024u;
    const int aoff = lds_byte(wr * 64 + fr, fq * 8), boff = lds_byte(wc * 32 + fr, fq * 8);
#define PG8_SA(b, h) (((b) * 2 + (h)) * HTB)
#define PG8_SB(b, h) ((4 + (b) * 2 + (h)) * HTB)
#define PG8_STAGE(bufoff, gbase, voff) do { _Pragma("unroll") for (int _i = 0; _i < 2; ++_i) \
        __builtin_amdgcn_global_load_lds((const unsigned*)((const char*)(gbase) + (voff)[_i]), (PG8_LAS unsigned*)(lds + (bufoff) + ldsw + _i * 8192), 16, 0, 0); } while (0)
#define PG8_LDA(dst, b, h) do { _Pragma("unroll") for (int m = 0; m < 4; ++m) _Pragma("unroll") for (int k = 0; k < 2; ++k) dst[m][k] = *(const PG8_LAS bf16x8*)(lds + PG8_SA(b, h) + aoff + m * 2048 + k * 1024); } while (0)
#define PG8_LDB(dst, b, h) do { _Pragma("unroll") for (int n = 0; n < 2; ++n) _Pragma("unroll") for (int k = 0; k < 2; ++k) dst[n][k] = *(const PG8_LAS bf16x8*)(lds + PG8_SB(b, h) + boff + n * 2048 + k * 1024); } while (0)
#define PG8_MMA(ai, bj, At, Bt) do { __builtin_amdgcn_s_setprio(1); _Pragma("unroll") for (int m = 0; m < 4; ++m) _Pragma("unroll") for (int n = 0; n < 2; ++n) _Pragma("unroll") for (int k = 0; k < 2; ++k) \
        acc[ai][bj][m][n] = mma16<Epi::I8>(Bt[n][k], At[m][k], acc[ai][bj][m][n]); __builtin_amdgcn_s_setprio(0); } while (0)
#define PG8_WAIT_V(n) asm volatile("s_waitcnt vmcnt(" #n ")" ::: "memory")
#define PG8_WAIT_L(n) asm volatile("s_waitcnt lgkmcnt(" #n ")" ::: "memory")
#define PG8_BAR __builtin_amdgcn_s_barrier()
#define PG8_SCHED __builtin_amdgcn_sched_barrier(0)
    Unit cur, nxt; int ui = 0;
    if (!S.next(0, cur)) return;
    f32x4 acc[2][2][4][2];
#pragma unroll
    for (int a = 0; a < 2; ++a)
#pragma unroll
        for (int b = 0; b < 2; ++b)
#pragma unroll
            for (int m = 0; m < 4; ++m)
#pragma unroll
                for (int n = 0; n < 2; ++n) acc[a][b][m][n] = (f32x4){0.f, 0.f, 0.f, 0.f};
    bf16x8 At[4][2], B0[2][2], B1[2][2];
    const char* cA = (const char*)g.A + (size_t)cur.pm * tstep; const char* cB = (const char*)g.Bt + (size_t)cur.pn * tstep;
    S.a_ready(cur);
    if constexpr (SP2) {
        PG8_STAGE(PG8_SB(0, 0), cB, voffB); PG8_STAGE(PG8_SB(0, 1), cB + hstep, voffB); PG8_STAGE(PG8_SA(0, 0), cA, voffA); PG8_STAGE(PG8_SA(0, 1), cA + hstep, voffA);
        if (wr == 1) PG8_BAR;
        PG8_WAIT_V(2); PG8_BAR;
        PG8_STAGE(PG8_SB(1, 0), cB + kstep, voffB); PG8_STAGE(PG8_SA(1, 0), cA + kstep, voffA); PG8_STAGE(PG8_SB(1, 1), cB + hstep + kstep, voffB);
        PG8_WAIT_V(6); PG8_BAR;
    } else {
        PG8_STAGE(PG8_SB(0, 0), cB, voffB); PG8_STAGE(PG8_SA(0, 0), cA, voffA); PG8_STAGE(PG8_SB(0, 1), cB + hstep, voffB); PG8_STAGE(PG8_SA(0, 1), cA + hstep, voffA);
        if (wr == 1) PG8_BAR;
        PG8_WAIT_V(4); PG8_BAR;
        PG8_STAGE(PG8_SB(1, 0), cB + kstep, voffB); PG8_STAGE(PG8_SA(1, 0), cA + kstep, voffA); PG8_STAGE(PG8_SB(1, 1), cB + hstep + kstep, voffB);
        PG8_WAIT_V(6); PG8_BAR;
    }
    for (;;) {
        const bool has_next = S.next(ui + 1, nxt);
        const char* nA = has_next ? (const char*)g.A + (size_t)nxt.pm * tstep : cA; const char* nB = has_next ? (const char*)g.Bt + (size_t)nxt.pn * tstep : cB;
        for (int t = 0; t < nt; t += 2) {
            const bool last = (t == nt - 2);
            const char* a1 = cA + (size_t)(t + 1) * kstep;
            const char* a2 = last ? nA : cA + (size_t)(t + 2) * kstep; const char* b2 = last ? nB : cB + (size_t)(t + 2) * kstep;
            const char* a3 = a2 + kstep; const char* b3 = b2 + kstep;
            if (last && has_next) S.a_ready(nxt);
            if constexpr (SP2) {
            PG8_LDB(B0, 0, 0); PG8_LDB(B1, 0, 1); PG8_SCHED; PG8_LDA(At, 0, 0); PG8_STAGE(PG8_SA(1, 1), a1 + hstep, voffA);
            PG8_WAIT_V(8); PG8_WAIT_L(0); PG8_BAR; PG8_MMA(0, 0, At, B0); PG8_MMA(0, 1, At, B1); PG8_BAR; PG8_SCHED;
            PG8_LDA(At, 0, 1); PG8_STAGE(PG8_SB(0, 0), b2, voffB); PG8_STAGE(PG8_SB(0, 1), b2 + hstep, voffB); PG8_STAGE(PG8_SA(0, 0), a2, voffA);
            PG8_WAIT_V(8); PG8_WAIT_L(0); PG8_BAR; PG8_MMA(1, 0, At, B0); PG8_MMA(1, 1, At, B1); PG8_BAR; PG8_SCHED;
            PG8_LDB(B0, 1, 0); PG8_LDB(B1, 1, 1); PG8_SCHED; PG8_LDA(At, 1, 0); PG8_STAGE(PG8_SA(0, 1), a2 + hstep, voffA);
            PG8_WAIT_V(8); PG8_WAIT_L(0); PG8_BAR; PG8_MMA(0, 0, At, B0); PG8_MMA(0, 1, At, B1); PG8_BAR; PG8_SCHED;
            PG8_LDA(At, 1, 1); PG8_STAGE(PG8_SB(1, 0), b3, voffB); PG8_STAGE(PG8_SB(1, 1), b3 + hstep, voffB); PG8_STAGE(PG8_SA(1, 0), a3, voffA);
            PG8_WAIT_V(8); PG8_WAIT_L(0); PG8_BAR; PG8_MMA(1, 0, At, B0); PG8_MMA(1, 1, At, B1); PG8_BAR; PG8_SCHED;
            } else {
            PG8_LDB(B0, 0, 0); PG8_SCHED; PG8_LDA(At, 0, 0); PG8_STAGE(PG8_SA(1, 1), a1 + hstep, voffA);
            PG8_WAIT_L(8); PG8_BAR; PG8_WAIT_L(0); PG8_MMA(0, 0, At, B0); PG8_BAR; PG8_SCHED;
            PG8_LDB(B1, 0, 1); PG8_STAGE(PG8_SB(0, 0), b2, voffB);
            PG8_BAR; PG8_WAIT_L(0); PG8_MMA(0, 1, At, B1); PG8_BAR;
            PG8_LDA(At, 0, 1); PG8_STAGE(PG8_SA(0, 0), a2, voffA);
            PG8_BAR; PG8_WAIT_L(0); PG8_MMA(1, 0, At, B0); PG8_BAR; PG8_SCHED;
            PG8_STAGE(PG8_SB(0, 1), b2 + hstep, voffB);
            PG8_WAIT_V(6); PG8_BAR; PG8_MMA(1, 1, At, B1); PG8_BAR;
            PG8_LDB(B0, 1, 0); PG8_SCHED; PG8_LDA(At, 1, 0); PG8_STAGE(PG8_SA(0, 1), a2 + hstep, voffA);
            PG8_WAIT_L(8); PG8_BAR; PG8_WAIT_L(0); PG8_MMA(0, 0, At, B0); PG8_BAR; PG8_SCHED;
            PG8_LDB(B1, 1, 1); PG8_STAGE(PG8_SB(1, 0), b3, voffB);
            PG8_BAR; PG8_WAIT_L(0); PG8_MMA(0, 1, At, B1); PG8_BAR;
            PG8_LDA(At, 1, 1); PG8_STAGE(PG8_SA(1, 0), a3, voffA);
            PG8_BAR; PG8_WAIT_L(0); PG8_MMA(1, 0, At, B0); PG8_BAR; PG8_SCHED;
            PG8_STAGE(PG8_SB(1, 1), b3 + hstep, voffB);
            PG8_WAIT_V(6); PG8_BAR; PG8_MMA(1, 1, At, B1); PG8_BAR;
            }
        }
        if constexpr (ALIGN_EPI) { if (wr == 0) PG8_BAR; }
        if constexpr (!Epi::AFTER_DRAIN) { E(acc, cur, wr, wc, fr, fq); S.done(cur); }
        if (!has_next) break;
#pragma unroll
        for (int a = 0; a < 2; ++a)
#pragma unroll
            for (int b = 0; b < 2; ++b)
#pragma unroll
                for (int m = 0; m < 4; ++m)
#pragma unroll
                    for (int n = 0; n < 2; ++n) acc[a][b][m][n] = (f32x4){0.f, 0.f, 0.f, 0.f};
        cur = nxt; cA = nA; cB = nB; ++ui;
        if constexpr (ALIGN_EPI) { if (wr == 1) PG8_BAR; }
    }
    PG8_WAIT_V(0);
    if constexpr (!ALIGN_EPI) { if (wr == 0) PG8_BAR; }
    PG8_BAR;
    if constexpr (Epi::AFTER_DRAIN) { E.fused(acc, cur, wr, wc, fr, fq, lds, wid, lane); S.done(cur); }
#undef PG8_SA
#undef PG8_SB
#undef PG8_STAGE
#undef PG8_LDA
#undef PG8_LDB
#undef PG8_MMA
#undef PG8_WAIT_V
#undef PG8_WAIT_L
#undef PG8_BAR
#undef PG8_SCHED
}
}

constexpr int NW = 8;
constexpr int M = 24576, DM = 2048, DFF = 5632, NZ = 2 * DFF, NQKV = 3072, AW = 2048;
constexpr int SEQ_P = 8192, SEQ_S = 4096, ROWS_P = 2 * SEQ_P;
constexpr float EPS = 1e-6f, LOG2E = 1.4426950408889634f;
constexpr size_t MiB = 1u << 20;
constexpr size_t WS_RS = 0;
constexpr size_t WS_BAR = 3 * MiB;
constexpr size_t WS_W = 4 * MiB;
constexpr size_t SZ_AIN = (size_t)4096 * 2048 * 2, SZ_SQ = (size_t)2048 * 2048 * 2, SZ_QKV = (size_t)3072 * 2048 * 2, SZ_FIN = (size_t)NZ * 2048 * 2, SZ_FOUT = (size_t)2048 * DFF * 2;
constexpr size_t WS_AIN = WS_W, WS_AOUT = WS_AIN + 2 * SZ_AIN, WS_BQKV = WS_AOUT + 2 * SZ_SQ, WS_BOUT = WS_BQKV + 2 * SZ_QKV, WS_FIN = WS_BOUT + 2 * SZ_SQ, WS_FOUT = WS_FIN + 4 * SZ_FIN;
constexpr size_t WS_XB = WS_FOUT + 4 * SZ_FOUT;
constexpr size_t SZ_ROWS = (size_t)M * 2048 * 2;
constexpr size_t WS_ACT = WS_XB + SZ_ROWS;
constexpr size_t WS_HZ = WS_ACT + (size_t)M * DFF * 2;
constexpr size_t WS_R = WS_HZ + (size_t)96 * 4 * NZ * 4;
constexpr size_t WS_XQ = WS_R + 3 * SZ_ROWS;
constexpr size_t WS_FINQ = WS_XQ + (size_t)M * 2048;
constexpr size_t WS_QKVQ = WS_FINQ + (size_t)4 * NZ * 2048;
constexpr size_t WS_RMAX = WS_QKVQ + (size_t)2 * NQKV * 2048;
constexpr size_t WS_PCNT = WS_RMAX + (size_t)8 * M * 4;
constexpr size_t WS_AINQ = WS_PCNT + (size_t)8 * 96 * 256;
constexpr size_t WS_END = WS_AINQ + (size_t)4096 * 2048;
constexpr size_t WS_SWA = 3 * MiB + 614400;
constexpr size_t WS_SWQ = 3 * MiB + 524288;
constexpr size_t WS_SX = 3 * MiB + 131072, WS_SW = 3 * MiB + 262144;
constexpr size_t R_U = 0, R_VT2 = SZ_ROWS, R_Y = 2 * SZ_ROWS;
constexpr size_t R_Q = 0, R_K = SZ_ROWS, R_VTA = R_K + (size_t)M * 512 * 2, R_O = R_VTA + (size_t)M * 512 * 2;
constexpr int XCH_OFF = 131072, BARST_OFF = 131072 + 8192, LDS_BYTES = 131072 + 8192 + 16;

#define LAS __attribute__((address_space(3)))
typedef unsigned short bf16;
typedef float f32x4 __attribute__((ext_vector_type(4)));
typedef short bf16x8 __attribute__((ext_vector_type(8)));
typedef unsigned u32x4v __attribute__((ext_vector_type(4)));
typedef unsigned u32x2v __attribute__((ext_vector_type(2)));
using pg8::cvt_pk_bf16; using pg8::stat_t; using pg8::stat_fix; using pg8::STAT_INV;
__device__ __forceinline__ float bf_lo(unsigned w) { return __uint_as_float(w << 16); }
__device__ __forceinline__ float bf_hi(unsigned w) { return __uint_as_float(w & 0xffff0000u); }
__device__ __forceinline__ float wave_sum(float v) {
#pragma unroll
    for (int o = 1; o < 64; o <<= 1) v += __shfl_xor(v, o);
    return v;
}

struct Args { const float* in[19]; float* out; unsigned char* ws; int ph_lo, ph_hi, coop, pad; };

__device__ __forceinline__ void transpose_item(const float* W, int K, int N, bf16* WT, const float* gain, LAS float* scr, int item, int lane, bool ffn_perm) {
    const int nblk = N / 64, kb = item / nblk, nb = item % nblk, k0 = 64 * kb, n0 = 64 * nb;
    int d0 = n0; if (ffn_perm) { const int half = n0 >= DFF, cc = n0 - half * DFF; d0 = (cc >> 7) * 256 + half * 128 + (cc & 127); }
    const int lr = lane >> 4, lc = (lane & 15) * 4;
    const float* src = W + (size_t)(k0 + lr) * N + n0 + lc;
    f32x4 v[16];
#pragma unroll
    for (int i = 0; i < 16; ++i) v[i] = __builtin_nontemporal_load((const f32x4*)(src + (size_t)(4 * i) * N));
#pragma unroll
    for (int i = 0; i < 16; ++i) { LAS float* d = scr + (4 * i + lr) * 65 + lc; d[0] = v[i][0]; d[1] = v[i][1]; d[2] = v[i][2]; d[3] = v[i][3]; }
    asm volatile("s_waitcnt lgkmcnt(0)" ::: "memory");
    const int c = lane & 7;
    f32x4 g0 = (f32x4){1.f, 1.f, 1.f, 1.f}, g1 = g0;
    if (gain) { g0 = *(const f32x4*)(gain + k0 + 8 * c); g1 = *(const f32x4*)(gain + k0 + 8 * c + 4); }
#pragma unroll
    for (int j = 0; j < 8; ++j) { const int n = (lane >> 3) + 8 * j; const LAS float* s = scr + (8 * c) * 65 + n;
        u32x4v o; o.x = cvt_pk_bf16(s[0 * 65] * g0[0], s[1 * 65] * g0[1]); o.y = cvt_pk_bf16(s[2 * 65] * g0[2], s[3 * 65] * g0[3]); o.z = cvt_pk_bf16(s[4 * 65] * g1[0], s[5 * 65] * g1[1]); o.w = cvt_pk_bf16(s[6 * 65] * g1[2], s[7 * 65] * g1[3]);
        *(u32x4v*)(WT + (size_t)(d0 + n) * K + k0 + 8 * c) = o; }
    asm volatile("s_waitcnt lgkmcnt(0)" ::: "memory");
}
__device__ __forceinline__ void transpose_matrix(const float* W, int K, int N, bf16* WT, const float* gain, LAS float* scr, int gw, int ngw, int lane, bool ffn_perm = false) {
    const int items = (K / 64) * (N / 64);
    for (int it = gw; it < items; it += ngw) transpose_item(W, K, N, WT, gain, scr, it, lane, ffn_perm);
}
__device__ __forceinline__ void prologue_phase(const Args& a, LAS unsigned char* lds, int tid, int wave, int lane) {
    unsigned char* ws = a.ws;
    const int G = gridDim.x, gw = blockIdx.x * NW + wave, ngw = G * NW;
    { stat_t* z = (stat_t*)(ws + WS_RS) + M; const int n = 10 * M; int i = blockIdx.x * 512 + tid; while (i < n) { z[i] = 0ull; i += G * 512; asm volatile("" : "+v"(i)); } }
    { unsigned* z = (unsigned*)(ws + WS_RMAX); const int n = (int)((WS_AINQ - WS_RMAX) / 4); int i = blockIdx.x * 512 + tid; while (i < n) { z[i] = 0u; i += G * 512; asm volatile("" : "+v"(i)); } }
    LAS float* scr = (LAS float*)(lds + wave * 16640);
    const float* mixn = a.in[3]; const float* ffnn = a.in[4];
#pragma unroll 1
    for (int j = 0; j < 2; ++j) {
        transpose_matrix(a.in[6] + (size_t)j * 2048 * 4096, 2048, 4096, (bf16*)(ws + WS_AIN + j * SZ_AIN), mixn + (2 * j) * 2048, scr, gw, ngw, lane);
        transpose_matrix(a.in[11] + (size_t)j * 2048 * 2048, 2048, 2048, (bf16*)(ws + WS_AOUT + j * SZ_SQ), nullptr, scr, gw, ngw, lane);
        transpose_matrix(a.in[12] + (size_t)j * 2048 * 3072, 2048, 3072, (bf16*)(ws + WS_BQKV + j * SZ_QKV), mixn + (2 * j + 1) * 2048, scr, gw, ngw, lane);
        transpose_matrix(a.in[14] + (size_t)j * 2048 * 2048, 2048, 2048, (bf16*)(ws + WS_BOUT + j * SZ_SQ), nullptr, scr, gw, ngw, lane);
    }
#pragma unroll 1
    for (int i = 0; i < 4; ++i) {
        transpose_matrix(a.in[15] + (size_t)i * 2048 * NZ, 2048, NZ, (bf16*)(ws + WS_FIN + i * SZ_FIN), ffnn + i * 2048, scr, gw, ngw, lane, true);
        transpose_matrix(a.in[18] + (size_t)i * DFF * 2048, DFF, 2048, (bf16*)(ws + WS_FOUT + i * SZ_FOUT), nullptr, scr, gw, ngw, lane);
    }
    stat_t* rs0 = (stat_t*)(ws + WS_RS); bf16* XB = (bf16*)(ws + WS_XB);
    for (int row = gw; row < M; row += ngw) {
        const float* src = row < ROWS_P ? a.in[0] + (size_t)row * DM : a.in[1] + (size_t)(row - ROWS_P) * DM;
        float ss = 0.f;
#pragma unroll
        for (int j = 0; j < 8; ++j) {
            const f32x4 v = *(const f32x4*)(src + j * 256 + lane * 4);
            u32x2v w; w.x = cvt_pk_bf16(v[0], v[1]); w.y = cvt_pk_bf16(v[2], v[3]);
            const float r0 = bf_lo(w.x), r1 = bf_hi(w.x), r2 = bf_lo(w.y), r3 = bf_hi(w.y);
            ss += (r0 * r0 + r1 * r1) + (r2 * r2 + r3 * r3);
            *(u32x2v*)(XB + (size_t)row * DM + j * 256 + lane * 4) = w;
        }
        ss = wave_sum(ss);
        if (lane == 0) rs0[row] = stat_fix(ss);
    }
}

__device__ __forceinline__ void a2_phase(LAS unsigned char* lds, const float* Wsp, const float* bs, const float* vn, const stat_t* rsv, const bf16* U, const bf16* VT, bf16* Y,
                                         int tid, int wave, int lane) {
    const int fr = lane & 15, fq = lane >> 4;
    const int q4 = (tid & 31) * 4, p0 = tid >> 5;
    const int crow = 8 * (fr >> 2) + (fr & 3);
    for (int unit = blockIdx.x; unit < 192 * 8; unit += gridDim.x) {
        const int g = unit & 7, chunk = unit >> 3, row0 = chunk * 128;
        f32x4 wv[8];
#pragma unroll
        for (int i = 0; i < 8; ++i) wv[i] = *(const f32x4*)(Wsp + (size_t)(g * 128 + p0 + 16 * i) * 128 + q4);
        stat_t sq[4];
#pragma unroll
        for (int k = 0; k < 4; ++k) sq[k] = rsv[row0 + q4 + k];
        bf16x8 vf[2][4];
#pragma unroll
        for (int cf = 0; cf < 2; ++cf)
#pragma unroll
            for (int ks = 0; ks < 4; ++ks) vf[cf][ks] = *(const bf16x8*)(VT + ((size_t)chunk * 2048 + 256 * g + 32 * wave + crow + 4 * cf) * 128 + 32 * ks + 8 * fq);
        const int c0 = 256 * g + 32 * wave + 8 * fq;
        u32x4v uu[8]; float bsv[8];
#pragma unroll
        for (int pf = 0; pf < 8; ++pf) { uu[pf] = *(const u32x4v*)(U + (size_t)(row0 + 16 * pf + fr) * AW + c0); bsv[pf] = bs[g * 128 + 16 * pf + fr]; }
        const f32x4 vn0 = *(const f32x4*)(vn + c0), vn1 = *(const f32x4*)(vn + c0 + 4);
        __syncthreads();
        float rv[4];
#pragma unroll
        for (int k = 0; k < 4; ++k) rv[k] = rsqrtf((float)sq[k] * (STAT_INV / 2048.f) + EPS);
#pragma unroll
        for (int i = 0; i < 8; ++i) {
            u32x2v o; o.x = cvt_pk_bf16(wv[i][0] * rv[0], wv[i][1] * rv[1]); o.y = cvt_pk_bf16(wv[i][2] * rv[2], wv[i][3] * rv[3]);
            *(LAS u32x2v*)(lds + ((p0 + 16 * i) * 136 + q4) * 2) = o;
        }
        __syncthreads();
        f32x4 acc[8][2];
#pragma unroll
        for (int pf = 0; pf < 8; ++pf)
#pragma unroll
            for (int cf = 0; cf < 2; ++cf) acc[pf][cf] = (f32x4){0.f, 0.f, 0.f, 0.f};
#pragma unroll
        for (int pf = 0; pf < 8; ++pf)
#pragma unroll
            for (int ks = 0; ks < 4; ++ks) {
                const bf16x8 wf = *(const LAS bf16x8*)(lds + ((16 * pf + fr) * 136 + 32 * ks + 8 * fq) * 2);
#pragma unroll
                for (int cf = 0; cf < 2; ++cf) acc[pf][cf] = __builtin_amdgcn_mfma_f32_16x16x32_bf16(vf[cf][ks], wf, acc[pf][cf], 0, 0, 0);
            }
#pragma unroll
        for (int pf = 0; pf < 8; ++pf) {
            const float b = bsv[pf]; const f32x4 s0 = acc[pf][0], s1 = acc[pf][1]; const u32x4v u4 = uu[pf];
            u32x4v o;
            o.x = cvt_pk_bf16(bf_lo(u4.x) * (s0[0] * vn0[0] + b), bf_hi(u4.x) * (s0[1] * vn0[1] + b));
            o.y = cvt_pk_bf16(bf_lo(u4.y) * (s0[2] * vn0[2] + b), bf_hi(u4.y) * (s0[3] * vn0[3] + b));
            o.z = cvt_pk_bf16(bf_lo(u4.z) * (s1[0] * vn1[0] + b), bf_hi(u4.z) * (s1[1] * vn1[1] + b));
            o.w = cvt_pk_bf16(bf_lo(u4.w) * (s1[2] * vn1[2] + b), bf_hi(u4.w) * (s1[3] * vn1[3] + b));
            *(u32x4v*)(Y + (size_t)(row0 + 16 * pf + fr) * AW + c0) = o;
        }
    }
}

__device__ __forceinline__ int t5_bucket(int rel) {
    const int n = rel < 0 ? -rel : rel; int b;
    if (n < 8) b = n; else { b = 8 + (n >= 12) + (n >= 16) + (n >= 23) + (n >= 32) + (n >= 46) + (n >= 64) + (n >= 91) + (n >= 128); if (b > 15) b = 15; }
    return b + (rel > 0 ? 16 : 0);
}
constexpr int AT_KS = 0, AT_VS = 34816, AT_TB = 69632;
__device__ __forceinline__ void attn_seq(int row0, int& s0, int& s1) {
    if (row0 < ROWS_P) { s0 = row0 & ~(SEQ_P - 1); s1 = s0 + SEQ_P; } else { s0 = ROWS_P + ((row0 - ROWS_P) & ~(SEQ_S - 1)); s1 = s0 + SEQ_S; }
}
__device__ __forceinline__ void attn_phase(LAS unsigned char* lds, const bf16* Q, const bf16* Kb, const bf16* VT, bf16* O, const float* rel_bias, const float* sink,
                                           int tid, int wave, int lane) {
    constexpr int NU = 192 * 8;
    const int fr = lane & 15, fq = lane >> 4, hh = wave >> 2, wq = wave & 3;
    const int G = gridDim.x;
    LAS float* tb = (LAS float*)(lds + AT_TB);
    const int sr = tid >> 4, scc = (tid & 15) * 8;
    int unit = blockIdx.x;
    if (unit >= NU) return;
    int s0, s1; attn_seq((unit >> 3) * 128, s0, s1);
    int kb = ((unit >> 3) * 128 - 128 >= s0) ? -1 : 0;
    bool ustart = true;
    bf16x8 Qf[2][4]; float l_run[2]; f32x4 Oacc[2][8];
#pragma unroll 1
    while (unit < NU) {
        const int hp = unit & 1, kvh = (unit >> 1) & 3, row0 = (unit >> 3) * 128, h = kvh * 4 + hp * 2 + hh;
        int nunit = unit, nkb = kb + 1;
        if (nkb > 1 || row0 + nkb * 128 >= s1) { nunit = unit + G; nkb = 0; if (nunit < NU) { int t0, t1; attn_seq((nunit >> 3) * 128, t0, t1); nkb = ((nunit >> 3) * 128 - 128 >= t0) ? -1 : 0; } }
        u32x4v kreg[4], vreg[4];
        {   const int kr0 = row0 + kb * 128;
#pragma unroll
            for (int i = 0; i < 4; ++i) { kreg[i] = *(const u32x4v*)(Kb + (size_t)(kr0 + sr + 32 * i) * 512 + kvh * 128 + scc); vreg[i] = *(const u32x4v*)(VT + (size_t)(kvh * 128 + sr + 32 * i) * M + kr0 + scc); } }
        if (ustart) {
#pragma unroll
            for (int qf = 0; qf < 2; ++qf)
#pragma unroll
                for (int ks = 0; ks < 4; ++ks) Qf[qf][ks] = *(const bf16x8*)(Q + (size_t)(row0 + wq * 32 + qf * 16 + fr) * DM + h * 128 + 32 * ks + 8 * fq);
#pragma unroll
            for (int qf = 0; qf < 2; ++qf) { l_run[qf] = (fq == 0) ? 1.0f : 0.0f;
#pragma unroll
                for (int a = 0; a < 8; ++a) Oacc[qf][a] = (f32x4){0.f, 0.f, 0.f, 0.f}; }
        }
        __syncthreads();
#pragma unroll
        for (int i = 0; i < 4; ++i) { *(LAS u32x4v*)(lds + AT_KS + ((sr + 32 * i) * 136 + scc) * 2) = kreg[i]; *(LAS u32x4v*)(lds + AT_VS + ((sr + 32 * i) * 136 + scc) * 2) = vreg[i]; }
        if (ustart) {
#pragma unroll
            for (int i = 0; i < 2; ++i) { const int e = tid + 512 * i, th = e >> 9, rel = (e & 511) - 256, hd = kvh * 4 + hp * 2 + th; const bool in = rel >= -128 && rel <= 128;
                tb[e] = in ? (rel_bias[t5_bucket(rel) * 16 + hd] - sink[hd]) * LOG2E : -INFINITY; }
        }
        __syncthreads();
        {
        const int kt_lo = (kb == -1) ? wq : 0, kt_hi = (kb == 1) ? wq : 3;
        bf16x8 kf[2][4];
#pragma unroll
        for (int t = 0; t < 2; ++t)
#pragma unroll
            for (int ks = 0; ks < 4; ++ks) kf[t][ks] = *(const LAS bf16x8*)(lds + AT_KS + ((32 * kt_lo + 16 * t + fr) * 136 + 32 * ks + 8 * fq) * 2);
#pragma unroll 1
        for (int kt = kt_lo; kt <= kt_hi; ++kt) {
            f32x4 S[2][2];
#pragma unroll
            for (int qf = 0; qf < 2; ++qf)
#pragma unroll
                for (int t = 0; t < 2; ++t) S[qf][t] = (f32x4){0.f, 0.f, 0.f, 0.f};
#pragma unroll
            for (int t = 0; t < 2; ++t)
#pragma unroll
                for (int ks = 0; ks < 4; ++ks)
#pragma unroll
                    for (int qf = 0; qf < 2; ++qf) S[qf][t] = __builtin_amdgcn_mfma_f32_16x16x32_bf16(kf[t][ks], Qf[qf][ks], S[qf][t], 0, 0, 0);
            __builtin_amdgcn_sched_barrier(0);
            const LAS float* tp0 = tb + hh * 512 + (kb * 128 + 32 * kt + 4 * fq - (wq * 32 + fr) + 256);
            float bias[2][8];
#pragma unroll
            for (int qf = 0; qf < 2; ++qf)
#pragma unroll
                for (int t = 0; t < 2; ++t)
#pragma unroll
                    for (int i = 0; i < 4; ++i) bias[qf][4 * t + i] = tp0[16 * t + i - 16 * qf];
            u32x2v vr[4][2], vr2[4][2];
#pragma unroll
            for (int a = 0; a < 4; ++a) {
                vr[a][0] = *(const LAS u32x2v*)(lds + AT_VS + ((16 * a + fr) * 136 + 32 * kt + 4 * fq) * 2);
                vr[a][1] = *(const LAS u32x2v*)(lds + AT_VS + ((16 * a + fr) * 136 + 32 * kt + 16 + 4 * fq) * 2);
            }
            bf16x8 pf[2];
#pragma unroll
            for (int qf = 0; qf < 2; ++qf) {
                float p[8]; float ps = 0.f;
#pragma unroll
                for (int t = 0; t < 2; ++t)
#pragma unroll
                    for (int i = 0; i < 4; ++i) { p[4 * t + i] = __builtin_amdgcn_exp2f(S[qf][t][i] + bias[qf][4 * t + i]); ps += p[4 * t + i]; }
                l_run[qf] += ps;
                u32x4v pw; pw.x = cvt_pk_bf16(p[0], p[1]); pw.y = cvt_pk_bf16(p[2], p[3]); pw.z = cvt_pk_bf16(p[4], p[5]); pw.w = cvt_pk_bf16(p[6], p[7]);
                pf[qf] = __builtin_bit_cast(bf16x8, pw);
            }
            __builtin_amdgcn_sched_barrier(0);
#pragma unroll
            for (int a = 0; a < 4; ++a) {
                vr2[a][0] = *(const LAS u32x2v*)(lds + AT_VS + ((16 * (a + 4) + fr) * 136 + 32 * kt + 4 * fq) * 2);
                vr2[a][1] = *(const LAS u32x2v*)(lds + AT_VS + ((16 * (a + 4) + fr) * 136 + 32 * kt + 16 + 4 * fq) * 2);
            }
#pragma unroll
            for (int a = 0; a < 4; ++a) {
                u32x4v vw; vw.x = vr[a][0].x; vw.y = vr[a][0].y; vw.z = vr[a][1].x; vw.w = vr[a][1].y;
                const bf16x8 vf = __builtin_bit_cast(bf16x8, vw);
#pragma unroll
                for (int qf = 0; qf < 2; ++qf) Oacc[qf][a] = __builtin_amdgcn_mfma_f32_16x16x32_bf16(vf, pf[qf], Oacc[qf][a], 0, 0, 0);
            }
            __builtin_amdgcn_sched_barrier(0);
            if (kt < kt_hi) {
#pragma unroll
                for (int t = 0; t < 2; ++t)
#pragma unroll
                    for (int ks = 0; ks < 4; ++ks) kf[t][ks] = *(const LAS bf16x8*)(lds + AT_KS + ((32 * (kt + 1) + 16 * t + fr) * 136 + 32 * ks + 8 * fq) * 2);
            }
#pragma unroll
            for (int a = 0; a < 4; ++a) {
                u32x4v vw; vw.x = vr2[a][0].x; vw.y = vr2[a][0].y; vw.z = vr2[a][1].x; vw.w = vr2[a][1].y;
                const bf16x8 vf = __builtin_bit_cast(bf16x8, vw);
#pragma unroll
                for (int qf = 0; qf < 2; ++qf) Oacc[qf][a + 4] = __builtin_amdgcn_mfma_f32_16x16x32_bf16(vf, pf[qf], Oacc[qf][a + 4], 0, 0, 0);
            }
        }
        }
        if (nunit != unit) {
#pragma unroll
            for (int qf = 0; qf < 2; ++qf) {
                float lt = l_run[qf]; lt += __shfl_xor(lt, 16); lt += __shfl_xor(lt, 32);
                const float inv = 1.0f / lt;
                bf16* orow = O + (size_t)(row0 + wq * 32 + qf * 16 + fr) * DM + h * 128 + 4 * fq;
#pragma unroll
                for (int a = 0; a < 8; ++a) { const f32x4 o = Oacc[qf][a] * inv; u32x2v w; w.x = cvt_pk_bf16(o[0], o[1]); w.y = cvt_pk_bf16(o[2], o[3]); *(u32x2v*)(orow + 16 * a) = w; }
            }
            if (nunit < NU) attn_seq((nunit >> 3) * 128, s0, s1);
        }
        ustart = (nunit != unit); unit = nunit; kb = nkb;
    }
}

__device__ __forceinline__ bool seq_start(int t) { return t == 0 || t == SEQ_P || t == ROWS_P || t == ROWS_P + SEQ_S || t >= M; }
__device__ __forceinline__ void ffn_fix_phase(const float* HZ, const float* cw, const float* cb, bf16* ACT, int tid) {
    constexpr int NC4 = DFF / 4;
    const int total = 192 * NC4;
    const f32x4 zero4 = (f32x4){0.f, 0.f, 0.f, 0.f};
    for (int it = blockIdx.x * 512 + tid; it < total; it += gridDim.x * 512) {
        const int ri = it / NC4, c4 = it - ri * NC4, pm = ri >> 1, last = ri & 1, t = pm * 256 + last * 255, ch = 4 * c4;
        const int gi = (ch >> 7) * 256 + (ch & 127), ui = gi + 128;
        const float* hp = last ? HZ + (size_t)(pm * 4 + 2) * NZ : (seq_start(t) ? nullptr : HZ + (size_t)(pm * 4 - 1) * NZ);
        const float* hc = HZ + (size_t)(pm * 4 + (last ? 3 : 0)) * NZ;
        const float* hn = last ? (seq_start(t + 1) ? nullptr : HZ + (size_t)(pm * 4 + 4) * NZ) : HZ + (size_t)(pm * 4 + 1) * NZ;
        const f32x4 pg = hp ? *(const f32x4*)(hp + gi) : zero4, pu = hp ? *(const f32x4*)(hp + ui) : zero4;
        const f32x4 cg_ = *(const f32x4*)(hc + gi), cu = *(const f32x4*)(hc + ui);
        const f32x4 ng = hn ? *(const f32x4*)(hn + gi) : zero4, nu = hn ? *(const f32x4*)(hn + ui) : zero4;
        const f32x4 w0g = *(const f32x4*)(cw + ch), w1g = *(const f32x4*)(cw + NZ + ch), w2g = *(const f32x4*)(cw + 2 * NZ + ch), bg = *(const f32x4*)(cb + ch);
        const f32x4 w0u = *(const f32x4*)(cw + DFF + ch), w1u = *(const f32x4*)(cw + NZ + DFF + ch), w2u = *(const f32x4*)(cw + 2 * NZ + DFF + ch), bu = *(const f32x4*)(cb + DFF + ch);
        float o[4];
#pragma unroll
        for (int j = 0; j < 4; ++j) {
            const float g = w0g[j] * pg[j] + w1g[j] * cg_[j] + w2g[j] * ng[j] + bg[j];
            const float u = w0u[j] * pu[j] + w1u[j] * cu[j] + w2u[j] * nu[j] + bu[j];
            o[j] = pg8::silu_f(g) * u;
        }
        u32x2v w; w.x = cvt_pk_bf16(o[0], o[1]); w.y = cvt_pk_bf16(o[2], o[3]);
        *(u32x2v*)(ACT + (size_t)t * DFF + ch) = w;
    }
}

__device__ __forceinline__ void quant_rows_phase(const bf16* src, unsigned char* dst, float* scale, int R, int wave, int lane) {
    const int gw = blockIdx.x * NW + wave, ngw = gridDim.x * NW;
    for (int row = gw; row < R; row += ngw) {
        const u32x4v* p = (const u32x4v*)(src + (size_t)row * 2048 + lane * 32);
        u32x4v v[4];
#pragma unroll
        for (int i = 0; i < 4; ++i) v[i] = p[i];
        float f[32]; float mx = 0.f;
#pragma unroll
        for (int i = 0; i < 4; ++i)
#pragma unroll
            for (int k = 0; k < 4; ++k) { f[8 * i + 2 * k] = bf_lo(v[i][k]); f[8 * i + 2 * k + 1] = bf_hi(v[i][k]); mx = fmaxf(mx, fmaxf(fabsf(f[8 * i + 2 * k]), fabsf(f[8 * i + 2 * k + 1]))); }
#pragma unroll
        for (int o = 1; o < 64; o <<= 1) mx = fmaxf(mx, __shfl_xor(mx, o));
        const float inv = mx > 0.f ? 127.0f / mx : 0.f;
        if (lane == 0) scale[row] = mx * (1.0f / 127.0f);
        u32x4v o[2];
#pragma unroll
        for (int d = 0; d < 8; ++d) {
            const int q0 = (int)__builtin_rintf(f[4 * d] * inv), q1 = (int)__builtin_rintf(f[4 * d + 1] * inv), q2 = (int)__builtin_rintf(f[4 * d + 2] * inv), q3 = (int)__builtin_rintf(f[4 * d + 3] * inv);
            o[d >> 2][d & 3] = (unsigned)(q0 & 255) | ((unsigned)(q1 & 255) << 8) | ((unsigned)(q2 & 255) << 16) | ((unsigned)q3 << 24);
        }
        u32x4v* q = (u32x4v*)(dst + (size_t)row * 2048 + lane * 32);
        q[0] = o[0]; q[1] = o[1];
    }
}

__device__ __forceinline__ void final_phase(const bf16* XB, float* out, const stat_t* rs, const float* gain, int wave, int lane) {
    const int gw = blockIdx.x * NW + wave, ngw = gridDim.x * NW;
    for (int row = gw; row < M; row += ngw) {
        const float r = rsqrtf((float)rs[row] * (STAT_INV / 2048.f) + EPS);
#pragma unroll
        for (int j = 0; j < 8; ++j) {
            const u32x2v w = *(const u32x2v*)(XB + (size_t)row * DM + j * 256 + lane * 4);
            const f32x4 g = *(const f32x4*)(gain + j * 256 + lane * 4);
            f32x4 v; v[0] = bf_lo(w.x) * r * g[0]; v[1] = bf_hi(w.x) * r * g[1]; v[2] = bf_lo(w.y) * r * g[2]; v[3] = bf_hi(w.y) * r * g[3];
            *(f32x4*)(out + (size_t)row * DM + j * 256 + lane * 4) = v;
        }
    }
}

#define XB_TMO      128
#define XB_XCNT(j)  (256  + 64 * (j))
#define XB_XSUB(j)  (1280 + 64 * (j))
#define XB_XGEN(j)  (2304 + 64 * (j))
#define XB_TOP      3328
#define XB_TOPGEN   3392
#define XCD_BAR_WORDS 3456
#define XB_SPIN_CAP (1u << 18)

__device__ __forceinline__ unsigned xb_ld(unsigned* p)              { return __hip_atomic_load(p, __ATOMIC_RELAXED, __HIP_MEMORY_SCOPE_AGENT); }
__device__ __forceinline__ unsigned xb_add(unsigned* p, unsigned v) { return __hip_atomic_fetch_add(p, v, __ATOMIC_RELAXED, __HIP_MEMORY_SCOPE_AGENT); }
__device__ __forceinline__ unsigned xb_xcc_id() { return (unsigned)__builtin_amdgcn_s_getreg((3 << 11) | 20) & 0xFu; }
#define XB_SPIN(cond, bar) do { unsigned _sp = 0; while (cond) { __builtin_amdgcn_s_sleep(1); \
    if ((++_sp & 255u) == 0u) { if (xb_ld(&(bar)[XB_TMO])) break; if (_sp > XB_SPIN_CAP) { atomicAdd(&(bar)[XB_TMO], 1u); break; } } } } while (0)

struct XcdBarrier {
    unsigned* bar; unsigned x;
    volatile LAS unsigned* st;
};

__device__ __forceinline__ XcdBarrier xcd_barrier_post(unsigned* bar, volatile LAS unsigned* st) {
    XcdBarrier b; b.bar = bar; b.x = xb_xcc_id(); b.st = st;
    if (threadIdx.x == 0) (void)xb_add(&bar[XB_XCNT(b.x)], 1u);
    return b;
}
__device__ __forceinline__ void xcd_barrier_complete(unsigned* bar, unsigned x, unsigned& nloc, unsigned& nx) {
    const unsigned G = gridDim.x * gridDim.y * gridDim.z;
    unsigned sum, cnt, mine, sp = 0u;
    for (;;) {
        sum = 0u; cnt = 0u; mine = 0u;
#pragma unroll
        for (unsigned j = 0; j < 16; ++j) { const unsigned c = xb_ld(&bar[XB_XCNT(j)]); sum += c; cnt += (c > 0u) ? 1u : 0u; mine = (j == x) ? c : mine; }
        if (sum == G) break;
        __builtin_amdgcn_s_sleep(1);
        if ((++sp & 255u) == 0u) { if (xb_ld(&bar[XB_TMO])) break; if (sp > XB_SPIN_CAP) { atomicAdd(&bar[XB_TMO], 1u); break; } }
    }
    nloc = mine > 0u ? mine : 1u; nx = cnt > 0u ? cnt : 1u;
}

__device__ __forceinline__ void xcd_barrier(const XcdBarrier& b) {
    asm volatile("s_waitcnt vmcnt(0)" ::: "memory");
    __syncthreads();
    if (threadIdx.x == 0) {
        unsigned* bar = b.bar;
        __builtin_amdgcn_s_waitcnt(0);
        unsigned nloc = b.st[0], nx = b.st[1];
        if (nloc == 0u) { xcd_barrier_complete(bar, b.x, nloc, nx); b.st[0] = nloc; b.st[1] = nx; }
        const unsigned old = xb_add(&bar[XB_XSUB(b.x)], 1u);
        const unsigned gen = old / nloc;
        if (old + 1u == (gen + 1u) * nloc) {
            __builtin_amdgcn_fence(__ATOMIC_RELEASE, "agent");
            asm volatile("s_waitcnt vmcnt(0)" ::: "memory");
            const unsigned og = xb_add(&bar[XB_TOP], 1u);
            const unsigned tg = og / nx;
            if (og + 1u == (tg + 1u) * nx) xb_add(&bar[XB_TOPGEN], 1u);
            else XB_SPIN(xb_ld(&bar[XB_TOPGEN]) == tg, bar);
            __builtin_amdgcn_fence(__ATOMIC_ACQUIRE, "agent");
            xb_add(&bar[XB_XGEN(b.x)], 1u);
            asm volatile("s_waitcnt vmcnt(0)" ::: "memory");
        } else {
            XB_SPIN(xb_ld(&bar[XB_XGEN(b.x)]) == gen, bar);
            __builtin_amdgcn_fence(__ATOMIC_ACQUIRE, "agent");
            asm volatile("s_waitcnt vmcnt(0)" ::: "memory");
        }
    }
    __syncthreads();
}

constexpr int N_PHASES = 35;
__global__ void __launch_bounds__(NW * 64, 2) fwd_kernel(Args a) {
    extern __shared__ __attribute__((aligned(16))) unsigned char lds_raw[];
    LAS unsigned char* lds = (LAS unsigned char*)lds_raw;
    unsigned char* ws = a.ws;
    stat_t* RS = (stat_t*)(ws + WS_RS); stat_t* RSV = RS + 9 * M;
    bf16* XB = (bf16*)(ws + WS_XB); bf16* ACT = (bf16*)(ws + WS_ACT); unsigned char* R = ws + WS_R;
    const int G = gridDim.x;
    if (threadIdx.x < 4) ((LAS unsigned*)(lds + BARST_OFF))[threadIdx.x] = 0u;
    if (a.ph_lo == 0 && blockIdx.x == 0) { unsigned* bw = (unsigned*)(ws + WS_BAR); for (int i = threadIdx.x; i < XCD_BAR_WORDS; i += NW * 64) bw[i] = 0u; }
    __syncthreads();
    XcdBarrier bar; bar.bar = (unsigned*)(ws + WS_BAR); bar.x = 0; bar.st = (volatile LAS unsigned*)(lds + BARST_OFF);
#pragma unroll 1
    for (int ph = a.ph_lo; ph < a.ph_hi; ++ph) {
        int tid_ = threadIdx.x; asm volatile("" : "+v"(tid_));
        const int tid = tid_, lane = tid & 63, wave = __builtin_amdgcn_readfirstlane(tid >> 6);
        int bx_ = blockIdx.x; asm volatile("" : "+s"(bx_)); const int bx = bx_;
        if (ph == 0) prologue_phase(a, lds, tid, wave, lane);
        else if (ph == 1) { quant_rows_phase((const bf16*)(ws + WS_FIN), ws + WS_FINQ, (float*)(ws + WS_SW), 4 * NZ, wave, lane);
                            quant_rows_phase((const bf16*)(ws + WS_BQKV), ws + WS_QKVQ, (float*)(ws + WS_SWQ), 2 * NQKV, wave, lane);
                            quant_rows_phase((const bf16*)(ws + WS_AIN + SZ_AIN), ws + WS_AINQ, (float*)(ws + WS_SWA), 4096, wave, lane); }
        else if (ph == N_PHASES - 1) final_phase(XB, a.out, RS + 8 * M, a.in[5], wave, lane);
        else {
            const int li = (ph - 2) / 8, sp8 = (ph - 2) % 8, j = li >> 1; const bool isA = (li & 1) == 0;
            const bool fusedq = (G == 256);
            if ((sp8 == 0 && isA && li != 2) || (fusedq && (sp8 == 0 || sp8 == 4))) continue;
            const int sp = sp8 == 0 ? -1 : (sp8 < 4 ? sp8 - 1 : sp8 - 2);
            if (sp8 == 0 || sp8 == 4) quant_rows_phase(XB, ws + WS_XQ, (float*)(ws + WS_SX), M, wave, lane); else
            if (sp == 0 && isA) {
                if (li == 2) {
                    pg8::Gemm g{(const bf16*)(ws + WS_XQ), (const bf16*)(ws + WS_AINQ), M, 4096, 1024}; pg8::StaticOrder S; S.init(M, 4096, G, bx);
                    pg8::EpiGeluUV<true> E{RS + (2 * li) * M, a.in[7] + j * 4096, (bf16*)(R + R_U), (bf16*)(R + R_VT2), RSV + j * M, (const float*)(ws + WS_SX), (const float*)(ws + WS_SWA)};
                    pg8::gemm_phase<pg8::EpiGeluUV<true>, pg8::StaticOrder, true, true>(lds, g, S, E);
                } else {
                    pg8::Gemm g{XB, (const bf16*)(ws + WS_AIN + j * SZ_AIN), M, 4096, 2048}; pg8::StaticOrder S; S.init(M, 4096, G, bx);
                    pg8::EpiGeluUV<false> E{RS + (2 * li) * M, a.in[7] + j * 4096, (bf16*)(R + R_U), (bf16*)(R + R_VT2), RSV + j * M, nullptr, nullptr};
                    pg8::gemm_phase<pg8::EpiGeluUV<false>, pg8::StaticOrder, true, true>(lds, g, S, E);
                }
            } else if (sp == 0) {
                pg8::Gemm g{(const bf16*)(ws + WS_XQ), (const bf16*)(ws + WS_QKVQ + (size_t)j * NQKV * 2048), M, NQKV, 1024}; pg8::StaticOrder S; S.init(M, NQKV, G, bx);
                pg8::EpiQKV E{RS + (2 * li) * M, (bf16*)(R + R_Q), (bf16*)(R + R_K), (bf16*)(R + R_VTA), 0.08838834764831845f * LOG2E, (const float*)(ws + WS_SX), (const float*)(ws + WS_SWQ) + (size_t)j * NQKV};
                pg8::gemm_phase<pg8::EpiQKV, pg8::StaticOrder, true, true>(lds, g, S, E);
            } else if (sp == 1 && isA) {
                a2_phase(lds, a.in[9] + (size_t)j * 8 * 128 * 128, a.in[10] + j * 8 * 128, a.in[8] + j * 2048, RSV + j * M, (const bf16*)(R + R_U), (const bf16*)(R + R_VT2), (bf16*)(R + R_Y), tid, wave, lane);
            } else if (sp == 1) {
                attn_phase(lds, (const bf16*)(R + R_Q), (const bf16*)(R + R_K), (const bf16*)(R + R_VTA), (bf16*)(R + R_O), a.in[2], a.in[13] + j * 16, tid, wave, lane);
            } else if (sp == 2 || sp == 5) {
                const bf16* A; const bf16* Bt; int K; stat_t* rsn;
                if (sp == 2) { A = isA ? (const bf16*)(R + R_Y) : (const bf16*)(R + R_O); Bt = isA ? (const bf16*)(ws + WS_AOUT + j * SZ_SQ) : (const bf16*)(ws + WS_BOUT + j * SZ_SQ); K = 2048; rsn = RS + (2 * li + 1) * M; }
                else { A = ACT; Bt = (const bf16*)(ws + WS_FOUT + li * SZ_FOUT); K = DFF; rsn = RS + (2 * li + 2) * M; }
                pg8::Gemm g{A, Bt, M, 2048, K}; pg8::StaticOrder S; S.init(M, 2048, G, bx);
                const int quse = (sp == 2) ? li : (li == 0 ? 4 : (li == 2 ? 5 : 6));
                const int doq = fusedq && (sp == 2 || li < 3);
                typedef pg8::EpiResid<WS_XQ, WS_SX, WS_RMAX> EpiR;
                EpiR E{XB, rsn, ws, doq ? quse : -1};
                pg8::gemm_phase<EpiR, pg8::StaticOrder, true, true>(lds, g, S, E);
            } else if (sp == 3) {
                pg8::Gemm g{(const bf16*)(ws + WS_XQ), (const bf16*)(ws + WS_FINQ + (size_t)li * NZ * 2048), M, NZ, 1024}; pg8::StaticOrder S; S.init(M, NZ, G, bx);
                pg8::EpiConvGate E{RS + (2 * li + 1) * M, a.in[16] + (size_t)li * 3 * NZ, a.in[17] + (size_t)li * NZ, ACT, (float*)(ws + WS_HZ), lds + XCH_OFF, (const float*)(ws + WS_SX), (const float*)(ws + WS_SW) + (size_t)li * NZ};
                pg8::gemm_phase<pg8::EpiConvGate, pg8::StaticOrder, true, true>(lds, g, S, E);
            } else {
                ffn_fix_phase((const float*)(ws + WS_HZ), a.in[16] + (size_t)li * 3 * NZ, a.in[17] + (size_t)li * NZ, ACT, tid);
            }
        }
        if (a.coop && ph + 1 < a.ph_hi) {
            if (ph == 0) { cg::this_grid().sync(); bar = xcd_barrier_post((unsigned*)(ws + WS_BAR), (volatile LAS unsigned*)(lds + BARST_OFF)); }
            else xcd_barrier(bar);
        }
    }
}

extern "C" void kernel_launch(void* const* d_in, const int* in_sizes, int n_in, void* d_out, int out_size, void* d_ws, size_t ws_size, hipStream_t stream) {
    static int grid = 0;
    if (grid == 0) {
        if (n_in != 19 || out_size != M * DM || ws_size < WS_END) { fprintf(stderr, "kernel_launch: unexpected shapes (n_in %d out %d ws %zu need %zu)\n", n_in, out_size, ws_size, (size_t)WS_END); grid = -1; return; }
        int dev = 0, cus = 0, per_cu = 0;
        hipGetDevice(&dev); hipDeviceGetAttribute(&cus, hipDeviceAttributeMultiprocessorCount, dev);
        hipFuncSetAttribute((const void*)fwd_kernel, hipFuncAttributeMaxDynamicSharedMemorySize, LDS_BYTES);
        if (hipOccupancyMaxActiveBlocksPerMultiprocessor(&per_cu, (const void*)fwd_kernel, NW * 64, LDS_BYTES) != hipSuccess || per_cu < 1) { fprintf(stderr, "kernel_launch: occupancy query says %d\n", per_cu); per_cu = 1; }
        (void)hipGetLastError();
        grid = cus > 0 ? cus : 256;
    }
    if (grid < 0) return;
    Args a{};
    for (int i = 0; i < 19; ++i) a.in[i] = (const float*)d_in[i];
    a.out = (float*)d_out; a.ws = (unsigned char*)d_ws; a.pad = 0;
#if MK_COOP
    a.ph_lo = 0; a.ph_hi = N_PHASES; a.coop = 1;
    void* kargs[] = {&a};
    hipError_t e = hipLaunchCooperativeKernel((const void*)fwd_kernel, dim3(grid), dim3(NW * 64), kargs, LDS_BYTES, stream);
    if (e != hipSuccess) fprintf(stderr, "cooperative launch failed: %s (grid %d)\n", hipGetErrorString(e), grid);
#else
    a.coop = 0;
    for (int ph = 0; ph < N_PHASES; ++ph) { a.ph_lo = ph; a.ph_hi = ph + 1; hipLaunchKernelGGL(fwd_kernel, dim3(grid), dim3(NW * 64), LDS_BYTES, stream, a); }
#endif
}
```
